# Optimizing an MI355X kernel written in HIP

```python
import math
import jax
import jax.numpy as jnp
from jax import lax
import numpy as np

D_MODEL = 1024
BATCH = 4
SEQ = 4096
DEPTH = 2

CHUNK = 64
Q_BLOCK = 128
NORM_EPS = 1e-6
NEG_INF = -1e30

N_EVEN = (DEPTH + 1) // 2
N_ODD = DEPTH // 2

RWKV_HEAD_DIM = 64
RWKV_WIDTH = D_MODEL // 2
RWKV_HEADS = RWKV_WIDTH // RWKV_HEAD_DIM
DECAY_LORA = 64
ICLR_LORA = 64
GATE_LORA = 160
RWKV_GN_EPS = 1e-5 * RWKV_HEAD_DIM
RWKV_SPLITS = (RWKV_WIDTH, 2 * RWKV_WIDTH, 3 * RWKV_WIDTH,
               3 * RWKV_WIDTH + DECAY_LORA, 3 * RWKV_WIDTH + DECAY_LORA + ICLR_LORA)
RWKV_COLS = 3 * RWKV_WIDTH + DECAY_LORA + ICLR_LORA + GATE_LORA

S5_WIDTH = D_MODEL - RWKV_WIDTH
S5_GROUP = 16
S5_GROUPS = S5_WIDTH // S5_GROUP
S5_STATE = 64
S5_DT_MIN = 1e-3
S5_DT_MAX = 1e-1

IN_COLS = RWKV_COLS + S5_WIDTH
MIX_WIDTH = RWKV_WIDTH + S5_WIDTH

DIFF_HEAD_DIM = 64
DIFF_V_DIM = 2 * DIFF_HEAD_DIM
DIFF_HEADS = D_MODEL // DIFF_V_DIM
DIFF_WIDTH = DIFF_HEADS * DIFF_V_DIM

MEM_LEN = 256
MEM_HEADS = 4
MEM_HEAD_DIM = D_MODEL // MEM_HEADS

D_FF = 2816
N_EXPERTS = 8
TOP_K = 2
D_FF_EXPERT = 3584

kernel_name = 'hybrid_rwkv7_s5_diffattn_moe_encoder'

F32 = jnp.float32


def rms_norm(x, gain):
    xf = x.astype(F32)
    y = xf * lax.rsqrt(jnp.mean(xf * xf, axis=-1, keepdims=True) + NORM_EPS)
    return (y * gain.astype(F32)).astype(x.dtype)


def token_shift(z):
    return jnp.pad(z, ((0, 0), (1, 0), (0, 0)))[:, :-1]


def alibi_slopes(n_heads):
    return 2.0 ** (-8.0 * jnp.arange(1, n_heads + 1, dtype=F32) / n_heads)


def rwkv7_recurrence(r, decay, k, v, kk, a):
    b, _, h, n = r.shape

    def step(state, inp):
        r_t, w_t, k_t, v_t, kk_t, a_t = inp
        s_kk = jnp.einsum('bhvk,bhk->bhv', state, kk_t)
        state = (state * w_t[:, :, None, :]
                 - s_kk[..., None] * (kk_t * a_t)[:, :, None, :]
                 + v_t[..., None] * k_t[:, :, None, :])
        return state, jnp.einsum('bhvk,bhk->bhv', state, r_t)

    xs = tuple(jnp.moveaxis(t, 1, 0) for t in (r, decay, k, v, kk, a))
    _, out = lax.scan(step, jnp.zeros((b, h, n, n), F32), xs)
    return jnp.moveaxis(out, 0, 1)


def rwkv7_time_mix(zr, mu, w0, w_up, a0, a_up, g_up, k_k, k_a, r_k, ln_w, ln_b):
    b, t, _ = zr.shape
    zr = zr.astype(F32)
    zr = zr + (token_shift(zr) - zr) * mu.astype(F32)
    r, k, v, wd, ad, gd = jnp.split(zr, RWKV_SPLITS, axis=-1)
    heads = lambda u: u.reshape(b, t, RWKV_HEADS, RWKV_HEAD_DIM)
    w_log = -jax.nn.softplus(-(w0.astype(F32) + jnp.tanh(wd) @ w_up.astype(F32))) - 0.5
    decay = jnp.exp(-jnp.exp(w_log))
    a = jax.nn.sigmoid(a0.astype(F32) + ad @ a_up.astype(F32))
    g = jax.nn.sigmoid(gd) @ g_up.astype(F32)
    kk = heads(k * k_k.astype(F32))
    kk = kk * lax.rsqrt(jnp.maximum(jnp.sum(kk * kk, axis=-1, keepdims=True), 1e-24))
    k = k * (1.0 + (a - 1.0) * k_a.astype(F32))
    r_h, k_h, v_h = heads(r), heads(k), heads(v)
    o = rwkv7_recurrence(r_h, heads(decay), k_h, v_h, kk, heads(a))
    mean = jnp.mean(o, axis=-1, keepdims=True)
    var = jnp.mean(jnp.square(o - mean), axis=-1, keepdims=True)
    o = ((o - mean) * lax.rsqrt(var + RWKV_GN_EPS)).reshape(b, t, RWKV_WIDTH)
    o = o * ln_w.astype(F32) + ln_b.astype(F32)
    bonus = jnp.sum(r_h * k_h * r_k.astype(F32), axis=-1, keepdims=True) * v_h
    return (o + bonus.reshape(b, t, RWKV_WIDTH)) * g


def s5_ssm(u, lam_re, lam_im, log_dt, b_re, b_im, c_re, c_im, d_skip, w_glu, b_glu):
    b, t, _ = u.shape
    ug = u.astype(F32).reshape(b, t, S5_GROUPS, S5_GROUP)
    lam = lax.complex(lam_re.astype(F32), lam_im.astype(F32))
    dt = jnp.exp(log_dt.astype(F32))[:, None]
    lam_bar = jnp.exp(lam * dt)
    b_bar = ((lam_bar - 1.0) / lam)[..., None] * lax.complex(b_re.astype(F32), b_im.astype(F32))
    bu = jnp.einsum('gpi,btgi->btgp', b_bar, ug.astype(jnp.complex64))

    def combine(left, right):
        a_l, x_l = left
        a_r, x_r = right
        return a_r * a_l, a_r * x_l + x_r

    _, states = lax.associative_scan(combine, (jnp.broadcast_to(lam_bar, bu.shape), bu), axis=1)
    c_mat = lax.complex(c_re.astype(F32), c_im.astype(F32))
    y = jnp.real(jnp.einsum('gip,btgp->btgi', c_mat, states))
    y = y + d_skip.astype(F32).reshape(S5_GROUPS, S5_GROUP) * ug
    y = jax.nn.gelu(y.reshape(b, t, S5_WIDTH))
    return y * jax.nn.sigmoid(y @ w_glu.astype(F32) + b_glu.astype(F32))


def diff_attention(h, w_qkv, q_gain, k_gain, lam_q1, lam_k1, lam_q2, lam_k2, sub_gain, w_o, lambda_init):
    b, t, _ = h.shape
    q, k, v = jnp.split(h @ w_qkv, 3, axis=-1)
    q = rms_norm(q.reshape(b, t, DIFF_HEADS, 2, DIFF_HEAD_DIM), q_gain).astype(F32)
    k = rms_norm(k.reshape(b, t, DIFF_HEADS, 2, DIFF_HEAD_DIM), k_gain).astype(F32)
    v = v.reshape(b, t, DIFF_HEADS, DIFF_V_DIM).astype(F32)
    lam = (jnp.exp(jnp.sum(lam_q1.astype(F32) * lam_k1.astype(F32)))
           - jnp.exp(jnp.sum(lam_q2.astype(F32) * lam_k2.astype(F32))) + lambda_init)
    slopes = alibi_slopes(DIFF_HEADS)
    key_pos = jnp.arange(t)
    n_blocks = t // Q_BLOCK
    q_blocks = jnp.moveaxis(q.reshape(b, n_blocks, Q_BLOCK, DIFF_HEADS, 2, DIFF_HEAD_DIM), 1, 0)
    starts = jnp.arange(n_blocks) * Q_BLOCK
    scale = DIFF_HEAD_DIM ** -0.5

    def attend_block(args):
        qb, start = args
        q_pos = start + jnp.arange(Q_BLOCK)
        s = jnp.einsum('bqhcd,bshcd->bhcqs', qb, k) * scale
        dist = jnp.abs(q_pos[:, None] - key_pos[None, :]).astype(F32)
        bias = -slopes[:, None, None, None] * dist
        visible = (key_pos[None, :] // CHUNK) <= (q_pos[:, None] // CHUNK)
        p = jax.nn.softmax(jnp.where(visible, s + bias, NEG_INF), axis=-1)
        attn = p[:, :, 0] - lam * p[:, :, 1]
        return jnp.einsum('bhqs,bshe->bqhe', attn, v)

    o = lax.map(attend_block, (q_blocks, starts))
    o = jnp.moveaxis(o, 0, 1).reshape(b, t, DIFF_HEADS, DIFF_V_DIM)
    o = rms_norm(o, sub_gain) * (1.0 - lambda_init)
    return o.reshape(b, t, DIFF_WIDTH).astype(h.dtype) @ w_o


def memory_cross_attention(h, mem_n, w_q, w_kv, q_gain, k_gain, w_o):
    b, t, _ = h.shape
    m = mem_n.shape[1]
    q = rms_norm((h @ w_q).reshape(b, t, MEM_HEADS, MEM_HEAD_DIM), q_gain).astype(F32)
    k, v = jnp.split(mem_n @ w_kv, 2, axis=-1)
    k = rms_norm(k.reshape(b, m, MEM_HEADS, MEM_HEAD_DIM), k_gain).astype(F32)
    v = v.reshape(b, m, MEM_HEADS, MEM_HEAD_DIM).astype(F32)
    p = jax.nn.softmax(jnp.einsum('bthd,bmhd->bhtm', q, k) * MEM_HEAD_DIM ** -0.5, axis=-1)
    o = jnp.einsum('bhtm,bmhd->bthd', p, v).reshape(b, t, D_MODEL)
    return o.astype(h.dtype) @ w_o


def swiglu(h, w_gate, w_up, w_down):
    return (jax.nn.silu(h @ w_gate) * (h @ w_up)) @ w_down


def moe_swiglu(h, w_router, b_router, w_gate, w_up, w_down):
    logits = (h @ w_router).astype(F32) + b_router.astype(F32)
    top_logits, top_idx = lax.top_k(logits, TOP_K)
    top_w = jax.nn.softmax(top_logits, axis=-1)
    gates = jnp.sum(jax.nn.one_hot(top_idx, N_EXPERTS, dtype=F32) * top_w[..., None], axis=-2)
    out = jnp.zeros(h.shape, F32)
    for e in range(N_EXPERTS):
        y_e = swiglu(h, w_gate[e], w_up[e], w_down[e]).astype(F32)
        out = out + gates[..., e:e + 1] * y_e
    return out.astype(h.dtype)


def setup_inputs(seed: int = 0) -> dict:
    key = jax.random.key(seed)
    keys = iter(jax.random.split(key, 80))

    def nrm(shape, scale):
        return jax.random.normal(next(keys), shape, F32) * scale

    def gain(shape):
        return 1.0 + nrm(shape, 0.02)

    D, L, NE, NO = D_MODEL, DEPTH, N_EVEN, N_ODD
    G, P, I = S5_GROUPS, S5_STATE, S5_GROUP
    decay_ramp = -6.5 + 5.0 * jnp.linspace(0.0, 1.0, RWKV_WIDTH, dtype=F32) ** 0.85
    return {
        'x': nrm((BATCH, SEQ, D), 1.0),
        'mem': nrm((BATCH, MEM_LEN, D), 1.0),
        'norm_mix': gain((L, D)),
        'norm_xattn': gain((L, D)),
        'norm_mem': gain((L, D)),
        'norm_ffn': gain((L, D)),
        'xa_w_q': nrm((L, D, D), D ** -0.5),
        'xa_w_kv': nrm((L, D, 2 * D), D ** -0.5),
        'xa_q_gain': gain((L, MEM_HEAD_DIM)),
        'xa_k_gain': gain((L, MEM_HEAD_DIM)),
        'xa_w_o': nrm((L, D, D), D ** -0.5),
        'hy_w_in': nrm((NE, D, IN_COLS), D ** -0.5),
        'rw_mu': jax.random.uniform(next(keys), (NE, RWKV_COLS), F32),
        'rw_w0': decay_ramp + nrm((NE, RWKV_WIDTH), 0.01),
        'rw_w_up': nrm((NE, DECAY_LORA, RWKV_WIDTH), 0.1),
        'rw_a0': nrm((NE, RWKV_WIDTH), 0.1),
        'rw_a_up': nrm((NE, ICLR_LORA, RWKV_WIDTH), ICLR_LORA ** -0.5),
        'rw_g_up': nrm((NE, GATE_LORA, RWKV_WIDTH), GATE_LORA ** -0.5),
        'rw_k_k': 0.85 + nrm((NE, RWKV_WIDTH), 0.02),
        'rw_k_a': gain((NE, RWKV_WIDTH)),
        'rw_r_k': nrm((NE, RWKV_HEADS, RWKV_HEAD_DIM), 0.1),
        'rw_ln_w': gain((NE, RWKV_WIDTH)),
        'rw_ln_b': nrm((NE, RWKV_WIDTH), 0.02),
        's5_lam_re': -0.5 + nrm((NE, G, P), 0.01),
        's5_lam_im': jnp.pi * jnp.arange(P, dtype=F32) + nrm((NE, G, P), 0.01),
        's5_log_dt': jax.random.uniform(next(keys), (NE, G), F32, math.log(S5_DT_MIN), math.log(S5_DT_MAX)),
        's5_b_re': nrm((NE, G, P, I), (2 * I) ** -0.5),
        's5_b_im': nrm((NE, G, P, I), (2 * I) ** -0.5),
        's5_c_re': nrm((NE, G, I, P), P ** -0.5),
        's5_c_im': nrm((NE, G, I, P), P ** -0.5),
        's5_d': nrm((NE, S5_WIDTH), 1.0),
        's5_w_glu': nrm((NE, S5_WIDTH, S5_WIDTH), S5_WIDTH ** -0.5),
        's5_b_glu': nrm((NE, S5_WIDTH), 0.02),
        'hy_w_out': nrm((NE, MIX_WIDTH, D), MIX_WIDTH ** -0.5),
        'ff_w_gate': nrm((NE, D, D_FF), D ** -0.5),
        'ff_w_up': nrm((NE, D, D_FF), D ** -0.5),
        'ff_w_down': nrm((NE, D_FF, D), D_FF ** -0.5),
        'da_w_qkv': nrm((NO, D, 3 * DIFF_WIDTH), D ** -0.5),
        'da_q_gain': gain((NO, DIFF_HEAD_DIM)),
        'da_k_gain': gain((NO, DIFF_HEAD_DIM)),
        'da_lam_q1': nrm((NO, DIFF_HEAD_DIM), 0.1),
        'da_lam_k1': nrm((NO, DIFF_HEAD_DIM), 0.1),
        'da_lam_q2': nrm((NO, DIFF_HEAD_DIM), 0.1),
        'da_lam_k2': nrm((NO, DIFF_HEAD_DIM), 0.1),
        'da_sub_gain': gain((NO, DIFF_V_DIM)),
        'da_w_o': nrm((NO, DIFF_WIDTH, D), DIFF_WIDTH ** -0.5),
        'moe_w_router': nrm((NO, D, N_EXPERTS), D ** -0.5),
        'moe_b_router': nrm((NO, N_EXPERTS), 0.01),
        'moe_w_gate': nrm((NO, N_EXPERTS, D, D_FF_EXPERT), D ** -0.5),
        'moe_w_up': nrm((NO, N_EXPERTS, D, D_FF_EXPERT), D ** -0.5),
        'moe_w_down': nrm((NO, N_EXPERTS, D_FF_EXPERT, D), D_FF_EXPERT ** -0.5),
    }


def reference(x, mem, norm_mix, norm_xattn, norm_mem, norm_ffn,
              xa_w_q, xa_w_kv, xa_q_gain, xa_k_gain, xa_w_o,
              hy_w_in, rw_mu, rw_w0, rw_w_up, rw_a0, rw_a_up, rw_g_up, rw_k_k, rw_k_a, rw_r_k,
              rw_ln_w, rw_ln_b,
              s5_lam_re, s5_lam_im, s5_log_dt, s5_b_re, s5_b_im, s5_c_re, s5_c_im, s5_d,
              s5_w_glu, s5_b_glu, hy_w_out,
              ff_w_gate, ff_w_up, ff_w_down,
              da_w_qkv, da_q_gain, da_k_gain, da_lam_q1, da_lam_k1, da_lam_q2, da_lam_k2,
              da_sub_gain, da_w_o,
              moe_w_router, moe_b_router, moe_w_gate, moe_w_up, moe_w_down):
    h = x
    for l in range(DEPTH):
        i = l // 2
        hn = rms_norm(h, norm_mix[l])
        if l % 2 == 0:
            z = hn @ hy_w_in[i]
            y_a = rwkv7_time_mix(z[..., :RWKV_COLS], rw_mu[i], rw_w0[i], rw_w_up[i], rw_a0[i],
                                 rw_a_up[i], rw_g_up[i], rw_k_k[i], rw_k_a[i], rw_r_k[i],
                                 rw_ln_w[i], rw_ln_b[i])
            y_b = s5_ssm(z[..., RWKV_COLS:], s5_lam_re[i], s5_lam_im[i], s5_log_dt[i], s5_b_re[i],
                         s5_b_im[i], s5_c_re[i], s5_c_im[i], s5_d[i], s5_w_glu[i], s5_b_glu[i])
            y_mix = jnp.concatenate([y_a, y_b], axis=-1).astype(h.dtype) @ hy_w_out[i]
        else:
            lambda_init = 0.8 - 0.6 * math.exp(-0.3 * l)
            y_mix = diff_attention(hn, da_w_qkv[i], da_q_gain[i], da_k_gain[i], da_lam_q1[i],
                                   da_lam_k1[i], da_lam_q2[i], da_lam_k2[i], da_sub_gain[i],
                                   da_w_o[i], lambda_init)
        h = h + y_mix.astype(h.dtype)
        y_mem = memory_cross_attention(rms_norm(h, norm_xattn[l]), rms_norm(mem, norm_mem[l]),
                                       xa_w_q[l], xa_w_kv[l], xa_q_gain[l], xa_k_gain[l], xa_w_o[l])
        h = h + y_mem.astype(h.dtype)
        hn = rms_norm(h, norm_ffn[l])
        if l % 2 == 0:
            y_ff = swiglu(hn, ff_w_gate[i], ff_w_up[i], ff_w_down[i])
        else:
            y_ff = moe_swiglu(hn, moe_w_router[i], moe_b_router[i], moe_w_gate[i],
                              moe_w_up[i], moe_w_down[i])
        h = h + y_ff.astype(h.dtype)
    return h
```

```cpp
#include <hip/hip_runtime.h>
#include <stdint.h>
#include <stdio.h>

#define LAS __attribute__((address_space(3)))

#define XB_TMO      128
#define XB_XCNT(j)  (256  + 64 * (j))
#define XB_XSUB(j)  (1280 + 64 * (j))
#define XB_XGEN(j)  (2304 + 64 * (j))
#define XB_TOP      3328
#define XB_TOPGEN   3392
#define XCD_BAR_WORDS 3456
#define XB_SPIN_CAP (1u << 25)

__device__ __forceinline__ unsigned xb_ld(unsigned* p)              { return __hip_atomic_load(p, __ATOMIC_RELAXED, __HIP_MEMORY_SCOPE_AGENT); }
__device__ __forceinline__ unsigned xb_add(unsigned* p, unsigned v) { return __hip_atomic_fetch_add(p, v, __ATOMIC_RELAXED, __HIP_MEMORY_SCOPE_AGENT); }
__device__ __forceinline__ unsigned xb_xcc_id() { return (unsigned)__builtin_amdgcn_s_getreg((3 << 11) | 20) & 0xFu; }
#define XB_SPIN(cond, bar) do { unsigned _sp = 0; while (cond) { __builtin_amdgcn_s_sleep(1); \
    if ((++_sp & 255u) == 0u) { if (xb_ld(&(bar)[XB_TMO])) break; if (_sp > XB_SPIN_CAP) { atomicAdd(&(bar)[XB_TMO], 1u); break; } } } } while (0)

struct XcdBarrier { unsigned* bar; unsigned x; volatile LAS unsigned* st; };

__device__ __forceinline__ XcdBarrier xcd_barrier_post(unsigned* bar, volatile LAS unsigned* st) {
    XcdBarrier b; b.bar = bar; b.x = xb_xcc_id(); b.st = st;
    if (threadIdx.x == 0) (void)xb_add(&bar[XB_XCNT(b.x)], 1u);
    return b;
}
__device__ __forceinline__ void xcd_barrier_complete(unsigned* bar, unsigned x, unsigned& nloc, unsigned& nx) {
    const unsigned G = gridDim.x * gridDim.y * gridDim.z;
    unsigned sum, cnt, mine, sp = 0u;
    for (;;) {
        sum = 0u; cnt = 0u; mine = 0u;
#pragma unroll
        for (unsigned j = 0; j < 16; ++j) { const unsigned c = xb_ld(&bar[XB_XCNT(j)]); sum += c; cnt += (c > 0u) ? 1u : 0u; mine = (j == x) ? c : mine; }
        if (sum == G) break;
        __builtin_amdgcn_s_sleep(1);
        if ((++sp & 255u) == 0u) { if (xb_ld(&bar[XB_TMO])) break; if (sp > XB_SPIN_CAP) { atomicAdd(&bar[XB_TMO], 1u); break; } }
    }
    nloc = mine > 0u ? mine : 1u; nx = cnt > 0u ? cnt : 1u;
}
__device__ __forceinline__ void xcd_barrier(const XcdBarrier& b) {
    asm volatile("s_waitcnt vmcnt(0)" ::: "memory");
    __syncthreads();
    if (threadIdx.x == 0) {
        unsigned* bar = b.bar;
        __builtin_amdgcn_s_waitcnt(0);
        unsigned nloc = b.st[0], nx = b.st[1];
        if (nloc == 0u) { xcd_barrier_complete(bar, b.x, nloc, nx); b.st[0] = nloc; b.st[1] = nx; }
        const unsigned old = xb_add(&bar[XB_XSUB(b.x)], 1u);
        const unsigned gen = old / nloc;
        if (old + 1u == (gen + 1u) * nloc) {
            __builtin_amdgcn_fence(__ATOMIC_RELEASE, "agent");
            asm volatile("s_waitcnt vmcnt(0)" ::: "memory");
            const unsigned og = xb_add(&bar[XB_TOP], 1u);
            const unsigned tg = og / nx;
            const bool lastx = (og + 1u == (tg + 1u) * nx);
            if (lastx) xb_add(&bar[XB_TOPGEN], 1u);
            else { __builtin_amdgcn_fence(__ATOMIC_ACQUIRE, "agent"); asm volatile("s_waitcnt vmcnt(0)" ::: "memory"); XB_SPIN(xb_ld(&bar[XB_TOPGEN]) == tg, bar); }
            xb_add(&bar[XB_XGEN(b.x)], 1u);
            if (lastx) __builtin_amdgcn_fence(__ATOMIC_ACQUIRE, "agent");
            asm volatile("s_waitcnt vmcnt(0)" ::: "memory");
        } else {
            __builtin_amdgcn_fence(__ATOMIC_ACQUIRE, "agent");
            asm volatile("s_waitcnt vmcnt(0)" ::: "memory");
            XB_SPIN(xb_ld(&bar[XB_XGEN(b.x)]) == gen, bar);
        }
    }
    __syncthreads();
}

constexpr int NB = 4, T = 4096, D = 1024, M = NB * T;
constexpr int RCOLS = 1824, INCOLS = 2336, DFF = 2816, NEXP = 8, DFFE = 3584, MEML = 256;
constexpr int NTHR = 512;
constexpr int LDS_BYTES = 147456;
constexpr float NORM_EPS = 1e-6f;
constexpr float LAMBDA_INIT = 0.35550906f;

enum { I_X = 0, I_MEM, I_NORM_MIX, I_NORM_XATTN, I_NORM_MEM, I_NORM_FFN, I_XA_WQ, I_XA_WKV, I_XA_QG, I_XA_KG, I_XA_WO,
       I_HY_WIN, I_RW_MU, I_RW_W0, I_RW_WUP, I_RW_A0, I_RW_AUP, I_RW_GUP, I_RW_KK, I_RW_KA, I_RW_RK, I_RW_LNW, I_RW_LNB,
       I_S5_LRE, I_S5_LIM, I_S5_LDT, I_S5_BRE, I_S5_BIM, I_S5_CRE, I_S5_CIM, I_S5_D, I_S5_WGLU, I_S5_BGLU, I_HY_WOUT,
       I_FF_WG, I_FF_WU, I_FF_WD, I_DA_WQKV, I_DA_QG, I_DA_KG, I_DA_LQ1, I_DA_LK1, I_DA_LQ2, I_DA_LK2, I_DA_SUBG, I_DA_WO,
       I_MOE_WR, I_MOE_BR, I_MOE_WG, I_MOE_WU, I_MOE_WD, N_IN };

struct Params { const float* in[N_IN]; float* out; unsigned char* ws; };

constexpr size_t MiB = 1u << 20;
constexpr size_t WS_CTL = 0, CTL_BYTES = 1 * MiB;
constexpr size_t CW_BAR = 4096;
constexpr size_t CW_CNT = 16384;
constexpr size_t CW_ATTQ = 16448;
constexpr size_t CW_GLUF = 17088;
constexpr size_t CW_R2F = 16512;
#define WSF(mib) ((float*)(ws + (size_t)(mib) * MiB))

__device__ __forceinline__ int otid() { int t = threadIdx.x; asm volatile("" : "+v"(t)); return t; }
__device__ __forceinline__ float wave_sum(float v) {
#pragma unroll
    for (int o = 1; o < 64; o <<= 1) v += __shfl_xor(v, o);
    return v;
}
__device__ __forceinline__ float row_sum_dpp(float v) {
#define DPP_ROR_ADD(n) v += __builtin_bit_cast(float, __builtin_amdgcn_update_dpp(0, __builtin_bit_cast(int, v), 0x120 + (n), 0xf, 0xf, false))
    DPP_ROR_ADD(8); DPP_ROR_ADD(4); DPP_ROR_ADD(2); DPP_ROR_ADD(1);
#undef DPP_ROR_ADD
    return v;
}
__device__ __forceinline__ float wave_sum_dpp(float v) {
    float o;
    asm("s_nop 1\n\tv_add_f32_dpp %0, %1, %1 row_ror:8 row_mask:0xf bank_mask:0xf\n\t"
        "s_nop 1\n\tv_add_f32_dpp %0, %0, %0 row_ror:4 row_mask:0xf bank_mask:0xf\n\t"
        "s_nop 1\n\tv_add_f32_dpp %0, %0, %0 row_ror:2 row_mask:0xf bank_mask:0xf\n\t"
        "s_nop 1\n\tv_add_f32_dpp %0, %0, %0 row_ror:1 row_mask:0xf bank_mask:0xf\n\t"
        "s_nop 1\n\tv_add_f32_dpp %0, %0, %0 row_bcast:15 row_mask:0xa bank_mask:0xf\n\t"
        "s_nop 1\n\tv_add_f32_dpp %0, %0, %0 row_bcast:31 row_mask:0xc bank_mask:0xf"
        : "=&v"(o) : "v"(v));
    return __builtin_bit_cast(float, __builtin_amdgcn_readlane(__builtin_bit_cast(int, o), 63));
}
__device__ __forceinline__ float wave_max(float v) {
#pragma unroll
    for (int o = 1; o < 64; o <<= 1) v = fmaxf(v, __shfl_xor(v, o));
    return v;
}
__device__ __forceinline__ float sigmoidf_(float x) { return 1.0f / (1.0f + expf(-x)); }
__device__ __forceinline__ float fexp2(float x) { return __builtin_amdgcn_exp2f(x); }
__device__ __forceinline__ float fexp(float x) { return __builtin_amdgcn_exp2f(x * 1.4426950408889634f); }
__device__ __forceinline__ float frcp(float x) { return __builtin_amdgcn_rcpf(x); }
__device__ __forceinline__ float frsq(float x) { return __builtin_amdgcn_rsqf(x); }
__device__ __forceinline__ float fsigmoid(float x) { return frcp(1.0f + fexp(-x)); }
__device__ __forceinline__ float ftanh(float x) { const float a = fminf(fmaxf(x, -15.f), 15.f); return 1.0f - 2.0f * frcp(1.0f + fexp(2.0f * a)); }
__device__ __forceinline__ float fsoftplus(float x) { return x > 20.f ? x : __builtin_amdgcn_logf(1.0f + fexp(x)) * 0.6931471805599453f; }
__device__ __forceinline__ float softplusf_(float x) { return x > 20.f ? x : log1pf(expf(x)); }
__device__ __forceinline__ float gelu_tanh(float y) { return 0.5f * y * (1.0f + ftanh(0.7978845608028654f * (y + 0.044715f * y * y * y))); }

namespace pg8 {
#define PG8_LAS __attribute__((address_space(3)))
typedef unsigned short bf16_t;
typedef short bf16x8 __attribute__((ext_vector_type(8)));
typedef float f32x4 __attribute__((ext_vector_type(4)));
typedef unsigned u32x4 __attribute__((ext_vector_type(4)));
constexpr int BM = 256, BK = 64, HALF = 128, HTB = HALF * BK * 2  , STAGE_BYTES = 8 * HTB, NXCD = 8, WGM = 8;

__host__ __device__ __forceinline__ int lds_byte(int r, int c) { const int st = (r >> 4) * 2 + (c >> 5), rr = r & 15, cc = c & 31, ob = rr * 64 + cc * 2; return st * 1024 + (ob ^ (((ob >> 9) & 1) << 5)); }
__host__ __device__ __forceinline__ void stage_rc(int b, int& R, int& C) { const int st = b / 1024, sb = b % 1024, swz = sb ^ (((sb >> 9) & 1) << 5); R = (st >> 1) * 16 + swz / 64; C = (st & 1) * 32 + (swz % 64) / 2; }
__host__ __device__ __forceinline__ int perm32(int rho) { const int n = rho >> 4, i = rho & 15; return 8 * (i >> 2) + 4 * n + (i & 3); }

struct Unit { int pm, pn; };
struct Gemm { const bf16_t* A; const bf16_t* Bt; int M, N, K; int lda, ldb; };

struct StaticOrder {
    int nM, nN, nwg, G, c;
    __host__ __device__ void init(int M, int N, int G_, int c_) { nM = M / BM; nN = N / BM; nwg = nM * nN; G = G_; c = c_; }
    __host__ __device__ bool next(int i, Unit& u) const {
        const long L = (long)i * G + c; if (L >= nwg) return false;
        int wgid = (int)L; { const int q = nwg / NXCD, r = nwg % NXCD, xcd = wgid % NXCD, off = wgid / NXCD; wgid = (xcd < r ? xcd * (q + 1) : r * (q + 1) + (xcd - r) * q) + off; }
        const int nig = WGM * nN, gid = wgid / nig, fm = gid * WGM, gsz = (nM - fm) < WGM ? (nM - fm) : WGM;
        u.pm = fm + ((wgid % nig) % gsz); u.pn = (wgid % nig) / gsz; return true;
    }
    __device__ __forceinline__ void a_ready(const Unit&) const {}
    __device__ __forceinline__ void done(const Unit&) const {}
};
__device__ __forceinline__ void static_unit_of(int nM, int nN, int c, int& pm, int& pn) {
    const int nwg = nM * nN; const int q = nwg / NXCD, r = nwg % NXCD, xcd = c % NXCD, off = c / NXCD; const int wgid = (xcd < r ? xcd * (q + 1) : r * (q + 1) + (xcd - r) * q) + off;
    const int nig = WGM * nN, gid = wgid / nig, fm = gid * WGM, gsz = (nM - fm) < WGM ? (nM - fm) : WGM; pm = fm + ((wgid % nig) % gsz); pn = (wgid % nig) / gsz;
}
typedef float f32x2c __attribute__((ext_vector_type(2)));
typedef __bf16 bf16x2c __attribute__((ext_vector_type(2)));
__device__ __forceinline__ unsigned cvt_pk_bf16(float lo, float hi) { const f32x2c v = {lo, hi}; const bf16x2c r = __builtin_convertvector(v, bf16x2c); return __builtin_bit_cast(unsigned, r); }
typedef float f32x2 __attribute__((ext_vector_type(2)));
template <class Epi, class Sched, bool ALIGN_EPI = false, bool SP2 = false>
__device__ __forceinline__ void gemm_phase(PG8_LAS unsigned char* lds, const Gemm g, const Sched& S, const Epi& E) {
    const int tid = ::otid(), wid = __builtin_amdgcn_readfirstlane(tid >> 6), lane = tid & 63, wr = wid >> 2, wc = wid & 3, fr = lane & 15, fq = lane >> 4;
    const int K = g.K, nt = K / BK; const int lda = g.lda ? g.lda : K, ldb = g.ldb ? g.ldb : K;
    unsigned voffA[2], voffB[2];
#pragma unroll
    for (int i = 0; i < 2; ++i) { int R, C; stage_rc(tid * 16 + i * 8192, R, C); const int Rb = Epi::PERM ? ((R & ~31) + perm32(R & 31)) : R;
        voffA[i] = (unsigned)(R * lda + C) * 2u; voffB[i] = (unsigned)(Rb * ldb + C) * 2u; }
    const size_t kstep = (size_t)(BK * 2);
    const size_t hstepA = (size_t)HALF * lda * 2, hstepB = (size_t)HALF * ldb * 2;
    const size_t tstepA = 2 * hstepA, tstepB = 2 * hstepB;
    const unsigned ldsw = (unsigned)wid * 1024u; const unsigned ldsb32 = (unsigned)(size_t)lds;
    const int aoff = lds_byte(wr * 64 + fr, fq * 8), boff = lds_byte(wc * 32 + fr, fq * 8);
#define PG8_SA(b, h) (((b) * 2 + (h)) * HTB)
#define PG8_SB(b, h) ((4 + (b) * 2 + (h)) * HTB)
#define PG8_STAGE(bufoff, gbase, voff) do { _Pragma("unroll") for (int _i = 0; _i < 2; ++_i) \
        asm volatile("s_mov_b32 m0, %2\n\tglobal_load_lds_dwordx4 %0, %1" :: "v"((voff)[_i]), "s"((const char*)(gbase)), "s"((unsigned)(ldsb32 + (unsigned)(bufoff) + ldsw + (unsigned)(_i * 8192))) : "memory", "m0"); } while (0)
#define PG8_LDA(dst, b, h) do { _Pragma("unroll") for (int m = 0; m < 4; ++m) _Pragma("unroll") for (int k = 0; k < 2; ++k) dst[m][k] = *(const PG8_LAS bf16x8*)(lds + PG8_SA(b, h) + aoff + m * 2048 + k * 1024); } while (0)
#define PG8_LDB(dst, b, h) do { _Pragma("unroll") for (int n = 0; n < 2; ++n) _Pragma("unroll") for (int k = 0; k < 2; ++k) dst[n][k] = *(const PG8_LAS bf16x8*)(lds + PG8_SB(b, h) + boff + n * 2048 + k * 1024); } while (0)
#define PG8_MMA(ai, bj, At, Bt) do { __builtin_amdgcn_s_setprio(1); _Pragma("unroll") for (int m = 0; m < 4; ++m) _Pragma("unroll") for (int n = 0; n < 2; ++n) _Pragma("unroll") for (int k = 0; k < 2; ++k) \
        acc[ai][bj][m][n] = __builtin_amdgcn_mfma_f32_16x16x32_bf16(Bt[n][k], At[m][k], acc[ai][bj][m][n], 0, 0, 0); __builtin_amdgcn_s_setprio(0); } while (0)
#define PG8_WAIT_V(n) asm volatile("s_waitcnt vmcnt(" #n ")" ::: "memory")
#define PG8_WAIT_L(n) asm volatile("s_waitcnt lgkmcnt(" #n ")" ::: "memory")
#define PG8_BAR __builtin_amdgcn_s_barrier()
#define PG8_SCHED __builtin_amdgcn_sched_barrier(0)
    Unit cur, nxt; int ui = 0;
    if (!S.next(0, cur)) return;
    f32x4 acc[2][2][4][2];
#pragma unroll
    for (int a = 0; a < 2; ++a)
#pragma unroll
        for (int b = 0; b < 2; ++b)
#pragma unroll
            for (int m = 0; m < 4; ++m)
#pragma unroll
                for (int n = 0; n < 2; ++n) acc[a][b][m][n] = (f32x4){0.f, 0.f, 0.f, 0.f};
    bf16x8 At[4][2], B0[2][2], B1[2][2];
    const char* cA = (const char*)g.A + (size_t)cur.pm * tstepA; const char* cB = (const char*)g.Bt + (size_t)cur.pn * tstepB;
    S.a_ready(cur);
    if constexpr (SP2) {
        PG8_STAGE(PG8_SB(0, 0), cB, voffB); PG8_STAGE(PG8_SB(0, 1), cB + hstepB, voffB); PG8_STAGE(PG8_SA(0, 0), cA, voffA); PG8_STAGE(PG8_SA(0, 1), cA + hstepA, voffA);
        if (wr == 1) PG8_BAR;
        PG8_WAIT_V(2); PG8_BAR;
        PG8_STAGE(PG8_SB(1, 0), cB + kstep, voffB); PG8_STAGE(PG8_SA(1, 0), cA + kstep, voffA); PG8_STAGE(PG8_SB(1, 1), cB + hstepB + kstep, voffB);
        PG8_WAIT_V(6); PG8_BAR;
    } else {
        PG8_STAGE(PG8_SB(0, 0), cB, voffB); PG8_STAGE(PG8_SA(0, 0), cA, voffA); PG8_STAGE(PG8_SB(0, 1), cB + hstepB, voffB); PG8_STAGE(PG8_SA(0, 1), cA + hstepA, voffA);
        if (wr == 1) PG8_BAR;
        PG8_WAIT_V(4); PG8_BAR;
        PG8_STAGE(PG8_SB(1, 0), cB + kstep, voffB); PG8_STAGE(PG8_SA(1, 0), cA + kstep, voffA); PG8_STAGE(PG8_SB(1, 1), cB + hstepB + kstep, voffB);
        PG8_WAIT_V(6); PG8_BAR;
    }
    for (;;) {
        const bool has_next = S.next(ui + 1, nxt);
        const char* nA = has_next ? (const char*)g.A + (size_t)nxt.pm * tstepA : cA; const char* nB = has_next ? (const char*)g.Bt + (size_t)nxt.pn * tstepB : cB;
        for (int t = 0; t < nt; t += 2) {
            const bool last = (t == nt - 2);
            const char* a1 = cA + (size_t)(t + 1) * kstep;
            const char* a2 = last ? nA : cA + (size_t)(t + 2) * kstep; const char* b2 = last ? nB : cB + (size_t)(t + 2) * kstep;
            const char* a3 = a2 + kstep; const char* b3 = b2 + kstep;
            if (last && has_next) S.a_ready(nxt);
            if constexpr (SP2) {
            PG8_LDB(B0, 0, 0); PG8_LDB(B1, 0, 1); PG8_SCHED; PG8_LDA(At, 0, 0); PG8_STAGE(PG8_SA(1, 1), a1 + hstepA, voffA);
            PG8_WAIT_V(8); PG8_WAIT_L(0); PG8_BAR; PG8_MMA(0, 0, At, B0); PG8_MMA(0, 1, At, B1); PG8_BAR; PG8_SCHED;
            PG8_LDA(At, 0, 1); PG8_STAGE(PG8_SB(0, 0), b2, voffB); PG8_STAGE(PG8_SB(0, 1), b2 + hstepB, voffB); PG8_STAGE(PG8_SA(0, 0), a2, voffA);
            PG8_WAIT_V(8); PG8_WAIT_L(0); PG8_BAR; PG8_MMA(1, 0, At, B0); PG8_MMA(1, 1, At, B1); PG8_BAR; PG8_SCHED;
            PG8_LDB(B0, 1, 0); PG8_LDB(B1, 1, 1); PG8_SCHED; PG8_LDA(At, 1, 0); PG8_STAGE(PG8_SA(0, 1), a2 + hstepA, voffA);
            PG8_WAIT_V(8); PG8_WAIT_L(0); PG8_BAR; PG8_MMA(0, 0, At, B0); PG8_MMA(0, 1, At, B1); PG8_BAR; PG8_SCHED;
            PG8_LDA(At, 1, 1); PG8_STAGE(PG8_SB(1, 0), b3, voffB); PG8_STAGE(PG8_SB(1, 1), b3 + hstepB, voffB); PG8_STAGE(PG8_SA(1, 0), a3, voffA);
            PG8_WAIT_V(8); PG8_WAIT_L(0); PG8_BAR; PG8_MMA(1, 0, At, B0); PG8_MMA(1, 1, At, B1); PG8_BAR; PG8_SCHED;
            } else {
            PG8_LDB(B0, 0, 0); PG8_SCHED; PG8_LDA(At, 0, 0); PG8_STAGE(PG8_SA(1, 1), a1 + hstepA, voffA);
            PG8_WAIT_L(8); PG8_BAR; PG8_WAIT_L(0); PG8_MMA(0, 0, At, B0); PG8_BAR; PG8_SCHED;
            PG8_LDB(B1, 0, 1); PG8_STAGE(PG8_SB(0, 0), b2, voffB);
            PG8_BAR; PG8_WAIT_L(0); PG8_MMA(0, 1, At, B1); PG8_BAR;
            PG8_LDA(At, 0, 1); PG8_STAGE(PG8_SA(0, 0), a2, voffA);
            PG8_BAR; PG8_WAIT_L(0); PG8_MMA(1, 0, At, B0); PG8_BAR; PG8_SCHED;
            PG8_STAGE(PG8_SB(0, 1), b2 + hstepB, voffB);
            PG8_WAIT_V(6); PG8_BAR; PG8_MMA(1, 1, At, B1); PG8_BAR;
            PG8_LDB(B0, 1, 0); PG8_SCHED; PG8_LDA(At, 1, 0); PG8_STAGE(PG8_SA(0, 1), a2 + hstepA, voffA);
            PG8_WAIT_L(8); PG8_BAR; PG8_WAIT_L(0); PG8_MMA(0, 0, At, B0); PG8_BAR; PG8_SCHED;
            PG8_LDB(B1, 1, 1); PG8_STAGE(PG8_SB(1, 0), b3, voffB);
            PG8_BAR; PG8_WAIT_L(0); PG8_MMA(0, 1, At, B1); PG8_BAR;
            PG8_LDA(At, 1, 1); PG8_STAGE(PG8_SA(1, 0), a3, voffA);
            PG8_BAR; PG8_WAIT_L(0); PG8_MMA(1, 0, At, B0); PG8_BAR; PG8_SCHED;
            PG8_STAGE(PG8_SB(1, 1), b3 + hstepB, voffB);
            PG8_WAIT_V(6); PG8_BAR; PG8_MMA(1, 1, At, B1); PG8_BAR;
            }
        }
        if constexpr (ALIGN_EPI) { if (wr == 0) PG8_BAR; }
        if constexpr (!Epi::AFTER_DRAIN) { const int t2_ = ::otid(), l2_ = t2_ & 63, w2_ = __builtin_amdgcn_readfirstlane(t2_ >> 6);
            E(acc, cur, w2_ >> 2, w2_ & 3, l2_ & 15, l2_ >> 4); S.done(cur); }
        if (!has_next) break;
#pragma unroll
        for (int a = 0; a < 2; ++a)
#pragma unroll
            for (int b = 0; b < 2; ++b)
#pragma unroll
                for (int m = 0; m < 4; ++m)
#pragma unroll
                    for (int n = 0; n < 2; ++n) acc[a][b][m][n] = (f32x4){0.f, 0.f, 0.f, 0.f};
        cur = nxt; cA = nA; cB = nB; ++ui;
        if constexpr (ALIGN_EPI) { if (wr == 1) PG8_BAR; }
    }
    PG8_WAIT_V(0);
    if constexpr (!ALIGN_EPI) { if (wr == 0) PG8_BAR; }
    PG8_BAR;
    if constexpr (Epi::AFTER_DRAIN) { E.fused(acc, cur, wr, wc, fr, fq, lds, wid, lane); S.done(cur); }
#undef PG8_SA
#undef PG8_SB
#undef PG8_STAGE
#undef PG8_LDA
#undef PG8_LDB
#undef PG8_MMA
#undef PG8_WAIT_V
#undef PG8_WAIT_L
#undef PG8_BAR
#undef PG8_SCHED
}
typedef int v8i32 __attribute__((ext_vector_type(8)));
typedef int v4i32 __attribute__((ext_vector_type(4)));
template <class Epi, class Sched, bool ALIGN_EPI = false, bool SP2 = false>
__device__ __forceinline__ void gemm_phase_f8(PG8_LAS unsigned char* lds, const Gemm g, const Sched& S, const Epi& E) {
    const int tid = ::otid(), wid = __builtin_amdgcn_readfirstlane(tid >> 6), lane = tid & 63, wr = wid >> 2, wc = wid & 3, fr = lane & 15, fq = lane >> 4;
    const int K = g.K, nt = K / BK; const int lda = g.lda ? g.lda : K, ldb = g.ldb ? g.ldb : K;
    unsigned voffA[2], voffB[2];
#pragma unroll
    for (int i = 0; i < 2; ++i) { int R, C; stage_rc(tid * 16 + i * 8192, R, C); const int Rb = Epi::PERM ? ((R & ~31) + perm32(R & 31)) : R;
        voffA[i] = (unsigned)(R * lda + C) * 2u; voffB[i] = (unsigned)(Rb * ldb + C) * 2u; }
    const size_t kstep = (size_t)(BK * 2);
    const size_t hstepA = (size_t)HALF * lda * 2, hstepB = (size_t)HALF * ldb * 2;
    const size_t tstepA = 2 * hstepA, tstepB = 2 * hstepB;
    const unsigned ldsw = (unsigned)wid * 1024u; const unsigned ldsb32 = (unsigned)(size_t)lds;
    const int aoff = lds_byte(wr * 64 + fr, 16 * (fq & 1)) + (fq >> 1) * 1024, boff = lds_byte(wc * 32 + fr, 16 * (fq & 1)) + (fq >> 1) * 1024;
#define PG8_SA(b, h) (((b) * 2 + (h)) * HTB)
#define PG8_SB(b, h) ((4 + (b) * 2 + (h)) * HTB)
#define PG8_STAGE(bufoff, gbase, voff) do { _Pragma("unroll") for (int _i = 0; _i < 2; ++_i) \
        asm volatile("s_mov_b32 m0, %2\n\tglobal_load_lds_dwordx4 %0, %1" :: "v"((voff)[_i]), "s"((const char*)(gbase)), "s"((unsigned)(ldsb32 + (unsigned)(bufoff) + ldsw + (unsigned)(_i * 8192))) : "memory", "m0"); } while (0)
#define PG8_LDA(dst, b, h) do { _Pragma("unroll") for (int m = 0; m < 4; ++m) { const v4i32 lo_ = *(const PG8_LAS v4i32*)(lds + PG8_SA(b, h) + aoff + m * 2048), hi_ = *(const PG8_LAS v4i32*)(lds + PG8_SA(b, h) + aoff + m * 2048 + 16); dst[m] = __builtin_shufflevector(lo_, hi_, 0, 1, 2, 3, 4, 5, 6, 7); } } while (0)
#define PG8_LDB(dst, b, h) do { _Pragma("unroll") for (int n = 0; n < 2; ++n) { const v4i32 lo_ = *(const PG8_LAS v4i32*)(lds + PG8_SB(b, h) + boff + n * 2048), hi_ = *(const PG8_LAS v4i32*)(lds + PG8_SB(b, h) + boff + n * 2048 + 16); dst[n] = __builtin_shufflevector(lo_, hi_, 0, 1, 2, 3, 4, 5, 6, 7); } } while (0)
#define PG8_MMA(ai, bj, At, Bt) do { __builtin_amdgcn_s_setprio(1); _Pragma("unroll") for (int m = 0; m < 4; ++m) _Pragma("unroll") for (int n = 0; n < 2; ++n) \
        acc[ai][bj][m][n] = __builtin_amdgcn_mfma_scale_f32_16x16x128_f8f6f4(Bt[n], At[m], acc[ai][bj][m][n], 0, 0, 0, 0x7F7F7F7F, 0, 0x7F7F7F7F); \
          \
        asm volatile("" : "+v"(acc[ai][bj][0][0]), "+v"(acc[ai][bj][0][1]), "+v"(acc[ai][bj][1][0]), "+v"(acc[ai][bj][1][1]), "+v"(acc[ai][bj][2][0]), "+v"(acc[ai][bj][2][1]), "+v"(acc[ai][bj][3][0]), "+v"(acc[ai][bj][3][1])); \
        __builtin_amdgcn_s_setprio(0); } while (0)
#define PG8_WAIT_V(n) asm volatile("s_waitcnt vmcnt(" #n ")" ::: "memory")
#define PG8_WAIT_L(n) asm volatile("s_waitcnt lgkmcnt(" #n ")" ::: "memory")
#define PG8_BAR __builtin_amdgcn_s_barrier()
#define PG8_SCHED __builtin_amdgcn_sched_barrier(0)
    Unit cur, nxt; int ui = 0;
    if (!S.next(0, cur)) return;
    f32x4 acc[2][2][4][2];
#pragma unroll
    for (int a = 0; a < 2; ++a)
#pragma unroll
        for (int b = 0; b < 2; ++b)
#pragma unroll
            for (int m = 0; m < 4; ++m)
#pragma unroll
                for (int n = 0; n < 2; ++n) acc[a][b][m][n] = (f32x4){0.f, 0.f, 0.f, 0.f};
    v8i32 At[4], B0[2], B1[2];
    const char* cA = (const char*)g.A + (size_t)cur.pm * tstepA; const char* cB = (const char*)g.Bt + (size_t)cur.pn * tstepB;
    S.a_ready(cur);
    if constexpr (SP2) {
        PG8_STAGE(PG8_SB(0, 0), cB, voffB); PG8_STAGE(PG8_SB(0, 1), cB + hstepB, voffB); PG8_STAGE(PG8_SA(0, 0), cA, voffA); PG8_STAGE(PG8_SA(0, 1), cA + hstepA, voffA);
        if (wr == 1) PG8_BAR;
        PG8_WAIT_V(2); PG8_BAR;
        PG8_STAGE(PG8_SB(1, 0), cB + kstep, voffB); PG8_STAGE(PG8_SA(1, 0), cA + kstep, voffA); PG8_STAGE(PG8_SB(1, 1), cB + hstepB + kstep, voffB);
        PG8_WAIT_V(6); PG8_BAR;
    } else {
        PG8_STAGE(PG8_SB(0, 0), cB, voffB); PG8_STAGE(PG8_SA(0, 0), cA, voffA); PG8_STAGE(PG8_SB(0, 1), cB + hstepB, voffB); PG8_STAGE(PG8_SA(0, 1), cA + hstepA, voffA);
        if (wr == 1) PG8_BAR;
        PG8_WAIT_V(4); PG8_BAR;
        PG8_STAGE(PG8_SB(1, 0), cB + kstep, voffB); PG8_STAGE(PG8_SA(1, 0), cA + kstep, voffA); PG8_STAGE(PG8_SB(1, 1), cB + hstepB + kstep, voffB);
        PG8_WAIT_V(6); PG8_BAR;
    }
    for (;;) {
        const bool has_next = S.next(ui + 1, nxt);
        const char* nA = has_next ? (const char*)g.A + (size_t)nxt.pm * tstepA : cA; const char* nB = has_next ? (const char*)g.Bt + (size_t)nxt.pn * tstepB : cB;
#pragma unroll 1
        for (int t = 0; t < nt; t += 2) {
            const bool last = (t == nt - 2);
            const char* a1 = cA + (size_t)(t + 1) * kstep;
            const char* a2 = last ? nA : cA + (size_t)(t + 2) * kstep; const char* b2 = last ? nB : cB + (size_t)(t + 2) * kstep;
            const char* a3 = a2 + kstep; const char* b3 = b2 + kstep;
            if (last && has_next) S.a_ready(nxt);
            if constexpr (SP2) {
            PG8_LDB(B0, 0, 0); PG8_LDB(B1, 0, 1); PG8_SCHED; PG8_LDA(At, 0, 0); PG8_STAGE(PG8_SA(1, 1), a1 + hstepA, voffA);
            PG8_WAIT_V(8); PG8_WAIT_L(0); PG8_BAR; PG8_MMA(0, 0, At, B0); PG8_MMA(0, 1, At, B1); PG8_BAR; PG8_SCHED;
            PG8_LDA(At, 0, 1); PG8_STAGE(PG8_SB(0, 0), b2, voffB); PG8_STAGE(PG8_SB(0, 1), b2 + hstepB, voffB); PG8_STAGE(PG8_SA(0, 0), a2, voffA);
            PG8_WAIT_V(8); PG8_WAIT_L(0); PG8_BAR; PG8_MMA(1, 0, At, B0); PG8_MMA(1, 1, At, B1); PG8_BAR; PG8_SCHED;
            PG8_LDB(B0, 1, 0); PG8_LDB(B1, 1, 1); PG8_SCHED; PG8_LDA(At, 1, 0); PG8_STAGE(PG8_SA(0, 1), a2 + hstepA, voffA);
            PG8_WAIT_V(8); PG8_WAIT_L(0); PG8_BAR; PG8_MMA(0, 0, At, B0); PG8_MMA(0, 1, At, B1); PG8_BAR; PG8_SCHED;
            PG8_LDA(At, 1, 1); PG8_STAGE(PG8_SB(1, 0), b3, voffB); PG8_STAGE(PG8_SB(1, 1), b3 + hstepB, voffB); PG8_STAGE(PG8_SA(1, 0), a3, voffA);
            PG8_WAIT_V(8); PG8_WAIT_L(0); PG8_BAR; PG8_MMA(1, 0, At, B0); PG8_MMA(1, 1, At, B1); PG8_BAR; PG8_SCHED;
            } else {
            PG8_LDB(B0, 0, 0); PG8_SCHED; PG8_LDA(At, 0, 0); PG8_STAGE(PG8_SA(1, 1), a1 + hstepA, voffA);
            PG8_WAIT_L(8); PG8_BAR; PG8_WAIT_L(0); PG8_MMA(0, 0, At, B0); PG8_BAR; PG8_SCHED;
            PG8_LDB(B1, 0, 1); PG8_STAGE(PG8_SB(0, 0), b2, voffB);
            PG8_BAR; PG8_WAIT_L(0); PG8_MMA(0, 1, At, B1); PG8_BAR;
            PG8_LDA(At, 0, 1); PG8_STAGE(PG8_SA(0, 0), a2, voffA);
            PG8_BAR; PG8_WAIT_L(0); PG8_MMA(1, 0, At, B0); PG8_BAR; PG8_SCHED;
            PG8_STAGE(PG8_SB(0, 1), b2 + hstepB, voffB);
            PG8_WAIT_V(6); PG8_BAR; PG8_MMA(1, 1, At, B1); PG8_BAR;
            PG8_LDB(B0, 1, 0); PG8_SCHED; PG8_LDA(At, 1, 0); PG8_STAGE(PG8_SA(0, 1), a2 + hstepA, voffA);
            PG8_WAIT_L(8); PG8_BAR; PG8_WAIT_L(0); PG8_MMA(0, 0, At, B0); PG8_BAR; PG8_SCHED;
            PG8_LDB(B1, 1, 1); PG8_STAGE(PG8_SB(1, 0), b3, voffB);
            PG8_BAR; PG8_WAIT_L(0); PG8_MMA(0, 1, At, B1); PG8_BAR;
            PG8_LDA(At, 1, 1); PG8_STAGE(PG8_SA(1, 0), a3, voffA);
            PG8_BAR; PG8_WAIT_L(0); PG8_MMA(1, 0, At, B0); PG8_BAR; PG8_SCHED;
            PG8_STAGE(PG8_SB(1, 1), b3 + hstepB, voffB);
            PG8_WAIT_V(6); PG8_BAR; PG8_MMA(1, 1, At, B1); PG8_BAR;
            }
        }
        if constexpr (ALIGN_EPI) { if (wr == 0) PG8_BAR; }
        if constexpr (!Epi::AFTER_DRAIN) { const int t2_ = ::otid(), l2_ = t2_ & 63, w2_ = __builtin_amdgcn_readfirstlane(t2_ >> 6);
            E(acc, cur, w2_ >> 2, w2_ & 3, l2_ & 15, l2_ >> 4); S.done(cur); }
        if (!has_next) break;
#pragma unroll
        for (int a = 0; a < 2; ++a)
#pragma unroll
            for (int b = 0; b < 2; ++b)
#pragma unroll
                for (int m = 0; m < 4; ++m)
#pragma unroll
                    for (int n = 0; n < 2; ++n) acc[a][b][m][n] = (f32x4){0.f, 0.f, 0.f, 0.f};
        cur = nxt; cA = nA; cB = nB; ++ui;
        if constexpr (ALIGN_EPI) { if (wr == 1) PG8_BAR; }
    }
    PG8_WAIT_V(0);
    if constexpr (!ALIGN_EPI) { if (wr == 0) PG8_BAR; }
    PG8_BAR;
    if constexpr (Epi::AFTER_DRAIN) { E.fused(acc, cur, wr, wc, fr, fq, lds, wid, lane); S.done(cur); }
#undef PG8_SA
#undef PG8_SB
#undef PG8_STAGE
#undef PG8_LDA
#undef PG8_LDB
#undef PG8_MMA
#undef PG8_WAIT_V
#undef PG8_WAIT_L
#undef PG8_BAR
#undef PG8_SCHED
}
}

#ifndef PG8_SP2
#define PG8_SP2 true
#endif
#ifndef PG8_ALIGN
#define PG8_ALIGN true
#endif
typedef pg8::bf16_t bf16_t;
__device__ __forceinline__ unsigned f2bf(float f) { return pg8::cvt_pk_bf16(f, f) & 0xffffu; }
__device__ __forceinline__ unsigned pk2(float lo, float hi) { return pg8::cvt_pk_bf16(lo, hi); }
__device__ __forceinline__ float bf2f(unsigned short b) { return __builtin_bit_cast(float, ((unsigned)b) << 16); }
__device__ __forceinline__ unsigned pk4_fp8(float a, float b, float c, float d) { unsigned r = 0; r = __builtin_amdgcn_cvt_pk_fp8_f32(a, b, r, false); r = __builtin_amdgcn_cvt_pk_fp8_f32(c, d, r, true); return r; }

struct EpiF32R {
    static constexpr bool PERM = false, AFTER_DRAIN = false;
    float* C; int ldc; const float* R; int ncols; float* C2; int ldc2; int split; int nN;
    __device__ __forceinline__ void operator()(const pg8::f32x4 (&acc)[2][2][4][2], const pg8::Unit& u, int wr, int wc, int fr, int fq) const {
        const int row0 = u.pm * 256 + wr * 64 + fr, col0 = (nN ? (u.pn % nN) : u.pn) * 256 + wc * 32 + 4 * fq;
#pragma unroll
        for (int ai = 0; ai < 2; ++ai)
#pragma unroll
            for (int m = 0; m < 4; ++m) { const size_t row = (size_t)(row0 + ai * 128 + m * 16);
#pragma unroll
                for (int bj = 0; bj < 2; ++bj)
#pragma unroll
                    for (int n = 0; n < 2; ++n) { const int col = col0 + bj * 128 + n * 16;
                        if (col < ncols) {
                            pg8::f32x4 v = acc[ai][bj][m][n];
                            if (col < split) { if (R) v += *(const pg8::f32x4*)(R + row * ldc + col); *(pg8::f32x4*)(C + row * ldc + col) = v; }
                            else *(pg8::f32x4*)(C2 + row * ldc2 + (col - split)) = v;
                        } } }
    }
};
__device__ __forceinline__ float row_rstd(const float* ssq, int row) {
    const pg8::f32x4* p4 = (const pg8::f32x4*)(ssq + (size_t)row * 16); const pg8::f32x4 a = p4[0], b = p4[1], c = p4[2], d = p4[3];
    const float t = ((a[0] + a[1]) + (a[2] + a[3])) + ((b[0] + b[1]) + (b[2] + b[3])) + ((c[0] + c[1]) + (c[2] + c[3])) + ((d[0] + d[1]) + (d[2] + d[3]));
    return 1.0f / sqrtf(t * (1.0f / 1024.0f) + NORM_EPS);
}
struct EpiSwiGLU {
    static constexpr bool PERM = true, AFTER_DRAIN = false;
    bf16_t* H; int ldh; int nN; int row_shift; const float* ssq;
    __device__ __forceinline__ void operator()(const pg8::f32x4 (&acc)[2][2][4][2], const pg8::Unit& u, int wr, int wc, int fr, int fq) const {
        const int row0 = u.pm * 256 + wr * 64 + fr + row_shift; const int pnl = nN ? (u.pn % nN) : u.pn;
        const int hc0 = (pnl * 256 + wc * 32 + 8 * fq) >> 1;
#pragma unroll
        for (int ai = 0; ai < 2; ++ai)
#pragma unroll
            for (int m = 0; m < 4; ++m) { bf16_t* rowp = H + (size_t)(row0 + ai * 128 + m * 16) * ldh + hc0; const float rs = ssq ? row_rstd(ssq, row0 + ai * 128 + m * 16) : 1.0f;
#pragma unroll
                for (int bj = 0; bj < 2; ++bj) { const pg8::f32x4 g = acc[ai][bj][m][0] * rs, up = acc[ai][bj][m][1] * rs; float o[4];
#pragma unroll
                    for (int j = 0; j < 4; ++j) o[j] = g[j] * __builtin_amdgcn_rcpf(1.0f + __expf(-g[j])) * up[j];
                    uint2 w; w.x = pg8::cvt_pk_bf16(o[0], o[1]); w.y = pg8::cvt_pk_bf16(o[2], o[3]);
                    *(uint2*)(rowp + bj * 64) = w; } }
    }
};
struct EpiBf16P {
    static constexpr bool PERM = true, AFTER_DRAIN = false;
    bf16_t* O; int ldc; int nN; int row_shift; const float* ssq;
    __device__ __forceinline__ void operator()(const pg8::f32x4 (&acc)[2][2][4][2], const pg8::Unit& u, int wr, int wc, int fr, int fq) const {
        const int row0 = u.pm * 256 + wr * 64 + fr + row_shift; const int pnl = nN ? (u.pn % nN) : u.pn;
        const int col0 = pnl * 256 + wc * 32 + 8 * fq;
#pragma unroll
        for (int ai = 0; ai < 2; ++ai)
#pragma unroll
            for (int m = 0; m < 4; ++m) { bf16_t* rowp = O + (size_t)(row0 + ai * 128 + m * 16) * ldc + col0; const float rs = ssq ? row_rstd(ssq, row0 + ai * 128 + m * 16) : 1.0f;
#pragma unroll
                for (int bj = 0; bj < 2; ++bj) { const pg8::f32x4 v0 = acc[ai][bj][m][0] * rs, v1 = acc[ai][bj][m][1] * rs;
                    pg8::u32x4 w; w.x = pg8::cvt_pk_bf16(v0[0], v0[1]); w.y = pg8::cvt_pk_bf16(v0[2], v0[3]); w.z = pg8::cvt_pk_bf16(v1[0], v1[1]); w.w = pg8::cvt_pk_bf16(v1[2], v1[3]);
                    *(pg8::u32x4*)(rowp + bj * 128) = w; } }
    }
};


template <bool HALFN> struct EpiF32S {
    static constexpr bool PERM = false, AFTER_DRAIN = false;
    float* C; int ldc; int nN;
    __device__ __forceinline__ void operator()(const pg8::f32x4 (&acc)[2][2][4][2], const pg8::Unit& u, int wr, int wc, int fr, int fq) const {
        const int row0 = u.pm * 256 + wr * 64 + fr, col0 = (nN ? (u.pn % nN) : u.pn) * 256 + wc * 32 + 4 * fq;
#pragma unroll
        for (int ai = 0; ai < 2; ++ai)
#pragma unroll
            for (int m = 0; m < 4; ++m) { float* rowp = C + (size_t)(row0 + ai * 128 + m * 16) * ldc + col0;
#pragma unroll
                for (int bj = 0; bj < (HALFN ? 1 : 2); ++bj)
#pragma unroll
                    for (int n = 0; n < 2; ++n) *(pg8::f32x4*)(rowp + bj * 128 + n * 16) = acc[ai][bj][m][n]; }
    }
};
struct EpiRes {
    static constexpr bool PERM = false, AFTER_DRAIN = false;
    const float* R32; bf16_t* Hb; float* ssq;
    __device__ __forceinline__ void operator()(const pg8::f32x4 (&acc)[2][2][4][2], const pg8::Unit& u, int wr, int wc, int fr, int fq) const {
        const int row0 = u.pm * 256 + wr * 64 + fr, col0 = u.pn * 256 + wc * 32 + 4 * fq;
#pragma unroll
        for (int ai = 0; ai < 2; ++ai)
#pragma unroll
            for (int m = 0; m < 4; ++m) { const size_t row = (size_t)(row0 + ai * 128 + m * 16); float sq = 0.f;
#pragma unroll
                for (int bj = 0; bj < 2; ++bj)
#pragma unroll
                    for (int n = 0; n < 2; ++n) { const int col = col0 + bj * 128 + n * 16;
                        pg8::f32x4 v = acc[ai][bj][m][n];
                        if (R32) v += *(const pg8::f32x4*)(R32 + row * D + col);
                        else { const uint2 rw = *(const uint2*)(Hb + row * D + col);
                            v[0] += bf2f((unsigned short)(rw.x & 0xffff)); v[1] += bf2f((unsigned short)(rw.x >> 16)); v[2] += bf2f((unsigned short)(rw.y & 0xffff)); v[3] += bf2f((unsigned short)(rw.y >> 16)); }
                        uint2 w; w.x = pg8::cvt_pk_bf16(v[0], v[1]); w.y = pg8::cvt_pk_bf16(v[2], v[3]); *(uint2*)(Hb + row * D + col) = w;
                        sq += (v[0] * v[0] + v[1] * v[1]) + (v[2] * v[2] + v[3] * v[3]); }
                sq += __shfl_xor(sq, 16); sq += __shfl_xor(sq, 32); if (fq == 0) ssq[row * 16 + u.pn * 4 + wc] = sq; }
    }
};
struct EpiGLU {
    static constexpr bool PERM = true, AFTER_DRAIN = false;
    const float* YS; const float* bglu; bf16_t* YMIX;
    __device__ __forceinline__ void operator()(const pg8::f32x4 (&acc)[2][2][4][2], const pg8::Unit& u, int wr, int wc, int fr, int fq) const {
        const int row0 = u.pm * 256 + wr * 64 + fr, col0 = u.pn * 256 + wc * 32 + 8 * fq;
#pragma unroll
        for (int ai = 0; ai < 2; ++ai)
#pragma unroll
            for (int m = 0; m < 4; ++m) { const size_t row = (size_t)(row0 + ai * 128 + m * 16);
#pragma unroll
                for (int bj = 0; bj < 2; ++bj) { const int col = col0 + bj * 128;
                    const pg8::f32x4 y0 = *(const pg8::f32x4*)(YS + row * 512 + col), y1 = *(const pg8::f32x4*)(YS + row * 512 + col + 4);
                    const pg8::f32x4 b0 = *(const pg8::f32x4*)(bglu + col), b1 = *(const pg8::f32x4*)(bglu + col + 4);
                    const pg8::f32x4 a0 = acc[ai][bj][m][0] + b0, a1 = acc[ai][bj][m][1] + b1; float o[8];
#pragma unroll
                    for (int j = 0; j < 4; ++j) { o[j] = y0[j] * __builtin_amdgcn_rcpf(1.0f + __expf(-a0[j])); o[4 + j] = y1[j] * __builtin_amdgcn_rcpf(1.0f + __expf(-a1[j])); }
                    pg8::u32x4 w; w.x = pg8::cvt_pk_bf16(o[0], o[1]); w.y = pg8::cvt_pk_bf16(o[2], o[3]); w.z = pg8::cvt_pk_bf16(o[4], o[5]); w.w = pg8::cvt_pk_bf16(o[6], o[7]);
                    *(pg8::u32x4*)(YMIX + row * 1024 + 512 + col) = w; } }
    }
};

struct EpiQKV {
    static constexpr bool PERM = true, AFTER_DRAIN = false;
    bf16_t* O; const float* ssq; const float* qg; const float* kg;
    __device__ __forceinline__ void operator()(const pg8::f32x4 (&acc)[2][2][4][2], const pg8::Unit& u, int wr, int wc, int fr, int fq) const {
        const int row0 = u.pm * 256 + wr * 64 + fr; const int G = 4 * u.pn + wc;
        const float* gp = G < 16 ? qg : kg; const float post = G < 16 ? 0.125f * 1.4426950408889634f : 1.0f;
        pg8::f32x4 gv[2][2];
#pragma unroll
        for (int bj = 0; bj < 2; ++bj)
#pragma unroll
            for (int n = 0; n < 2; ++n) gv[bj][n] = (G < 32) ? *(const pg8::f32x4*)(gp + 32 * bj + 8 * fq + 4 * n) * post : (pg8::f32x4){1.f, 1.f, 1.f, 1.f};
#pragma unroll
        for (int ai = 0; ai < 2; ++ai)
#pragma unroll
            for (int m = 0; m < 4; ++m) { const int row = row0 + ai * 128 + m * 16; const float rs = row_rstd(ssq, row);
                pg8::f32x4 v[2][2]; float sq = 0.f;
#pragma unroll
                for (int bj = 0; bj < 2; ++bj)
#pragma unroll
                    for (int n = 0; n < 2; ++n) { v[bj][n] = acc[ai][bj][m][n] * rs; sq += (v[bj][n][0] * v[bj][n][0] + v[bj][n][1] * v[bj][n][1]) + (v[bj][n][2] * v[bj][n][2] + v[bj][n][3] * v[bj][n][3]); }
                sq += __shfl_xor(sq, 16); sq += __shfl_xor(sq, 32);
                const float rn = (G < 32) ? frsq(sq * (1.0f / 64.0f) + NORM_EPS) : 1.0f;
                bf16_t* rowp = O + (size_t)row * 3072 + 64 * G + 8 * fq;
#pragma unroll
                for (int bj = 0; bj < 2; ++bj) { const pg8::f32x4 a = v[bj][0] * rn * gv[bj][0], b = v[bj][1] * rn * gv[bj][1];
                    pg8::u32x4 w; w.x = pg8::cvt_pk_bf16(a[0], a[1]); w.y = pg8::cvt_pk_bf16(a[2], a[3]); w.z = pg8::cvt_pk_bf16(b[0], b[1]); w.w = pg8::cvt_pk_bf16(b[2], b[3]);
                    *(pg8::u32x4*)(rowp + 32 * bj) = w; } }
    }
};
struct MoeOrder {
    const int* cnt; int nN, G, c, t_lo, t_hi, pm_base;
    __device__ __forceinline__ bool next(int i, pg8::Unit& u) const {
        int ts[9]; ts[0] = 0;
#pragma unroll
        for (int e = 0; e < 8; ++e) ts[e + 1] = ts[e] + ((__builtin_amdgcn_readfirstlane(cnt[e]) + 255) >> 8);
        const int tend = t_hi < ts[8] ? t_hi : ts[8]; const int nt = tend - t_lo; if (nt <= 0) return false;
        const long L = (long)i * G + c; if (L >= (long)nt * nN) return false;
        const int per = 8 * nN; const int grp = (int)(L / per), r = (int)(L % per);
        const int gt0 = grp * 8; const int gsz = (nt - gt0) < 8 ? (nt - gt0) : 8;
        const int tile = t_lo + gt0 + (r % gsz), pn = r / gsz;
        int e = 0;
#pragma unroll
        for (int j = 1; j < 8; ++j) e += (tile >= ts[j]) ? 1 : 0;
        u.pm = __builtin_amdgcn_readfirstlane(tile - pm_base); u.pn = __builtin_amdgcn_readfirstlane(e * nN + pn); return true;
    }
    __device__ __forceinline__ void a_ready(const pg8::Unit&) const {}
    __device__ __forceinline__ void done(const pg8::Unit&) const {}
};

struct WC { const float* W; int ldw; int K; int ncols; int npad; bf16_t* WT; int rbase; int rs4; int ldt; int koff; int nkt_out; const float* kscale; int qkvmap; };
__device__ __forceinline__ int wc_nblk(const WC& w) { const int nkt = w.ldt ? w.nkt_out : w.K / 64, nnt = (w.npad + 63) / 64; return (nkt >> 1) * (nnt >> 2); }
__device__ __forceinline__ void ph_wconv(const WC w, float* lds, int vb = -1, int vg = 0, int rot = 0) {
    const int TIDX = otid();
    const int lane = TIDX & 63, wave = TIDX >> 6;
    unsigned char* scr = (unsigned char*)lds + wave * 9216;
    const int nwg = vb >= 0 ? vg : (int)gridDim.x; int wgid = (vb >= 0 ? vb : (int)blockIdx.x) - rot; if (wgid < 0) wgid += nwg;
    const int nkt = w.ldt ? w.nkt_out : w.K / 64, nnt = (w.npad + 63) / 64; const int ldt = w.ldt ? w.ldt : w.K;
    const int bk = nkt >> 1, bn = nnt >> 2;
    const int g = lane >> 4, l15 = lane & 15;
    float4 va[8], vb4[8];
#define WCONV_LOAD(bt) do { const int kt_ = 2 * ((bt) % bk) + (wave & 1), nt_ = 4 * ((bt) / bk) + (wave >> 1); const int k0_ = kt_ * 64, ncol_ = nt_ * 64 + 4 * l15; const bool cv_ = ncol_ < w.ncols; \
        const float* wp_ = w.W + (size_t)(k0_ + 2 * g) * w.ldw + ncol_; \
        _Pragma("unroll") for (int j = 0; j < 8; ++j) { va[j] = make_float4(0.f, 0.f, 0.f, 0.f); vb4[j] = va[j]; \
            if (cv_ && k0_ + 8 * j + 2 * g < w.K) va[j] = *(const float4*)(wp_ + (size_t)(8 * j) * w.ldw); \
            if (cv_ && k0_ + 8 * j + 2 * g + 1 < w.K) vb4[j] = *(const float4*)(wp_ + (size_t)(8 * j + 1) * w.ldw); } } while (0)
    int bt = wgid;
    if (bt < bk * bn) WCONV_LOAD(bt);
#pragma unroll 1
    for (; bt < bk * bn; bt += nwg) {
        const int kt = 2 * (bt % bk) + (wave & 1), nt = 4 * (bt / bk) + (wave >> 1); const int k0 = kt * 64, n0 = nt * 64;
#pragma unroll
        for (int j = 0; j < 8; ++j) {
            float4 a = va[j], b = vb4[j];
            if (w.kscale) { const float sa = w.kscale[k0 + 8 * j + 2 * g], sb = w.kscale[k0 + 8 * j + 2 * g + 1]; a.x *= sa; a.y *= sa; a.z *= sa; a.w *= sa; b.x *= sb; b.y *= sb; b.z *= sb; b.w *= sb; }
            const int kb = (8 * j + 2 * g) * 2;
            *(unsigned*)(scr + (4 * l15 + 0) * 144 + kb) = pk2(a.x, b.x);
            *(unsigned*)(scr + (4 * l15 + 1) * 144 + kb) = pk2(a.y, b.y);
            *(unsigned*)(scr + (4 * l15 + 2) * 144 + kb) = pk2(a.z, b.z);
            *(unsigned*)(scr + (4 * l15 + 3) * 144 + kb) = pk2(a.w, b.w);
        }
        if (bt + nwg < bk * bn) WCONV_LOAD(bt + nwg);
        asm volatile("s_waitcnt lgkmcnt(0)" ::: "memory");
#pragma unroll
        for (int i = 0; i < 8; ++i) {
            const int nl = 8 * i + (lane >> 3), ch = lane & 7; const int n = n0 + nl;
            const uint4 v = *(const uint4*)(scr + nl * 144 + ch * 16);
            if (n < w.npad) { int drow = w.rbase + (n >> 2) * w.rs4 + (n & 3); if (w.qkvmap) { const int G_ = n >> 6, d_ = n & 63; drow = 256 * (G_ >> 2) + 128 * (d_ >> 5) + 32 * (G_ & 3) + (d_ & 31); }
                int dk = w.koff + k0; if (dk >= ldt) dk -= ldt; *(uint4*)(w.WT + (size_t)drow * ldt + dk + 8 * ch) = v; }
        }
        asm volatile("s_waitcnt lgkmcnt(0)" ::: "memory");
    }
#undef WCONV_LOAD
}

__device__ __forceinline__ void ph_rmsnorm(const float* __restrict__ x, const float* __restrict__ gain, bf16_t* __restrict__ out, int rows) {
    const int TIDX = otid();
    const int lane = TIDX & 63, wave = TIDX >> 6;
    const int gw = blockIdx.x * 8 + wave, NGW = gridDim.x * 8;
#pragma unroll 2
    for (int r = gw; r < rows; r += NGW) {
        const float4* xr = (const float4*)(x + (size_t)r * D) + lane;
        float4 v[4]; float s = 0.f;
#pragma unroll
        for (int j = 0; j < 4; ++j) { v[j] = xr[64 * j]; s += v[j].x * v[j].x + v[j].y * v[j].y + v[j].z * v[j].z + v[j].w * v[j].w; }
        s = wave_sum(s);
        const float rs = 1.0f / sqrtf(s * (1.0f / D) + NORM_EPS);
        uint2* o = (uint2*)(out + (size_t)r * D) + lane;
#pragma unroll
        for (int j = 0; j < 4; ++j) { const float4 g = ((const float4*)gain)[lane + 64 * j]; uint2 w; w.x = pk2(v[j].x * rs * g.x, v[j].y * rs * g.y); w.y = pk2(v[j].z * rs * g.z, v[j].w * rs * g.w); o[64 * j] = w; }
    }
}

struct GD { const float* A; int lda; const int* arow; const int* mcnt; int M; const float* B; const float* B2; int ldb; int K; int N;
            float* C; int ldc; int mode; const float* R; const float* gw; const int* crow; };
struct RwkvP { const float *mu, *w0, *w_up, *a0, *a_up, *g_up, *k_k, *k_a, *r_k, *ln_w, *ln_b; };
struct S5P { const float *lre, *lim, *ldt, *bre, *bim, *cre, *cim, *dsk; };
struct DAP { const float *lq1, *lk1, *lq2, *lk2, *subg; };
typedef short bf16x8_t __attribute__((ext_vector_type(8)));
typedef short s16x4_t __attribute__((ext_vector_type(4)));
typedef float f32x16_t __attribute__((ext_vector_type(16)));
#define MFMA32(a, b, c) __builtin_amdgcn_mfma_f32_32x32x16_bf16((a), (b), (c), 0, 0, 0)
__device__ __forceinline__ bf16x8_t pack8(float a0, float a1, float a2, float a3, float a4, float a5, float a6, float a7) {
    pg8::u32x4 p; p.x = pg8::cvt_pk_bf16(a0, a1); p.y = pg8::cvt_pk_bf16(a2, a3); p.z = pg8::cvt_pk_bf16(a4, a5); p.w = pg8::cvt_pk_bf16(a6, a7);
    return __builtin_bit_cast(bf16x8_t, p);
}
constexpr int DA_KROW = 144, DA_VROW = 288, DA_KT = 64 * DA_KROW, DA_VT = 64 * DA_VROW, DA_BUF = 2 * DA_KT + DA_VT;
__device__ __forceinline__ void ph_diff_attn_mfma(const bf16_t* __restrict__ QKVb, const DAP p, bf16_t* __restrict__ AO, float* ldsf, unsigned* qctr, const float* __restrict__ qgain, const float* __restrict__ kgain) {
    const int TIDX = otid();
    const int tid = TIDX, lane = tid & 63, wave = __builtin_amdgcn_readfirstlane(tid >> 6);
    const int sub = wave & 3, map = wave >> 2;
    const int r = lane & 31, hh = lane >> 5, blk = (lane >> 4) & 1, i16 = lane & 15, tq = i16 >> 2, tp = i16 & 3;
    unsigned char* lds = (unsigned char*)ldsf;
    float d1 = 0.f, d2 = 0.f;
    for (int i = 0; i < 64; ++i) { d1 += p.lq1[i] * p.lk1[i]; d2 += p.lq2[i] * p.lk2[i]; }
    const float lam = expf(d1) - expf(d2) + LAMBDA_INIT;
    float gqm = 0.f, gkm = 0.f;
    for (int i = 0; i < 64; ++i) { gqm = fmaxf(gqm, fabsf(qgain[i])); gkm = fmaxf(gkm, fabsf(kgain[i])); }
    const float wnum = 2.0f * (8.0f * gqm * gkm * 1.02f) + 8.3178f + 18.0219f;
    const int kr = tid >> 3, c8 = tid & 7;
    volatile int* unit_word = (volatile int*)(lds + 2 * DA_BUF);
#pragma unroll 1
    for (;;) {
        __syncthreads();
        if (tid == 0) *unit_word = (int)atomicAdd(qctr, 1u);
        __syncthreads();
        const int rank = *unit_word;
        if (rank >= NB * 8 * 32) break;
        {
            const int qb = 31 - (rank >> 5); const int bh = rank & 31; const int b = bh >> 3, h = 7 - (bh & 7);
            const float slope = fexp2(-(float)(h + 1));
            const float slope2 = slope * 1.4426950408889634f;
            const float wf = ceilf(wnum / (64.0f * slope)); const int Wh = wf > 64.f ? 64 : (int)wf;
            const int row0 = qb * 128 + sub * 32; const int cq = qb * 2 + (sub >> 1); const int nt = qb * 2 + 2;
            const int t_first = (qb * 2 - Wh) > 0 ? (qb * 2 - Wh) : 0;
            const size_t tokb = (size_t)b * T;
            bf16x8_t qf[4];
            { const bf16_t* qp = QKVb + (tokb + row0 + r) * 3072 + h * 128 + map * 64 + 8 * hh;
#pragma unroll
              for (int s = 0; s < 4; ++s) qf[s] = *(const bf16x8_t*)(qp + 16 * s); }
            const float qpos = (float)(row0 + r);
            f32x16_t O[4];
#pragma unroll
            for (int dt = 0; dt < 4; ++dt)
#pragma unroll
                for (int i = 0; i < 16; ++i) O[dt][i] = 0.f;
            float m = -1e30f, l = 0.f;
            typedef unsigned u32x4b __attribute__((ext_vector_type(4)));
            const __amdgpu_buffer_rsrc_t rsrc = __builtin_amdgcn_make_buffer_rsrc((void*)QKVb, 0, (int)((size_t)M * 3072 * 2), 0x00020000);
            const int voK = (kr * 3072 + h * 128 + c8 * 8 + 1024) * 2, voV0 = ((tid >> 4) * 3072 + 2048 + h * 128 + (tid & 15) * 8) * 2, voV1 = voV0 + 32 * 3072 * 2;
            u32x4b g0, g1, g2, g3;
            { const int so = (int)((tokb + (size_t)t_first * 64) * 3072 * 2);
              g0 = __builtin_amdgcn_raw_buffer_load_b128(rsrc, voK, so, 0); g1 = __builtin_amdgcn_raw_buffer_load_b128(rsrc, voK + 128, so, 0);
              g2 = __builtin_amdgcn_raw_buffer_load_b128(rsrc, voV0, so, 0); g3 = __builtin_amdgcn_raw_buffer_load_b128(rsrc, voV1, so, 0); }
            __syncthreads();
            { unsigned char* bufp = lds + (t_first & 1) * DA_BUF;
              *(u32x4b*)(bufp + kr * DA_KROW + c8 * 16) = g0; *(u32x4b*)(bufp + DA_KT + kr * DA_KROW + c8 * 16) = g1;
              *(u32x4b*)(bufp + 2 * DA_KT + (tid >> 4) * DA_VROW + (tid & 15) * 16) = g2; *(u32x4b*)(bufp + 2 * DA_KT + ((tid + 512) >> 4) * DA_VROW + (tid & 15) * 16) = g3; }
            __syncthreads();
#pragma unroll 1
            for (int t = t_first; t < nt; ++t) {
                const bool more = (t + 1 < nt);
                if (more) { const int so = (int)((tokb + (size_t)(t + 1) * 64) * 3072 * 2);
                    g0 = __builtin_amdgcn_raw_buffer_load_b128(rsrc, voK, so, 0); g1 = __builtin_amdgcn_raw_buffer_load_b128(rsrc, voK + 128, so, 0);
                    g2 = __builtin_amdgcn_raw_buffer_load_b128(rsrc, voV0, so, 0); g3 = __builtin_amdgcn_raw_buffer_load_b128(rsrc, voV1, so, 0); }
                if (t <= cq && t >= cq - Wh) {
                    const unsigned char* bufp = lds + (t & 1) * DA_BUF;
                    const unsigned char* kp = bufp + map * DA_KT + r * DA_KROW + 16 * hh;
                    f32x16_t x0, x1;
#pragma unroll
                    for (int i = 0; i < 16; ++i) { x0[i] = 0.f; x1[i] = 0.f; }
#pragma unroll
                    for (int s = 0; s < 4; ++s) {
                        const bf16x8_t a0 = *(const bf16x8_t*)(kp + 32 * s), a1 = *(const bf16x8_t*)(kp + 32 * DA_KROW + 32 * s);
                        x0 = MFMA32(a0, qf[s], x0); x1 = MFMA32(a1, qf[s], x1);
                    }
                    const float kb0 = (float)(t * 64 + 4 * hh) - qpos;
                    float mx = -1e30f;
#pragma unroll
                    for (int i = 0; i < 16; ++i) {
                        const float dk = kb0 + (float)((i & 3) + 8 * (i >> 2));
                        x0[i] = __builtin_fmaf(-slope2, fabsf(dk), x0[i]);
                        x1[i] = __builtin_fmaf(-slope2, fabsf(dk + 32.f), x1[i]);
                        mx = fmaxf(mx, fmaxf(x0[i], x1[i]));
                    }
                    mx = fmaxf(mx, __shfl_xor(mx, 32));
                    const float mn = fmaxf(m, mx);
                    const float alpha = fexp2(m - mn);
                    m = mn;
                    float rsum = 0.f;
#pragma unroll
                    for (int i = 0; i < 16; ++i) { x0[i] = fexp2(x0[i] - mn); x1[i] = fexp2(x1[i] - mn); rsum += x0[i] + x1[i]; }
                    l = l * alpha + rsum;
                    if (__any(alpha != 1.0f)) {
#pragma unroll
                        for (int dt = 0; dt < 4; ++dt)
#pragma unroll
                            for (int i = 0; i < 16; ++i) O[dt][i] *= alpha;
                    }
                    const bf16x8_t p00 = pack8(x0[0], x0[1], x0[2], x0[3], x0[4], x0[5], x0[6], x0[7]);
                    const bf16x8_t p01 = pack8(x0[8], x0[9], x0[10], x0[11], x0[12], x0[13], x0[14], x0[15]);
                    const bf16x8_t p10 = pack8(x1[0], x1[1], x1[2], x1[3], x1[4], x1[5], x1[6], x1[7]);
                    const bf16x8_t p11 = pack8(x1[8], x1[9], x1[10], x1[11], x1[12], x1[13], x1[14], x1[15]);
                    const unsigned vbase = (unsigned)(size_t)(bufp + 2 * DA_KT) + (unsigned)((4 * hh + tq) * DA_VROW + 32 * blk + 8 * tp);
#define DA_VREAD(va_, A0, A1, A2, A3, A4, A5, A6, A7) asm volatile("ds_read_b64_tr_b16 %0, %8\n\tds_read_b64_tr_b16 %1, %8 offset:%9\n\tds_read_b64_tr_b16 %2, %8 offset:%10\n\tds_read_b64_tr_b16 %3, %8 offset:%11\n\t" \
                                     "ds_read_b64_tr_b16 %4, %8 offset:%12\n\tds_read_b64_tr_b16 %5, %8 offset:%13\n\tds_read_b64_tr_b16 %6, %8 offset:%14\n\tds_read_b64_tr_b16 %7, %8 offset:%15" \
                                     : "=&v"(A0), "=&v"(A1), "=&v"(A2), "=&v"(A3), "=&v"(A4), "=&v"(A5), "=&v"(A6), "=&v"(A7) \
                                     : "v"(va_), "n"(8 * DA_VROW), "n"(16 * DA_VROW), "n"(24 * DA_VROW), "n"(32 * DA_VROW), "n"(40 * DA_VROW), "n"(48 * DA_VROW), "n"(56 * DA_VROW) : "memory")
#define DA_VWAIT(N, A0, A1, A2, A3, A4, A5, A6, A7) asm volatile("s_waitcnt lgkmcnt(" #N ")" : "+v"(A0), "+v"(A1), "+v"(A2), "+v"(A3), "+v"(A4), "+v"(A5), "+v"(A6), "+v"(A7) :: "memory")
#define DA_PV(dt_, A0, A1, A2, A3, A4, A5, A6, A7) do { \
                        const bf16x8_t a00 = __builtin_shufflevector(A0, A1, 0, 1, 2, 3, 4, 5, 6, 7), a01 = __builtin_shufflevector(A2, A3, 0, 1, 2, 3, 4, 5, 6, 7); \
                        const bf16x8_t a10 = __builtin_shufflevector(A4, A5, 0, 1, 2, 3, 4, 5, 6, 7), a11 = __builtin_shufflevector(A6, A7, 0, 1, 2, 3, 4, 5, 6, 7); \
                        O[dt_] = MFMA32(a00, p00, O[dt_]); O[dt_] = MFMA32(a01, p01, O[dt_]); O[dt_] = MFMA32(a10, p10, O[dt_]); O[dt_] = MFMA32(a11, p11, O[dt_]); } while (0)
                    {
                        s16x4_t e0, e1, e2, e3, e4, e5, e6, e7, f0, f1, f2, f3, f4, f5, f6, f7;
                        DA_VREAD(vbase, e0, e1, e2, e3, e4, e5, e6, e7);
                        DA_VREAD(vbase + 64, f0, f1, f2, f3, f4, f5, f6, f7);
                        DA_VWAIT(8, e0, e1, e2, e3, e4, e5, e6, e7);
                        DA_PV(0, e0, e1, e2, e3, e4, e5, e6, e7);
                        DA_VREAD(vbase + 128, e0, e1, e2, e3, e4, e5, e6, e7);
                        DA_VWAIT(8, f0, f1, f2, f3, f4, f5, f6, f7);
                        DA_PV(1, f0, f1, f2, f3, f4, f5, f6, f7);
                        DA_VREAD(vbase + 192, f0, f1, f2, f3, f4, f5, f6, f7);
                        DA_VWAIT(8, e0, e1, e2, e3, e4, e5, e6, e7);
                        DA_PV(2, e0, e1, e2, e3, e4, e5, e6, e7);
                        DA_VWAIT(0, f0, f1, f2, f3, f4, f5, f6, f7);
                        DA_PV(3, f0, f1, f2, f3, f4, f5, f6, f7);
                    }
                }
                if (more) { unsigned char* bufp = lds + ((t + 1) & 1) * DA_BUF;
                    *(u32x4b*)(bufp + kr * DA_KROW + c8 * 16) = g0; *(u32x4b*)(bufp + DA_KT + kr * DA_KROW + c8 * 16) = g1;
                    *(u32x4b*)(bufp + 2 * DA_KT + (tid >> 4) * DA_VROW + (tid & 15) * 16) = g2; *(u32x4b*)(bufp + 2 * DA_KT + ((tid + 512) >> 4) * DA_VROW + (tid & 15) * 16) = g3; }
                __syncthreads();
            }
            const float lt = l + __shfl_xor(l, 32); const float inv = 1.0f / lt;
            float* xch = ldsf + (size_t)sub * 4096;
            if (map == 1) {
#pragma unroll
                for (int dt = 0; dt < 4; ++dt)
#pragma unroll
                    for (int i = 0; i < 16; ++i) xch[(dt * 16 + i) * 64 + lane] = O[dt][i] * inv;
            }
            __syncthreads();
            if (map == 0) {
                float ss = 0.f;
#pragma unroll
                for (int dt = 0; dt < 4; ++dt)
#pragma unroll
                    for (int i = 0; i < 16; ++i) { const float o = O[dt][i] * inv - lam * xch[(dt * 16 + i) * 64 + lane]; O[dt][i] = o; ss += o * o; }
                ss += __shfl_xor(ss, 32);
                const float rs = (1.0f / sqrtf(ss * (1.0f / 128.0f) + NORM_EPS)) * (1.0f - LAMBDA_INIT);
                bf16_t* op = AO + (tokb + row0 + r) * 1024 + h * 128;
#pragma unroll
                for (int dt = 0; dt < 4; ++dt)
#pragma unroll
                    for (int gq = 0; gq < 4; ++gq) { const int dim = dt * 32 + 8 * gq + 4 * hh; const float4 sg = *(const float4*)(p.subg + dim);
                        uint2 w; w.x = pk2(O[dt][4 * gq] * rs * sg.x, O[dt][4 * gq + 1] * rs * sg.y); w.y = pk2(O[dt][4 * gq + 2] * rs * sg.z, O[dt][4 * gq + 3] * rs * sg.w);
                        *(uint2*)(op + dim) = w; }
            }
        }
    }
    __syncthreads();
}


struct RwkvChunkBufs { bf16_t* AR; bf16_t* BKh; bf16_t* VT; bf16_t* MK; bf16_t* MB; bf16_t* IT; float* bL; };
struct RwkvOps { bf16x8_t ar0, ar1, ar2, ar3, mk, it, mb, bb0, bk0, bb1, bk1, vt; };
__device__ __forceinline__ void ph_knorm_bf16(bf16_t* __restrict__ KVb, const float* __restrict__ kg, const float* __restrict__ qg, int vb, int vg) {
    const int TIDX = otid();
    const int lane = TIDX & 63, wave = TIDX >> 6;
    if (vb < 0) return;
    const int gw = vb * 8 + wave, NGW = vg * 8;
    for (int row = gw; row < NB * MEML; row += NGW) {
        uint4* rowp = (uint4*)(KVb + (size_t)row * 2048);
#pragma unroll
        for (int j = 0; j < 2; ++j) {
            const int ch = lane + 64 * j;
            const uint4 v = rowp[ch];
            const unsigned w[4] = {v.x, v.y, v.z, v.w}; float f[8]; float ss = 0.f;
#pragma unroll
            for (int q = 0; q < 4; ++q) { f[2 * q] = bf2f((unsigned short)(w[q] & 0xffff)); f[2 * q + 1] = bf2f((unsigned short)(w[q] >> 16)); ss += f[2 * q] * f[2 * q] + f[2 * q + 1] * f[2 * q + 1]; }
            ss += __shfl_xor(ss, 1); ss += __shfl_xor(ss, 2); ss += __shfl_xor(ss, 4); ss += __shfl_xor(ss, 8); ss += __shfl_xor(ss, 16);
            const float rs = 1.0f / sqrtf(ss * (1.0f / 256.0f) + NORM_EPS);
            const int d0 = (ch & 31) * 8;
            const float4 k0 = *(const float4*)(kg + d0), k1 = *(const float4*)(kg + d0 + 4), q0 = *(const float4*)(qg + d0), q1 = *(const float4*)(qg + d0 + 4);
            uint4 o; o.x = pk2(f[0] * rs * k0.x * q0.x, f[1] * rs * k0.y * q0.y); o.y = pk2(f[2] * rs * k0.z * q0.z, f[3] * rs * k0.w * q0.w);
            o.z = pk2(f[4] * rs * k1.x * q1.x, f[5] * rs * k1.y * q1.y); o.w = pk2(f[6] * rs * k1.z * q1.z, f[7] * rs * k1.w * q1.w);
            rowp[ch] = o;
        }
    }
}
constexpr int MA_KROW = 528, MA_VROW = 544, MA_KT = 64 * MA_KROW, MA_VT = 64 * MA_VROW;
__device__ __forceinline__ void ph_mem_attn_mfma(const bf16_t* __restrict__ Qb, const bf16_t* __restrict__ KVb, bf16_t* __restrict__ AO, float* ldsf, int u0) {
    const int TIDX = otid();
    const int tid = TIDX, lane = tid & 63, wave = __builtin_amdgcn_readfirstlane(tid >> 6);
    const int sub = wave & 3, dh = wave >> 2;
    const int r = lane & 31, hh = lane >> 5, blk = (lane >> 4) & 1, i16 = lane & 15, tq = i16 >> 2, tp = i16 & 3;
    unsigned char* lds = (unsigned char*)ldsf;
    typedef unsigned u32x4b __attribute__((ext_vector_type(4)));
    const __amdgpu_buffer_rsrc_t rsrc = __builtin_amdgcn_make_buffer_rsrc((void*)KVb, 0, NB * MEML * 2048 * 2, 0x00020000);
#pragma unroll 1
    for (int unit = u0; unit < u0 + 2; ++unit) {
        const int b = unit >> 7, head = (unit >> 5) & 3, qb = unit & 31;
        const int row0 = qb * 128 + sub * 32; const size_t tok = (size_t)b * T + row0 + r;
        bf16x8_t qf[16]; float ss = 0.f;
        { const bf16_t* qp = Qb + tok * 1024 + head * 256 + 8 * hh;
#pragma unroll
          for (int s = 0; s < 16; ++s) { qf[s] = *(const bf16x8_t*)(qp + 16 * s);
#pragma unroll
              for (int j = 0; j < 8; ++j) { const float f = bf2f((unsigned short)qf[s][j]); ss += f * f; } } }
        ss += __shfl_xor(ss, 32);
        const float rq = (1.0f / sqrtf(ss * (1.0f / 256.0f) + NORM_EPS)) * 0.0625f * 1.4426950408889634f;
        f32x16_t O[4];
#pragma unroll
        for (int dt = 0; dt < 4; ++dt)
#pragma unroll
            for (int i = 0; i < 16; ++i) O[dt][i] = 0.f;
        float m = -1e30f, l = 0.f;
        u32x4b g[8];
        const int vo = ((tid >> 5) * 2048 + head * 256 + (tid & 31) * 8) * 2;
#pragma unroll 1
        for (int kt = 0; kt < 4; ++kt) {
            { const int so = (b * MEML + kt * 64) * 2048 * 2;
#pragma unroll
              for (int j = 0; j < 4; ++j) { g[j] = __builtin_amdgcn_raw_buffer_load_b128(rsrc, vo + j * 16 * 4096, so, 0); g[4 + j] = __builtin_amdgcn_raw_buffer_load_b128(rsrc, vo + j * 16 * 4096 + 2048, so, 0); } }
            __syncthreads();
#pragma unroll
            for (int j = 0; j < 4; ++j) { *(u32x4b*)(lds + ((tid >> 5) + 16 * j) * MA_KROW + (tid & 31) * 16) = g[j]; *(u32x4b*)(lds + MA_KT + ((tid >> 5) + 16 * j) * MA_VROW + (tid & 31) * 16) = g[4 + j]; }
            __syncthreads();
            const unsigned char* kp = lds + r * MA_KROW + 16 * hh;
            f32x16_t x0, x1;
#pragma unroll
            for (int i = 0; i < 16; ++i) { x0[i] = 0.f; x1[i] = 0.f; }
#pragma unroll
            for (int s = 0; s < 16; ++s) {
                const bf16x8_t a0 = *(const bf16x8_t*)(kp + 32 * s), a1 = *(const bf16x8_t*)(kp + 32 * MA_KROW + 32 * s);
                x0 = MFMA32(a0, qf[s], x0); x1 = MFMA32(a1, qf[s], x1);
            }
            float mx = -1e30f;
#pragma unroll
            for (int i = 0; i < 16; ++i) { x0[i] *= rq; x1[i] *= rq; mx = fmaxf(mx, fmaxf(x0[i], x1[i])); }
            mx = fmaxf(mx, __shfl_xor(mx, 32));
            const float mn = fmaxf(m, mx); const float alpha = fexp2(m - mn); m = mn;
            float rsum = 0.f;
#pragma unroll
            for (int i = 0; i < 16; ++i) { x0[i] = fexp2(x0[i] - mn); x1[i] = fexp2(x1[i] - mn); rsum += x0[i] + x1[i]; }
            l = l * alpha + rsum;
            if (__any(alpha != 1.0f)) {
#pragma unroll
                for (int dt = 0; dt < 4; ++dt)
#pragma unroll
                    for (int i = 0; i < 16; ++i) O[dt][i] *= alpha;
            }
            const bf16x8_t p00 = pack8(x0[0], x0[1], x0[2], x0[3], x0[4], x0[5], x0[6], x0[7]);
            const bf16x8_t p01 = pack8(x0[8], x0[9], x0[10], x0[11], x0[12], x0[13], x0[14], x0[15]);
            const bf16x8_t p10 = pack8(x1[0], x1[1], x1[2], x1[3], x1[4], x1[5], x1[6], x1[7]);
            const bf16x8_t p11 = pack8(x1[8], x1[9], x1[10], x1[11], x1[12], x1[13], x1[14], x1[15]);
            const unsigned vbase = (unsigned)(size_t)(lds + MA_KT) + (unsigned)((4 * hh + tq) * MA_VROW + dh * 256 + 32 * blk + 8 * tp);
#pragma unroll
            for (int dt = 0; dt < 4; ++dt) {
                s16x4_t v0, v1, v2, v3, v4, v5, v6, v7;
                const unsigned va = vbase + dt * 64;
                asm volatile("ds_read_b64_tr_b16 %0, %8\n\tds_read_b64_tr_b16 %1, %8 offset:%9\n\tds_read_b64_tr_b16 %2, %8 offset:%10\n\tds_read_b64_tr_b16 %3, %8 offset:%11\n\t"
                             "ds_read_b64_tr_b16 %4, %8 offset:%12\n\tds_read_b64_tr_b16 %5, %8 offset:%13\n\tds_read_b64_tr_b16 %6, %8 offset:%14\n\tds_read_b64_tr_b16 %7, %8 offset:%15\n\ts_waitcnt lgkmcnt(0)"
                             : "=&v"(v0), "=&v"(v1), "=&v"(v2), "=&v"(v3), "=&v"(v4), "=&v"(v5), "=&v"(v6), "=&v"(v7)
                             : "v"(va), "n"(8 * MA_VROW), "n"(16 * MA_VROW), "n"(24 * MA_VROW), "n"(32 * MA_VROW), "n"(40 * MA_VROW), "n"(48 * MA_VROW), "n"(56 * MA_VROW) : "memory");
                const bf16x8_t a00 = __builtin_shufflevector(v0, v1, 0, 1, 2, 3, 4, 5, 6, 7), a01 = __builtin_shufflevector(v2, v3, 0, 1, 2, 3, 4, 5, 6, 7);
                const bf16x8_t a10 = __builtin_shufflevector(v4, v5, 0, 1, 2, 3, 4, 5, 6, 7), a11 = __builtin_shufflevector(v6, v7, 0, 1, 2, 3, 4, 5, 6, 7);
                O[dt] = MFMA32(a00, p00, O[dt]); O[dt] = MFMA32(a01, p01, O[dt]); O[dt] = MFMA32(a10, p10, O[dt]); O[dt] = MFMA32(a11, p11, O[dt]);
            }
        }
        const float lt = l + __shfl_xor(l, 32); const float inv = 1.0f / lt;
        bf16_t* op = AO + tok * 1024 + head * 256 + dh * 128;
#pragma unroll
        for (int dt = 0; dt < 4; ++dt)
#pragma unroll
            for (int gq = 0; gq < 4; ++gq) { const int dim = dt * 32 + 8 * gq + 4 * hh;
                uint2 w; w.x = pk2(O[dt][4 * gq] * inv, O[dt][4 * gq + 1] * inv); w.y = pk2(O[dt][4 * gq + 2] * inv, O[dt][4 * gq + 3] * inv);
                *(uint2*)(op + dim) = w; }
    }
    __syncthreads();
}


__device__ __forceinline__ void ph_lora_in(const bf16_t* __restrict__ ZA, const float* __restrict__ mu, bf16_t* __restrict__ LA, int vb, int vg) {
    const int TIDX = otid();
    const size_t n = (size_t)M * 384;
    if (vb < 0) return;
    for (size_t i = (size_t)vb * NTHR + TIDX; i < n; i += (size_t)vg * NTHR) {
        const int tok = (int)(i / 384), c = (int)(i % 384);
        float val = 0.f;
        if (c < 288) {
            const float cur = bf2f(ZA[(size_t)tok * RCOLS + 1536 + c]); const float prev = (tok % T) ? bf2f(ZA[(size_t)(tok - 1) * RCOLS + 1536 + c]) : 0.f;
            const float m = cur + (prev - cur) * mu[1536 + c];
            val = c < 64 ? ftanh(m) : (c < 128 ? m : fsigmoid(m));
        }
        LA[i] = (bf16_t)f2bf(val);
    }
}
__device__ __forceinline__ void ph_rwkv_chunk_prep2(const bf16_t* __restrict__ ZA, const bf16_t* __restrict__ LORA, const RwkvP p, const RwkvChunkBufs cb, bf16_t* __restrict__ BON, float* ldsf) {
    const int TIDX = otid();
    const int lane = TIDX & 63, wave = __builtin_amdgcn_readfirstlane(TIDX >> 6);
    const int r = lane & 31, hh = lane >> 5;
    unsigned char* scr = (unsigned char*)ldsf + wave * 10240;
    unsigned char* ARs = scr; unsigned char* BKs = scr + 4608; float* Mf = (float*)(scr + 9216);
    const int gw = blockIdx.x * 8 + wave, NGW = gridDim.x * 8;
    const int pos = (lane & ~15) + 8 * ((lane >> 2) & 1) + (lane & 3) + 4 * ((lane >> 3) & 1);
    unsigned short zr[17], zk[17], zv[17], lw[16], la[16];
#define R1_LOAD(chx) do { const int bh_ = (chx) >> 8, c_ = (chx) & 255; const int col_ = (bh_ & 7) * 64 + lane; const size_t tok0_ = (size_t)(bh_ >> 3) * T + c_ * 16; \
        zr[0] = 0; zk[0] = 0; zv[0] = 0; \
        if (c_ > 0) { const bf16_t* zp_ = ZA + (tok0_ - 1) * RCOLS + col_; zr[0] = zp_[0]; zk[0] = zp_[512]; zv[0] = zp_[1024]; } \
        _Pragma("unroll") for (int t = 0; t < 16; ++t) { const bf16_t* z_ = ZA + (tok0_ + t) * RCOLS + col_; const bf16_t* lo_ = LORA + (tok0_ + t) * 1536 + col_; \
            zr[t + 1] = z_[0]; zk[t + 1] = z_[512]; zv[t + 1] = z_[1024]; lw[t] = lo_[0]; la[t] = lo_[512]; } } while (0)
    if (gw < NB * 8 * 256) R1_LOAD(gw);
#pragma unroll 1
    for (int ch = gw; ch < NB * 8 * 256; ch += NGW) {
        const int bh = ch >> 8, c = ch & 255; const int b = bh >> 3, h = bh & 7; const int col = h * 64 + lane;
        const float mu_r = p.mu[col], mu_k = p.mu[512 + col], mu_v = p.mu[1024 + col], w0 = p.w0[col], a0 = p.a0[col], k_k = p.k_k[col], k_a = p.k_a[col], r_k = p.r_k[col];
        const size_t tok0 = (size_t)b * T + c * 16;
        float at[16], rt[16], bt[16], kt[16], vv[16]; float bcum = 1.0f;
        float pr = bf2f(zr[0]), pk = bf2f(zk[0]), pv = bf2f(zv[0]);
        float rr[16], kk2[16], vraw[16], wp[16], ap[16];
#pragma unroll
        for (int t = 0; t < 16; ++t) { const float cr = bf2f(zr[t + 1]), ck = bf2f(zk[t + 1]), cv = bf2f(zv[t + 1]);
            rr[t] = cr + (pr - cr) * mu_r; kk2[t] = ck + (pk - ck) * mu_k; vraw[t] = cv + (pv - cv) * mu_v; pr = cr; pk = ck; pv = cv; wp[t] = w0 + bf2f(lw[t]); ap[t] = a0 + bf2f(la[t]); }
        if (ch + NGW < NB * 8 * 256) R1_LOAD(ch + NGW);
#pragma unroll
        for (int t = 0; t < 16; ++t) {
            const float r_ = rr[t], k_ = kk2[t], v_ = vraw[t];
            const float wpre = wp[t], apre = ap[t];
            const float kkr = k_ * k_k; const float ss = wave_sum_dpp(kkr * kkr);
            const float kkv = kkr * frsq(fmaxf(ss, 1e-24f));
            const float a = fsigmoid(apre); const float kmod = k_ * (1.0f + (a - 1.0f) * k_a);
            const float w = fexp(-fexp(-fsoftplus(-wpre) - 0.5f));
            const float bon = wave_sum_dpp(r_ * kmod * r_k) * v_;
            BON[(tok0 + t) * 512 + col] = (bf16_t)f2bf(bon);
            const float ka = kkv * a;
            vv[t] = v_; at[t] = -bcum * kkv; bcum *= w; rt[t] = bcum * r_; const float ib = frcp(bcum); bt[t] = ka * ib; kt[t] = kmod * ib;
        }
        const float bL = bcum;
#pragma unroll
        for (int t = 0; t < 16; ++t) {
            *(bf16_t*)(ARs + t * 144 + pos * 2) = (bf16_t)f2bf(at[t]); *(bf16_t*)(ARs + (16 + t) * 144 + pos * 2) = (bf16_t)f2bf(rt[t]);
            *(bf16_t*)(BKs + t * 144 + pos * 2) = (bf16_t)f2bf(bt[t]); *(bf16_t*)(BKs + (16 + t) * 144 + pos * 2) = (bf16_t)f2bf(kt[t]);
        }
        asm volatile("s_waitcnt lgkmcnt(0)" ::: "memory");
        f32x16_t x;
#pragma unroll
        for (int i = 0; i < 16; ++i) x[i] = 0.f;
#pragma unroll
        for (int ks = 0; ks < 4; ++ks) {
            const bf16x8_t a = *(const bf16x8_t*)(BKs + r * 144 + ks * 32 + hh * 16), bq = *(const bf16x8_t*)(ARs + r * 144 + ks * 32 + hh * 16);
            x = MFMA32(a, bq, x);
        }
#pragma unroll
        for (int j = 0; j < 8; ++j) { const int sidx = (j & 3) + 8 * (j >> 2) + 4 * hh; const bool keep = (r < 16) ? (sidx < r) : (sidx <= r - 16);
            x[j] = keep ? x[j] : 0.f; x[8 + j] = keep ? x[8 + j] : 0.f; }
        *(bf16x8_t*)(cb.MK + (size_t)ch * 512 + r * 16 + hh * 8) = pack8(x[8], x[9], x[10], x[11], x[12], x[13], x[14], x[15]);
        if (r >= 16) *(bf16x8_t*)(cb.MB + (size_t)ch * 256 + (r - 16) * 16 + hh * 8) = pack8(x[0], x[1], x[2], x[3], x[4], x[5], x[6], x[7]);
        else {
#pragma unroll
            for (int j = 0; j < 8; ++j) Mf[((j & 3) + 8 * (j >> 2) + 4 * hh) * 16 + r] = x[j];
        }
#pragma unroll
        for (int i = 0; i < 4; ++i) { const int q = lane + 64 * i; *(uint4*)((unsigned char*)cb.AR + (size_t)ch * 4096 + q * 16) = *(const uint4*)(ARs + (q >> 3) * 144 + (q & 7) * 16); }
        { bf16_t* bk = cb.BKh + (size_t)ch * 2048 + lane * 32;
#pragma unroll
          for (int hp = 0; hp < 2; ++hp) {
              *(bf16x8_t*)(bk + hp * 8) = pack8(bL * bt[4 * hp], bL * bt[4 * hp + 1], bL * bt[4 * hp + 2], bL * bt[4 * hp + 3], bL * bt[8 + 4 * hp], bL * bt[9 + 4 * hp], bL * bt[10 + 4 * hp], bL * bt[11 + 4 * hp]);
              *(bf16x8_t*)(bk + 16 + hp * 8) = pack8(bL * kt[4 * hp], bL * kt[4 * hp + 1], bL * kt[4 * hp + 2], bL * kt[4 * hp + 3], bL * kt[8 + 4 * hp], bL * kt[9 + 4 * hp], bL * kt[10 + 4 * hp], bL * kt[11 + 4 * hp]);
              *(bf16x8_t*)(cb.VT + (size_t)ch * 1024 + lane * 16 + hp * 8) = pack8(vv[4 * hp], vv[4 * hp + 1], vv[4 * hp + 2], vv[4 * hp + 3], vv[8 + 4 * hp], vv[9 + 4 * hp], vv[10 + 4 * hp], vv[11 + 4 * hp]);
          } }
        cb.bL[(size_t)ch * 64 + lane] = bL;
        asm volatile("s_waitcnt lgkmcnt(0)" ::: "memory");
        if (lane < 16) {
            float inv[16];
#pragma unroll
            for (int q = 0; q < 16; ++q) inv[q] = (q == lane) ? 1.0f : 0.0f;
#pragma unroll
            for (int q = 14; q >= 0; --q) { float acc = 0.f;
#pragma unroll
                for (int j = q + 1; j < 16; ++j) acc += Mf[q * 16 + j] * inv[j];
                inv[q] += acc; }
            bf16_t* ip = cb.IT + (size_t)ch * 256 + lane * 16;
            *(bf16x8_t*)(ip) = pack8(inv[0], inv[1], inv[2], inv[3], inv[8], inv[9], inv[10], inv[11]);
            *(bf16x8_t*)(ip + 8) = pack8(inv[4], inv[5], inv[6], inv[7], inv[12], inv[13], inv[14], inv[15]);
        }
        asm volatile("s_waitcnt lgkmcnt(0)" ::: "memory");
    }
}
#undef R1_LOAD
__device__ __forceinline__ void ph_rwkv_fin2(const float* __restrict__ O, const bf16_t* __restrict__ LORA, const bf16_t* __restrict__ BON, const float* __restrict__ ln_w, const float* __restrict__ ln_b, bf16_t* __restrict__ YMIX) {
    const int TIDX = otid();
    const int c = TIDX;
#pragma unroll 4
    for (int tok = blockIdx.x; tok < M; tok += gridDim.x) {
        const size_t o = (size_t)tok * 512 + c;
        const float v = O[o];
        const float mean = wave_sum_dpp(v) * (1.0f / 64.0f);
        const float d = v - mean;
        const float var = wave_sum_dpp(d * d) * (1.0f / 64.0f);
        const float on = d * frsq(var + 64e-5f);
        YMIX[(size_t)tok * 1024 + c] = (bf16_t)f2bf((on * ln_w[c] + ln_b[c] + bf2f(BON[o])) * bf2f(LORA[(size_t)tok * 1536 + 1024 + c]));
    }
}
constexpr int S5L = 32, S5NC = M / S5L;
struct EpiZ {
    static constexpr bool PERM = false, AFTER_DRAIN = false;
    bf16_t* ZA; bf16_t* UGX;
    __device__ __forceinline__ void operator()(const pg8::f32x4 (&acc)[2][2][4][2], const pg8::Unit& u, int wr, int wc, int fr, int fq) const {
        const int row0 = u.pm * 256 + wr * 64 + fr, col0 = u.pn * 256 + wc * 32 + 4 * fq;
#pragma unroll
        for (int ai = 0; ai < 2; ++ai)
#pragma unroll
            for (int m = 0; m < 4; ++m) { const int row = row0 + ai * 128 + m * 16;
#pragma unroll
                for (int bj = 0; bj < 2; ++bj)
#pragma unroll
                    for (int n = 0; n < 2; ++n) { const int col = col0 + bj * 128 + n * 16; const pg8::f32x4 v = acc[ai][bj][m][n];
                        if (col < RCOLS) { uint2 w; w.x = pg8::cvt_pk_bf16(v[0], v[1]); w.y = pg8::cvt_pk_bf16(v[2], v[3]); *(uint2*)(ZA + (size_t)row * RCOLS + col) = w; }
                        else if (col < INCOLS) { const int cc = col - RCOLS; const int g = cc >> 4, i = cc & 15;
                            uint2 w; w.x = pg8::cvt_pk_bf16(v[0], v[1]); w.y = pg8::cvt_pk_bf16(v[2], v[3]);
                            *(uint2*)(UGX + ((size_t)(g * S5NC + (row >> 5)) * 640 + (row & 31) * 16 + i)) = w; } } }
    }
};
struct EpiS5Y {
    static constexpr bool PERM = false, AFTER_DRAIN = false;
    const bf16_t* UGX; const float* dsk; float* YS; bf16_t* YSb;
    __device__ __forceinline__ void operator()(const pg8::f32x4 (&acc)[2][2][4][2], const pg8::Unit& u, int wr, int wc, int fr, int fq) const {
        const int g = u.pn >> 1; const int row0 = u.pm * 256 + wr * 64 + fr, col0 = (u.pn & 1) * 256 + wc * 32 + 4 * fq;
#pragma unroll
        for (int ai = 0; ai < 2; ++ai)
#pragma unroll
            for (int m = 0; m < 4; ++m) { const int R = row0 + ai * 128 + m * 16; const int chunk = R & (S5NC - 1);
#pragma unroll
                for (int bj = 0; bj < 2; ++bj)
#pragma unroll
                    for (int n = 0; n < 2; ++n) { const int col = col0 + bj * 128 + n * 16; const int t = col >> 4, j = col & 15; const pg8::f32x4 v = acc[ai][bj][m][n];
                        const uint2 uw = *(const uint2*)(UGX + (size_t)R * 640 + col);
                        const pg8::f32x4 dv = *(const pg8::f32x4*)(dsk + g * 16 + j);
                        pg8::f32x4 y;
                        y[0] = gelu_tanh(v[0] + dv[0] * bf2f((unsigned short)(uw.x & 0xffff))); y[1] = gelu_tanh(v[1] + dv[1] * bf2f((unsigned short)(uw.x >> 16)));
                        y[2] = gelu_tanh(v[2] + dv[2] * bf2f((unsigned short)(uw.y & 0xffff))); y[3] = gelu_tanh(v[3] + dv[3] * bf2f((unsigned short)(uw.y >> 16)));
                        const size_t o = (size_t)(chunk * S5L + t) * 512 + g * 16 + j;
                        *(pg8::f32x4*)(YS + o) = y;
                        uint2 w; w.x = pg8::cvt_pk_bf16(y[0], y[1]); w.y = pg8::cvt_pk_bf16(y[2], y[3]); *(uint2*)(YSb + o) = w; } }
    }
};
struct GroupOrder {
    int nm, nn, ng, G, c;
    __device__ __forceinline__ bool next(int i, pg8::Unit& u) const {
        if (c < 0) return false;
        const long L = (long)i * G + c; if (L >= (long)ng * nm * nn) return false;
        const int per = nm * nn; const int g = (int)(L / per), rem = (int)(L % per);
        u.pm = g * nm + rem / nn; u.pn = g * nn + rem % nn; return true;
    }
    __device__ __forceinline__ void a_ready(const pg8::Unit&) const {}
    __device__ __forceinline__ void done(const pg8::Unit&) const {}
};
__device__ __forceinline__ void ph_s5_mats(const S5P p, bf16_t* __restrict__ TE, bf16_t* __restrict__ TF, float* ldsf) {
    const int TIDX = otid();
    const int tid = TIDX;
    float* pwr = ldsf;
    float* pwi = pwr + 33 * 64;
    float* bbr = pwi + 33 * 64;
    float* bbi = bbr + 1024;
    float* crs = bbi + 1024;
    float* cis = crs + 1024;
    float* kt = cis + 1024;
#pragma unroll 1
    for (int item = blockIdx.x; item < 256; item += gridDim.x) {
        const int g = item >> 3, part = item & 7;
        __syncthreads();
        const float dt = expf(p.ldt[g]);
        for (int idx = tid; idx < 33 * 64; idx += NTHR) { const int n = idx >> 6, pp = idx & 63;
            const float are = p.lre[g * 64 + pp], aim = p.lim[g * 64 + pp];
            const float mag = expf((float)n * are * dt); float sn, cs; sincosf((float)n * aim * dt, &sn, &cs);
            pwr[idx] = mag * cs; pwi[idx] = mag * sn; }
        for (int idx = tid; idx < 1024; idx += NTHR) { const int pp = idx >> 4, i = idx & 15;
            const float are = p.lre[g * 64 + pp], aim = p.lim[g * 64 + pp];
            const float mag = expf(are * dt); float sn, cs; sincosf(aim * dt, &sn, &cs);
            const float nr_ = mag * cs - 1.0f, ni_ = mag * sn; const float den = are * are + aim * aim;
            const float cr_ = (nr_ * are + ni_ * aim) / den, ci_ = (ni_ * are - nr_ * aim) / den;
            const float br = p.bre[(g * 64 + pp) * 16 + i], bi = p.bim[(g * 64 + pp) * 16 + i];
            bbr[idx] = cr_ * br - ci_ * bi; bbi[idx] = cr_ * bi + ci_ * br;
            crs[idx] = p.cre[(size_t)g * 1024 + idx]; cis[idx] = p.cim[(size_t)g * 1024 + idx]; }
        __syncthreads();
        for (int idx = tid; idx < 4 * 256; idx += NTHR) { const int tau = 4 * part + (idx >> 8), j = (idx >> 4) & 15, i = idx & 15; float acc = 0.f;
#pragma unroll 4
            for (int pp = 0; pp < 64; ++pp) { const float pr = pwr[tau * 64 + pp], pi = pwi[tau * 64 + pp], br = bbr[pp * 16 + i], bi = bbi[pp * 16 + i];
                const float gr = pr * br - pi * bi, gi = pr * bi + pi * br; acc += crs[j * 64 + pp] * gr - cis[j * 64 + pp] * gi; }
            kt[idx] = acc; }
        __syncthreads();
        for (int q = tid; q < 8 * 32 * 32; q += NTHR) { const int lg = q >> 10, t = (q >> 5) & 31, j = (q >> 1) & 15, hf = q & 1; int sidx; float v[8];
            if (lg < 4) { sidx = t - (4 * part + lg);
#pragma unroll
                for (int e = 0; e < 8; ++e) v[e] = kt[(lg * 16 + j) * 16 + hf * 8 + e]; }
            else { sidx = t + 4 * part + (lg - 4) + 1;
#pragma unroll
                for (int e = 0; e < 8; ++e) v[e] = 0.f; }
            if (sidx >= 0 && sidx < 32) { uint4 o; o.x = pk2(v[0], v[1]); o.y = pk2(v[2], v[3]); o.z = pk2(v[4], v[5]); o.w = pk2(v[6], v[7]);
                *(uint4*)(TF + ((size_t)g * 512 + t * 16 + j) * 640 + sidx * 16 + hf * 8) = o; } }
        for (int q = tid; q < 64 * 16; q += NTHR) { const int row = part * 64 + (q >> 4), c8 = 64 + (q & 15); const int t = row >> 4, j = row & 15; float v[8];
            { const int n0 = (c8 - 64) * 8;
#pragma unroll
                for (int e = 0; e < 8; ++e) { const int n = n0 + e; const int pp = n & 63; const float cr = crs[j * 64 + pp], ci = cis[j * 64 + pp], pr = pwr[(t + 1) * 64 + pp], pi = pwi[(t + 1) * 64 + pp];
                    v[e] = (n < 64) ? (cr * pr - ci * pi) : -(cr * pi + ci * pr); } }
            uint4 o; o.x = pk2(v[0], v[1]); o.y = pk2(v[2], v[3]); o.z = pk2(v[4], v[5]); o.w = pk2(v[6], v[7]);
            *(uint4*)(TF + ((size_t)g * 512 + row) * 640 + c8 * 8) = o; }
        for (int q = tid; q < 32 * 64; q += NTHR) { const int n = part * 32 + (q >> 6), c8 = q & 63; const int sidx = c8 >> 1, i0 = (c8 & 1) * 8; float v[8];
#pragma unroll
            for (int e = 0; e < 8; ++e) { float val = 0.f;
                if (n < 128) { const int pp = n & 63; const float pr = pwr[(S5L - 1 - sidx) * 64 + pp], pi = pwi[(S5L - 1 - sidx) * 64 + pp], br = bbr[pp * 16 + i0 + e], bi = bbi[pp * 16 + i0 + e];
                    val = (n < 64) ? (pr * br - pi * bi) : (pr * bi + pi * br); }
                v[e] = val; }
            uint4 o; o.x = pk2(v[0], v[1]); o.y = pk2(v[2], v[3]); o.z = pk2(v[4], v[5]); o.w = pk2(v[6], v[7]);
            *(uint4*)(TE + ((size_t)g * 256 + n) * 512 + c8 * 8) = o; }
    }
    __syncthreads();
}
__device__ __forceinline__ void ph_s5_state(const S5P p, const float* __restrict__ XLOC, bf16_t* __restrict__ UGX, int blk0) {
    const int TIDX = otid();
    const int lane = TIDX & 63, wave = TIDX >> 6;
    const int vb = ((int)blockIdx.x + (int)gridDim.x - (blk0 % (int)gridDim.x)) % (int)gridDim.x;
    const int gw = vb * 8 + wave, NGW = gridDim.x * 8;
    for (int it = gw; it < NB * 32; it += NGW) {
        const int b = it >> 5, g = it & 31;
        const float are = p.lre[g * 64 + lane], aim = p.lim[g * 64 + lane]; const float dt = expf(p.ldt[g]);
        const float mag = expf((float)S5L * are * dt); float sn, cs; sincosf((float)S5L * aim * dt, &sn, &cs);
        const float lr = mag * cs, li = mag * sn;
        float xr = 0.f, xi = 0.f;
        const size_t row0 = (size_t)g * S5NC + b * (T / S5L);
#pragma unroll 4
        for (int c = 0; c < T / S5L; ++c) {
            UGX[(row0 + c) * 640 + 512 + lane] = (bf16_t)f2bf(xr); UGX[(row0 + c) * 640 + 576 + lane] = (bf16_t)f2bf(xi);
            const float ar = XLOC[(row0 + c) * 128 + lane], ai = XLOC[(row0 + c) * 128 + 64 + lane];
            const float nxr = lr * xr - li * xi + ar, nxi = lr * xi + li * xr + ai; xr = nxr; xi = nxi;
        }
    }
}


constexpr int R2_SLOT = 11520, R2_WAVE = 4 * R2_SLOT;
constexpr int R2_HALF = 128, R2_WGS = 96;
__device__ __forceinline__ void ph_rwkv_chunk_scan3(const RwkvChunkBufs cb, float* __restrict__ O, bf16_t* __restrict__ CP, bf16_t* __restrict__ SSTt, unsigned* flags, unsigned* barw, float* ldsf,
                                                    const bf16_t* __restrict__ LORA, const bf16_t* __restrict__ BON, const float* __restrict__ ln_w, const float* __restrict__ ln_b, bf16_t* __restrict__ YMIX, unsigned* othersdone, unsigned nothers) {
    const int TIDX = otid();
    const int lane = TIDX & 63, wave = __builtin_amdgcn_readfirstlane(TIDX >> 6);
    if ((int)blockIdx.x >= R2_WGS) return;
    const int role = (int)blockIdx.x >> 5, bh = (int)blockIdx.x & 31;
    const int b = bh >> 3, h = bh & 7;
    const int r = lane & 31, hh = lane >> 5;
    if (wave < 2) {
        const int vt = wave;
        LAS unsigned char* ldsw = (LAS unsigned char*)((LAS unsigned char*)ldsf + wave * R2_WAVE);
        const unsigned char* ldsg = (const unsigned char*)ldsf + wave * R2_WAVE;
#define R2_DMA16(gp, off) __builtin_amdgcn_global_load_lds((const unsigned*)(gp), (LAS unsigned*)(ldsw + (off)), 16, 0, 0)
#define R2_ISSUE(chx, slot) do { const size_t ch_ = (size_t)(chx); const int sb_ = (slot) * R2_SLOT; \
        const unsigned char* ar_ = (const unsigned char*)cb.AR + ch_ * 4096 + r * 128 + hh * 16; \
        R2_DMA16(ar_, sb_); R2_DMA16(ar_ + 32, sb_ + 1024); R2_DMA16(ar_ + 64, sb_ + 2048); R2_DMA16(ar_ + 96, sb_ + 3072); \
        R2_DMA16((const unsigned char*)cb.MK + ch_ * 1024 + r * 32 + hh * 16, sb_ + 4096); \
        R2_DMA16((r < 16) ? ((const unsigned char*)cb.IT + ch_ * 512 + r * 32 + hh * 16) : ((const unsigned char*)cb.MB + ch_ * 512 + (r - 16) * 32 + hh * 16), sb_ + 5120); \
        const unsigned char* bk_ = (const unsigned char*)cb.BKh + ch_ * 4096 + r * 64 + hh * 16; \
        R2_DMA16(bk_, sb_ + 6144); R2_DMA16(bk_ + 32, sb_ + 7168); R2_DMA16(bk_ + 2048, sb_ + 8192); R2_DMA16(bk_ + 2048 + 32, sb_ + 9216); \
        R2_DMA16((const unsigned char*)cb.VT + ch_ * 2048 + (32 * vt + r) * 32 + hh * 16, sb_ + 10240); \
        __builtin_amdgcn_global_load_lds((const unsigned*)(cb.bL + ch_ * 64 + lane), (LAS unsigned*)(ldsw + sb_ + 11264), 4, 0, 0); } while (0)
        f32x16_t S0, S1;
#pragma unroll
        for (int i = 0; i < 16; ++i) { const bool dg = (role == 2) && (((i & 3) + 8 * (i >> 2) + 4 * hh) == r); S0[i] = (dg && vt == 0) ? 1.f : 0.f; S1[i] = (dg && vt == 1) ? 1.f : 0.f; }
        const int cbeg = role ? R2_HALF : 0;
        const int ch0 = bh * 256 + cbeg;
        R2_ISSUE(ch0, 0); R2_ISSUE(ch0 + 1, 1); R2_ISSUE(ch0 + 2, 2);
#pragma unroll 1
        for (int c = 0; c < R2_HALF; ++c) {
            asm volatile("s_waitcnt vmcnt(24)" ::: "memory");
            const unsigned char* sp = ldsg + (c & 3) * R2_SLOT + lane * 16;
            RwkvOps cur;
            cur.ar0 = *(const bf16x8_t*)(sp); cur.ar1 = *(const bf16x8_t*)(sp + 1024); cur.ar2 = *(const bf16x8_t*)(sp + 2048); cur.ar3 = *(const bf16x8_t*)(sp + 3072);
            cur.mk = *(const bf16x8_t*)(sp + 4096);
            { const bf16x8_t v = *(const bf16x8_t*)(sp + 5120); const bf16x8_t z = {0, 0, 0, 0, 0, 0, 0, 0}; cur.it = (r < 16) ? v : z; cur.mb = (r < 16) ? z : v; }
            cur.bb0 = *(const bf16x8_t*)(sp + 6144); cur.bk0 = *(const bf16x8_t*)(sp + 7168); cur.bb1 = *(const bf16x8_t*)(sp + 8192); cur.bk1 = *(const bf16x8_t*)(sp + 9216);
            { const bf16x8_t v = *(const bf16x8_t*)(sp + 10240); const bf16x8_t z = {0, 0, 0, 0, 0, 0, 0, 0}; cur.vt = (role == 2) ? z : v; }
            float4 bl[8];
            { const unsigned char* bp = ldsg + (c & 3) * R2_SLOT + 11264 + 16 * hh;
#pragma unroll
              for (int g = 0; g < 8; ++g) bl[g] = *(const float4*)(bp + 32 * g); }
            asm volatile("s_waitcnt lgkmcnt(0)" ::: "memory");
            if (c + 3 < R2_HALF) R2_ISSUE(ch0 + c + 3, (c + 3) & 3);
            else { R2_ISSUE(ch0 + c, (c + 3) & 3); }
            const bf16x8_t s00 = pack8(S0[0], S0[1], S0[2], S0[3], S0[4], S0[5], S0[6], S0[7]), s01 = pack8(S0[8], S0[9], S0[10], S0[11], S0[12], S0[13], S0[14], S0[15]);
            const bf16x8_t s10 = pack8(S1[0], S1[1], S1[2], S1[3], S1[4], S1[5], S1[6], S1[7]), s11 = pack8(S1[8], S1[9], S1[10], S1[11], S1[12], S1[13], S1[14], S1[15]);
            f32x16_t Ya, Yb;
#pragma unroll
            for (int i = 0; i < 16; ++i) { Ya[i] = 0.f; Yb[i] = 0.f; }
            Ya = MFMA32(cur.ar0, s00, Ya); Yb = MFMA32(cur.ar2, s10, Yb);
            Ya = MFMA32(cur.ar1, s01, Ya); Yb = MFMA32(cur.ar3, s11, Yb);
            Ya = MFMA32(cur.mk, cur.vt, Ya);
#pragma unroll
            for (int i = 0; i < 16; ++i) Ya[i] += Yb[i];
            const bf16x8_t rhs = pack8(Ya[0], Ya[1], Ya[2], Ya[3], Ya[4], Ya[5], Ya[6], Ya[7]);
            f32x16_t Ut;
#pragma unroll
            for (int i = 0; i < 16; ++i) Ut[i] = 0.f;
            Ut = MFMA32(cur.it, rhs, Ut);
            const bf16x8_t uf = pack8(Ut[0], Ut[1], Ut[2], Ut[3], Ut[4], Ut[5], Ut[6], Ut[7]);
#pragma unroll
            for (int g = 0; g < 4; ++g) {
                S0[4 * g] *= bl[g].x; S0[4 * g + 1] *= bl[g].y; S0[4 * g + 2] *= bl[g].z; S0[4 * g + 3] *= bl[g].w;
                S1[4 * g] *= bl[4 + g].x; S1[4 * g + 1] *= bl[4 + g].y; S1[4 * g + 2] *= bl[4 + g].z; S1[4 * g + 3] *= bl[4 + g].w;
            }
            S0 = MFMA32(cur.bb0, uf, S0); S1 = MFMA32(cur.bb1, uf, S1);
            S0 = MFMA32(cur.bk0, cur.vt, S0); S1 = MFMA32(cur.bk1, cur.vt, S1);
            Ya = MFMA32(cur.mb, uf, Ya);
            if (role == 2) {
                bf16_t* cp = CP + ((size_t)bh * (R2_HALF * 16) + c * 16) * 64 + 32 * vt + r;
#pragma unroll
                for (int j = 0; j < 8; ++j) cp[(size_t)((j & 3) + 8 * (j >> 2) + 4 * hh) * 64] = (bf16_t)f2bf(Ya[8 + j]);
            } else {
                float* op = O + ((size_t)b * T + (cbeg + c) * 16) * 512 + h * 64 + 32 * vt + r;
#pragma unroll
                for (int j = 0; j < 8; ++j) op[(size_t)((j & 3) + 8 * (j >> 2) + 4 * hh) * 512] = Ya[8 + j];
            }
        }
        if (role == 0) {
            bf16_t* st = SSTt + ((size_t)bh * 64 + 32 * vt + r) * 64 + 4 * hh;
#pragma unroll
            for (int g = 0; g < 4; ++g) {
                uint2 w0, w1; w0.x = pg8::cvt_pk_bf16(S0[4 * g], S0[4 * g + 1]); w0.y = pg8::cvt_pk_bf16(S0[4 * g + 2], S0[4 * g + 3]);
                w1.x = pg8::cvt_pk_bf16(S1[4 * g], S1[4 * g + 1]); w1.y = pg8::cvt_pk_bf16(S1[4 * g + 2], S1[4 * g + 3]);
                *(uint2*)(st + 8 * g) = w0; *(uint2*)(st + 32 + 8 * g) = w1;
            }
        }
        asm volatile("s_waitcnt vmcnt(0)" ::: "memory");
#undef R2_ISSUE
#undef R2_DMA16
    }
    __syncthreads();
    if (threadIdx.x == 0) {
        __builtin_amdgcn_fence(__ATOMIC_RELEASE, "agent");
        asm volatile("s_waitcnt vmcnt(0)" ::: "memory");
        (void)xb_add(&flags[bh * 16], 1u);
        if (role) { __builtin_amdgcn_fence(__ATOMIC_ACQUIRE, "agent"); asm volatile("s_waitcnt vmcnt(0)" ::: "memory"); XB_SPIN(xb_ld(&flags[bh * 16]) < 3u, barw); }
    }
    __syncthreads();
    if (role) {
#pragma unroll 1
        for (int q = wave; q < 32; q += 8) {
            const int tb = (role - 1) * 32 + q;
            const bf16_t* ap = CP + ((size_t)bh * (R2_HALF * 16) + tb * 32 + r) * 64 + 8 * hh;
            const bf16x8_t a0 = *(const bf16x8_t*)(ap), a1 = *(const bf16x8_t*)(ap + 16), a2 = *(const bf16x8_t*)(ap + 32), a3 = *(const bf16x8_t*)(ap + 48);
#pragma unroll
            for (int nb = 0; nb < 2; ++nb) {
                const bf16_t* bp = SSTt + ((size_t)bh * 64 + 32 * nb + r) * 64 + 8 * hh;
                f32x16_t acc;
#pragma unroll
                for (int i = 0; i < 16; ++i) acc[i] = 0.f;
                acc = MFMA32(a0, *(const bf16x8_t*)(bp), acc); acc = MFMA32(a1, *(const bf16x8_t*)(bp + 16), acc);
                acc = MFMA32(a2, *(const bf16x8_t*)(bp + 32), acc); acc = MFMA32(a3, *(const bf16x8_t*)(bp + 48), acc);
                float* op = O + ((size_t)b * T + R2_HALF * 16 + tb * 32) * 512 + h * 64 + 32 * nb + r;
#pragma unroll
                for (int i = 0; i < 16; ++i) { float* o1 = op + (size_t)((i & 3) + 8 * (i >> 2) + 4 * hh) * 512; *o1 = *o1 + acc[i]; }
            }
        }
    }
    asm volatile("s_waitcnt vmcnt(0)" ::: "memory");
    __syncthreads();
    if (threadIdx.x == 0) { XB_SPIN(xb_ld(othersdone) < nothers, barw); }
    __syncthreads();
    {
        const int t0 = role == 0 ? 0 : (R2_HALF * 16 + (role - 1) * 1024), ntok = role == 0 ? R2_HALF * 16 : 1024;
        const int tq = lane >> 4, l = lane & 15; const int colb = h * 64 + 4 * l;
        const float4 lw = *(const float4*)(ln_w + colb), lb = *(const float4*)(ln_b + colb);
#pragma unroll 2
        for (int tt = wave * 4; tt < ntok; tt += 32) {
            const size_t tok = (size_t)b * T + t0 + tt + tq;
            const float4 o = *(const float4*)(O + tok * 512 + colb);
            const uint2 bw = *(const uint2*)(BON + tok * 512 + colb), gw = *(const uint2*)(LORA + tok * 1536 + 1024 + colb);
            const float mean = row_sum_dpp((o.x + o.y) + (o.z + o.w)) * (1.0f / 64.0f);
            const float d0 = o.x - mean, d1 = o.y - mean, d2 = o.z - mean, d3 = o.w - mean;
            const float var = row_sum_dpp((d0 * d0 + d1 * d1) + (d2 * d2 + d3 * d3)) * (1.0f / 64.0f);
            const float rs = frsq(var + 64e-5f);
            const float y0 = (d0 * rs * lw.x + lb.x + bf2f((unsigned short)(bw.x & 0xffff))) * bf2f((unsigned short)(gw.x & 0xffff));
            const float y1 = (d1 * rs * lw.y + lb.y + bf2f((unsigned short)(bw.x >> 16))) * bf2f((unsigned short)(gw.x >> 16));
            const float y2 = (d2 * rs * lw.z + lb.z + bf2f((unsigned short)(bw.y & 0xffff))) * bf2f((unsigned short)(gw.y & 0xffff));
            const float y3 = (d3 * rs * lw.w + lb.w + bf2f((unsigned short)(bw.y >> 16))) * bf2f((unsigned short)(gw.y >> 16));
            uint2 w; w.x = pg8::cvt_pk_bf16(y0, y1); w.y = pg8::cvt_pk_bf16(y2, y3);
            *(uint2*)(YMIX + tok * 1024 + colb) = w;
        }
    }
}

__device__ __forceinline__ void ph_router(const bf16_t* __restrict__ x, const float* __restrict__ gain, const float* __restrict__ wr, const float* __restrict__ br, unsigned char* __restrict__ HN, int* __restrict__ tok_e, float* __restrict__ tok_w, int* __restrict__ bcnt, float* ldsf) {
    const int TIDX = otid();
    const int lane = TIDX & 63, wave = TIDX >> 6;
    volatile int* hist = (volatile int*)ldsf;
    if (TIDX < 8) hist[TIDX] = 0;
    __syncthreads();
    const int TPB = (M + (int)gridDim.x - 1) / (int)gridDim.x; const int t_beg = (int)blockIdx.x * TPB, t_end = (t_beg + TPB) < M ? (t_beg + TPB) : M;
#pragma unroll 2
    for (int r = t_beg + wave; r < t_end; r += 8) {
        const uint2* xr = (const uint2*)(x + (size_t)r * D) + lane;
        float4 v[4]; float s = 0.f;
#pragma unroll
        for (int j = 0; j < 4; ++j) { const uint2 w = xr[64 * j]; v[j] = make_float4(bf2f((unsigned short)(w.x & 0xffff)), bf2f((unsigned short)(w.x >> 16)), bf2f((unsigned short)(w.y & 0xffff)), bf2f((unsigned short)(w.y >> 16)));
            s += v[j].x * v[j].x + v[j].y * v[j].y + v[j].z * v[j].z + v[j].w * v[j].w; }
        s = wave_sum(s);
        const float rs = 1.0f / sqrtf(s * (1.0f / D) + NORM_EPS);
        float lg[8];
#pragma unroll
        for (int e = 0; e < 8; ++e) lg[e] = 0.f;
        unsigned* o = (unsigned*)(HN + (size_t)r * D) + lane;
#pragma unroll
        for (int j = 0; j < 4; ++j) {
            const float4 g = ((const float4*)gain)[lane + 64 * j];
            const float4 hn = make_float4(v[j].x * rs * g.x, v[j].y * rs * g.y, v[j].z * rs * g.z, v[j].w * rs * g.w);
            o[64 * j] = pk4_fp8(hn.x, hn.y, hn.z, hn.w);
            const int d0 = 4 * (lane + 64 * j);
            const float hv[4] = {hn.x, hn.y, hn.z, hn.w};
#pragma unroll
            for (int i = 0; i < 4; ++i) {
                const float4 w0 = *(const float4*)(wr + (size_t)(d0 + i) * 8), w1 = *(const float4*)(wr + (size_t)(d0 + i) * 8 + 4);
                lg[0] += hv[i] * w0.x; lg[1] += hv[i] * w0.y; lg[2] += hv[i] * w0.z; lg[3] += hv[i] * w0.w;
                lg[4] += hv[i] * w1.x; lg[5] += hv[i] * w1.y; lg[6] += hv[i] * w1.z; lg[7] += hv[i] * w1.w;
            }
        }
#pragma unroll
        for (int e = 0; e < 8; ++e) lg[e] = wave_sum(lg[e]) + br[e];
        if (lane == 0) {
            int i1 = 0; float l1 = lg[0];
#pragma unroll
            for (int e = 1; e < 8; ++e) if (lg[e] > l1) { l1 = lg[e]; i1 = e; }
            int i2 = -1; float l2 = -3.0e38f;
#pragma unroll
            for (int e = 0; e < 8; ++e) if (e != i1 && lg[e] > l2) { l2 = lg[e]; i2 = e; }
            if (i2 < 0) { i2 = (i1 + 1) & 7; l2 = l1; }
            const float ex = expf(l2 - l1); const float w1 = 1.0f / (1.0f + ex);
            tok_e[r * 2] = i1; tok_e[r * 2 + 1] = i2; tok_w[r * 2] = w1; tok_w[r * 2 + 1] = ex * w1;
            atomicAdd((int*)&hist[i1], 1); atomicAdd((int*)&hist[i2], 1);
        }
    }
    __syncthreads();
    if (TIDX < 8) bcnt[blockIdx.x * 8 + TIDX] = hist[TIDX];
}
__device__ __forceinline__ void moe_prefix(const int* cnt, int (&ts)[9]) {
    ts[0] = 0;
#pragma unroll
    for (int e = 0; e < NEXP; ++e) ts[e + 1] = ts[e] + ((__builtin_amdgcn_readfirstlane(cnt[e]) + 255) >> 8);
}
__device__ __forceinline__ void ph_moe_combine(const bf16_t* __restrict__ Y, const int* __restrict__ tokpos, const float* __restrict__ tok_w, const bf16_t* __restrict__ Hb, float* __restrict__ out) {
    const int TIDX = otid();
    const int lane = TIDX & 63, wave = TIDX >> 6;
    const int gw = blockIdx.x * 8 + wave, NGW = gridDim.x * 8;
#pragma unroll 2
    for (int tok = gw; tok < M; tok += NGW) {
        const int p0 = tokpos[tok * 2], p1 = tokpos[tok * 2 + 1]; const float w0 = tok_w[tok * 2], w1 = tok_w[tok * 2 + 1];
        const uint4* y0 = (const uint4*)(Y + (size_t)p0 * D); const uint4* y1 = (const uint4*)(Y + (size_t)p1 * D); const uint4* hr = (const uint4*)(Hb + (size_t)tok * D);
        float4* op = (float4*)(out + (size_t)tok * D);
#pragma unroll
        for (int j = 0; j < 2; ++j) {
            const uint4 a = y0[lane + 64 * j], b = y1[lane + 64 * j], hv = hr[lane + 64 * j];
            const unsigned aw[4] = {a.x, a.y, a.z, a.w}, bw[4] = {b.x, b.y, b.z, b.w}, hw[4] = {hv.x, hv.y, hv.z, hv.w};
#pragma unroll
            for (int q = 0; q < 2; ++q) {
                const unsigned a0 = aw[2 * q], a1 = aw[2 * q + 1], b0 = bw[2 * q], b1 = bw[2 * q + 1], h0 = hw[2 * q], h1 = hw[2 * q + 1];
                float4 o;
                o.x = bf2f((unsigned short)(h0 & 0xffff)) + w0 * bf2f((unsigned short)(a0 & 0xffff)) + w1 * bf2f((unsigned short)(b0 & 0xffff));
                o.y = bf2f((unsigned short)(h0 >> 16)) + w0 * bf2f((unsigned short)(a0 >> 16)) + w1 * bf2f((unsigned short)(b0 >> 16));
                o.z = bf2f((unsigned short)(h1 & 0xffff)) + w0 * bf2f((unsigned short)(a1 & 0xffff)) + w1 * bf2f((unsigned short)(b1 & 0xffff));
                o.w = bf2f((unsigned short)(h1 >> 16)) + w0 * bf2f((unsigned short)(a1 >> 16)) + w1 * bf2f((unsigned short)(b1 >> 16));
                op[(lane + 64 * j) * 2 + q] = o;
            }
        }
    }
}


constexpr float W8_SCALE = 64.0f, W8_INV = 1.0f / 64.0f;
struct WC8 { const float* W; int ldw; int K; int ncols; unsigned char* WT; int rbase; int rs4; };
__device__ __forceinline__ void ph_wconv8(const WC8 w, float* lds, int vb, int vg, int rot) {
    const int TIDX = otid();
    const int lane = TIDX & 63, wave = TIDX >> 6;
    unsigned char* scr = (unsigned char*)lds + wave * 9216;
    const int nwg = vb >= 0 ? vg : (int)gridDim.x; int wgid = (vb >= 0 ? vb : (int)blockIdx.x) - rot; if (wgid < 0) wgid += nwg;
    const int nkt = w.K / 64, nnt = w.ncols / 64; const int bk = nkt >> 1, bn = nnt >> 2;
    const int g = lane >> 4, l15 = lane & 15;
    float4 v[4][4];
#define WC8_LOAD(bt) do { const int kt_ = 2 * ((bt) % bk) + (wave & 1), nt_ = 4 * ((bt) / bk) + (wave >> 1); \
        const float* wp_ = w.W + (size_t)(kt_ * 64 + 4 * g) * w.ldw + nt_ * 64 + 4 * l15; \
        _Pragma("unroll") for (int j = 0; j < 4; ++j) _Pragma("unroll") for (int q = 0; q < 4; ++q) v[j][q] = *(const float4*)(wp_ + (size_t)(16 * j + q) * w.ldw); } while (0)
    int bt = wgid;
    if (bt < bk * bn) WC8_LOAD(bt);
#pragma unroll 1
    for (; bt < bk * bn; bt += nwg) {
        const int kt = 2 * (bt % bk) + (wave & 1), nt = 4 * (bt / bk) + (wave >> 1); const int k0 = kt * 64, n0 = nt * 64;
#pragma unroll
        for (int j = 0; j < 4; ++j) { const int kb = 16 * j + 4 * g;
            *(unsigned*)(scr + (4 * l15 + 0) * 80 + kb) = pk4_fp8(v[j][0].x * W8_SCALE, v[j][1].x * W8_SCALE, v[j][2].x * W8_SCALE, v[j][3].x * W8_SCALE);
            *(unsigned*)(scr + (4 * l15 + 1) * 80 + kb) = pk4_fp8(v[j][0].y * W8_SCALE, v[j][1].y * W8_SCALE, v[j][2].y * W8_SCALE, v[j][3].y * W8_SCALE);
            *(unsigned*)(scr + (4 * l15 + 2) * 80 + kb) = pk4_fp8(v[j][0].z * W8_SCALE, v[j][1].z * W8_SCALE, v[j][2].z * W8_SCALE, v[j][3].z * W8_SCALE);
            *(unsigned*)(scr + (4 * l15 + 3) * 80 + kb) = pk4_fp8(v[j][0].w * W8_SCALE, v[j][1].w * W8_SCALE, v[j][2].w * W8_SCALE, v[j][3].w * W8_SCALE); }
        if (bt + nwg < bk * bn) WC8_LOAD(bt + nwg);
        asm volatile("s_waitcnt lgkmcnt(0)" ::: "memory");
#pragma unroll
        for (int i = 0; i < 4; ++i) { const int q = lane + 64 * i; const int nl = q >> 2, ch = q & 3; const int n = n0 + nl;
            const uint4 o = *(const uint4*)(scr + nl * 80 + ch * 16);
            const int drow = w.rbase + (n >> 2) * w.rs4 + (n & 3); *(uint4*)(w.WT + (size_t)drow * w.K + k0 + 16 * ch) = o; }
        asm volatile("s_waitcnt lgkmcnt(0)" ::: "memory");
    }
#undef WC8_LOAD
}
struct EpiSwiGLU8 {
    static constexpr bool PERM = true, AFTER_DRAIN = false;
    unsigned char* H; int ldh; int nN;
    __device__ __forceinline__ void operator()(const pg8::f32x4 (&acc)[2][2][4][2], const pg8::Unit& u, int wr, int wc, int fr, int fq) const {
        const int row0 = u.pm * 256 + wr * 64 + fr; const int pnl = u.pn % nN;
        const int hc0 = (pnl * 256 + wc * 32 + 8 * fq) >> 1;
#pragma unroll
        for (int ai = 0; ai < 2; ++ai)
#pragma unroll
            for (int m = 0; m < 4; ++m) { unsigned char* rowp = H + (size_t)(row0 + ai * 128 + m * 16) * ldh + hc0;
#pragma unroll
                for (int bj = 0; bj < 2; ++bj) { const pg8::f32x4 g = acc[ai][bj][m][0] * W8_INV, up = acc[ai][bj][m][1] * W8_INV; float o[4];
#pragma unroll
                    for (int j = 0; j < 4; ++j) o[j] = g[j] * __builtin_amdgcn_rcpf(1.0f + __expf(-g[j])) * up[j];
                    *(unsigned*)(rowp + bj * 64) = pk4_fp8(o[0], o[1], o[2], o[3]); } }
    }
};
struct EpiBf16S {
    static constexpr bool PERM = true, AFTER_DRAIN = false;
    bf16_t* O; int ldc; int nN; float scale;
    __device__ __forceinline__ void operator()(const pg8::f32x4 (&acc)[2][2][4][2], const pg8::Unit& u, int wr, int wc, int fr, int fq) const {
        const int row0 = u.pm * 256 + wr * 64 + fr; const int col0 = (u.pn % nN) * 256 + wc * 32 + 8 * fq;
#pragma unroll
        for (int ai = 0; ai < 2; ++ai)
#pragma unroll
            for (int m = 0; m < 4; ++m) { bf16_t* rowp = O + (size_t)(row0 + ai * 128 + m * 16) * ldc + col0;
#pragma unroll
                for (int bj = 0; bj < 2; ++bj) { const pg8::f32x4 v0 = acc[ai][bj][m][0] * scale, v1 = acc[ai][bj][m][1] * scale;
                    pg8::u32x4 w; w.x = pg8::cvt_pk_bf16(v0[0], v0[1]); w.y = pg8::cvt_pk_bf16(v0[2], v0[3]); w.z = pg8::cvt_pk_bf16(v1[0], v1[1]); w.w = pg8::cvt_pk_bf16(v1[2], v1[3]);
                    *(pg8::u32x4*)(rowp + bj * 128) = w; } }
    }
};
__device__ __forceinline__ void ph_moe_place8(const unsigned char* __restrict__ HN8, const int* __restrict__ bcnt, const int* __restrict__ tok_e, unsigned char* __restrict__ AS8, int* __restrict__ tokpos, int* __restrict__ cnt, float* ldsf) {
    const int TIDX = otid();
    const int lane = TIDX & 63, wave = TIDX >> 6;
    volatile int* sh = (volatile int*)ldsf;
    const int G = (int)gridDim.x;
    if (wave == 0) {
        float tot[8], off[8];
#pragma unroll
        for (int e = 0; e < 8; ++e) { tot[e] = 0.f; off[e] = 0.f; }
        for (int bb = lane; bb < G; bb += 64) { const int4 c0 = *(const int4*)(bcnt + bb * 8), c1 = *(const int4*)(bcnt + bb * 8 + 4); const int cc[8] = {c0.x, c0.y, c0.z, c0.w, c1.x, c1.y, c1.z, c1.w};
#pragma unroll
            for (int e = 0; e < 8; ++e) { tot[e] += (float)cc[e]; if (bb < (int)blockIdx.x) off[e] += (float)cc[e]; } }
        int ts = 0;
#pragma unroll
        for (int e = 0; e < 8; ++e) { const int te = (int)(wave_sum_dpp(tot[e]) + 0.5f), oe = (int)(wave_sum_dpp(off[e]) + 0.5f);
            if (lane == 0) { sh[e] = ts * 256 + oe; sh[8 + e] = te; sh[16 + e] = ts; if (blockIdx.x == 0) cnt[e] = te; }
            ts += (te + 255) >> 8; }
        if (lane == 0) sh[24] = ts;
    }
    __syncthreads();
    const int TPB = (M + G - 1) / G; const int t_beg = (int)blockIdx.x * TPB, t_end = (t_beg + TPB) < M ? (t_beg + TPB) : M;
    for (int g0 = t_beg; g0 < t_end; g0 += 64) {
        const int tk = g0 + lane; int e1 = -1, e2 = -1;
        if (tk < t_end) { e1 = tok_e[tk * 2]; e2 = tok_e[tk * 2 + 1]; }
        unsigned long long mk[8];
#pragma unroll
        for (int e = 0; e < 8; ++e) mk[e] = __ballot(e1 == e || e2 == e);
        const int n_here = (t_end - g0) < 64 ? (t_end - g0) : 64;
        for (int tl = wave; tl < n_here; tl += 8) {
            const int tok = g0 + tl;
            const int ea = __builtin_amdgcn_readlane(e1, tl), eb = __builtin_amdgcn_readlane(e2, tl);
            const unsigned long long below = (1ull << tl) - 1ull;
            int pa = 0, pb = 0;
#pragma unroll
            for (int e = 0; e < 8; ++e) { const int rk = __popcll(mk[e] & below); if (e == ea) pa = sh[e] + rk; if (e == eb) pb = sh[e] + rk; }
            const uint4 row = ((const uint4*)(HN8 + (size_t)tok * D))[lane];
            ((uint4*)(AS8 + (size_t)pa * D))[lane] = row; ((uint4*)(AS8 + (size_t)pb * D))[lane] = row;
            if (lane == 0) { tokpos[tok * 2] = pa; tokpos[tok * 2 + 1] = pb; }
        }
        __syncthreads();
        if (TIDX < 8) sh[TIDX] += __popcll(mk[TIDX]);
        __syncthreads();
    }
    const int gw = blockIdx.x * 8 + wave, NGW = G * 8;
#pragma unroll 1
    for (int e = 0; e < 8; ++e) { const int r0 = sh[16 + e] * 256 + sh[8 + e], r1 = (e < 7 ? sh[16 + e + 1] : sh[24]) * 256;
        for (int rr = r0 + gw; rr < r1; rr += NGW) ((uint4*)(AS8 + (size_t)rr * D))[lane] = make_uint4(0u, 0u, 0u, 0u); }
    __syncthreads();
}
#define WSB(mib) ((bf16_t*)(ws + (size_t)(mib) * MiB))
#define GEMM_STATIC(Aptr, Btptr, Mr, Nc, Kd, EpiT, Eobj) do { \
        pg8::Gemm g_{(const bf16_t*)(Aptr), (const bf16_t*)(Btptr), (Mr), (Nc), (Kd), 0, 0}; pg8::StaticOrder S_; S_.init((Mr), (Nc), (int)gridDim.x, (int)blockIdx.x); \
        pg8::gemm_phase<EpiT, pg8::StaticOrder, PG8_ALIGN, PG8_SP2>(ldsq, g_, S_, (Eobj)); } while (0)

#define GEMM_STATIC_OFF(Aptr, Btptr, Mr, Nc, Kd, EpiT, Eobj, COFF) do { \
        pg8::Gemm g_{(const bf16_t*)(Aptr), (const bf16_t*)(Btptr), (Mr), (Nc), (Kd), 0, 0}; pg8::StaticOrder S_; S_.init((Mr), (Nc), (int)gridDim.x, (int)((blockIdx.x + gridDim.x - ((COFF) % gridDim.x)) % gridDim.x)); \
        pg8::gemm_phase<EpiT, pg8::StaticOrder, PG8_ALIGN, PG8_SP2>(ldsq, g_, S_, (Eobj)); } while (0)

template <class T> __device__ __forceinline__ T* opaque_uniform(T* p) {
    const unsigned long long v = (unsigned long long)p;
    unsigned lo = __builtin_amdgcn_readfirstlane((unsigned)v), hi = __builtin_amdgcn_readfirstlane((unsigned)(v >> 32));
    asm volatile("" : "+s"(lo), "+s"(hi));
    return (T*)(((unsigned long long)hi << 32) | lo);
}
__device__ __forceinline__ const float* ld_in(const float* const* t, int i) { t = opaque_uniform(t);
    typedef const float* __attribute__((address_space(4))) const* cptr_t;
    return ((cptr_t)(unsigned long long)t)[i]; }
__global__ void __launch_bounds__(NTHR, 2) fwd(Params P) {
    extern __shared__ __attribute__((aligned(16))) unsigned char lds_raw[];
    float* lds = (float*)lds_raw;
    PG8_LAS unsigned char* ldsq = (PG8_LAS unsigned char*)lds_raw;
    volatile LAS unsigned* MISC = (volatile LAS unsigned*)((LAS unsigned char*)lds_raw + (LDS_BYTES - 64));
    if (threadIdx.x < 16) MISC[threadIdx.x] = 0u;
    __syncthreads();
    unsigned char* ws = P.ws;
    unsigned* ctl = (unsigned*)(ws + WS_CTL);
    XcdBarrier bar = xcd_barrier_post(ctl + CW_BAR, MISC + 8);
#define BAR() do { XcdBarrier b2_ = bar; b2_.bar = opaque_uniform(b2_.bar); xcd_barrier(b2_); } while (0)
    const float* const* in = (const float* const*)__builtin_amdgcn_kernarg_segment_ptr();
#define INP(i) ld_in(in, (i))
    float* out = P.out;

    bf16_t* MEMNb0 = WSB(1); bf16_t* MEMNb1 = WSB(3); bf16_t* KVb0 = WSB(5); bf16_t* KVb1 = WSB(9);
    bf16_t* Wt_in = WSB(13); bf16_t* Wt_glu = WSB(18); bf16_t* Wt_out = WSB(19); bf16_t* Wt_q0 = WSB(21); bf16_t* Wt_kv0 = WSB(23); bf16_t* Wt_o0 = WSB(27); bf16_t* Wt_gu = WSB(29); bf16_t* Wt_dn = WSB(40);
    bf16_t* Wt_lora = WSB(46); bf16_t* Wt_q1 = WSB(48); bf16_t* Wt_kv1 = WSB(50); bf16_t* Wt_o1 = WSB(54);
    bf16_t* HNb = WSB(56);
    bf16_t* ZAb = WSB(88); bf16_t* UGX = WSB(145); float* XLOC = WSF(165); bf16_t* TE = WSB(173); bf16_t* TF = WSB(181); bf16_t* LORA = WSB(201); bf16_t* BON = WSB(249);
    const RwkvChunkBufs cb{WSB(329), WSB(361), WSB(393), WSB(409), WSB(417), WSB(421), WSF(425)};
    bf16_t* LA = WSB(329);
    bf16_t* Hb = WSB(427); float* SSQ = WSF(459);
    bf16_t* Wt_qkv = WSB(460); bf16_t* Wt_dao = WSB(466);
    float* Orw = WSF(56); float* YS = WSF(88); bf16_t* YSb = WSB(120); bf16_t* YMIXb = WSB(168);
    const S5P sp{INP(I_S5_LRE), INP(I_S5_LIM), INP(I_S5_LDT), INP(I_S5_BRE), INP(I_S5_BIM), INP(I_S5_CRE), INP(I_S5_CIM), INP(I_S5_D)};
#pragma unroll 1
    for (int step = 0; step < 2; ++step) {
        const bool mats = (((int)blockIdx.x & 1) == 0) == (step == 0);
        if (mats) ph_s5_mats(sp, TE, TF, lds); else ph_rmsnorm(INP(I_X), INP(I_NORM_MIX), HNb, M);
        __syncthreads();
        if (step == 0) {
        int rot0 = 32 % (int)gridDim.x;
        { WC w{INP(I_HY_WIN), INCOLS, D, INCOLS, 2560, Wt_in, 0, 4, 0, 0, 0, nullptr, 0}; ph_wconv(w, lds, -1, 0, rot0); rot0 = (rot0 + wc_nblk(w)) % (int)gridDim.x; }
        { WC w{INP(I_XA_WKV), 2 * D, D, 2 * D, 2 * D, Wt_kv0, 0, 4, 0, 0, 0, nullptr, 0}; ph_wconv(w, lds, -1, 0, rot0); rot0 = (rot0 + wc_nblk(w)) % (int)gridDim.x; }
        { WC w{INP(I_RW_WUP), 512, 64, 512, 512, Wt_lora, 0, 4, 384, 0, 6, nullptr, 0}; ph_wconv(w, lds, -1, 0, rot0); rot0 = (rot0 + wc_nblk(w)) % (int)gridDim.x; }
        { WC w{INP(I_RW_AUP), 512, 64, 512, 512, Wt_lora, 512, 4, 384, 64, 6, nullptr, 0}; ph_wconv(w, lds, -1, 0, rot0); rot0 = (rot0 + wc_nblk(w)) % (int)gridDim.x; }
        { WC w{INP(I_RW_GUP), 512, 160, 512, 512, Wt_lora, 1024, 4, 384, 128, 6, nullptr, 0}; ph_wconv(w, lds, -1, 0, rot0); rot0 = (rot0 + wc_nblk(w)) % (int)gridDim.x; }
        { WC w{INP(I_XA_WKV) + (size_t)D * 2 * D, 2 * D, D, 2 * D, 2 * D, Wt_kv1, 0, 4, 0, 0, 0, nullptr, 0}; ph_wconv(w, lds, -1, 0, rot0); rot0 = (rot0 + wc_nblk(w)) % (int)gridDim.x; }
            __syncthreads();
        }
    }
    ph_rmsnorm(INP(I_MEM), INP(I_NORM_MEM), MEMNb0, NB * MEML);
    ph_rmsnorm(INP(I_MEM), INP(I_NORM_MEM) + D, MEMNb1, NB * MEML);
    BAR();
    { EpiZ E{ZAb, UGX}; GEMM_STATIC(HNb, Wt_in, M, 2560, D, EpiZ, E); }
    { EpiBf16P E{KVb0, 2 * D, 0, 0, nullptr}; GEMM_STATIC_OFF(MEMNb0, Wt_kv0, NB * MEML, 2 * D, D, EpiBf16P, E, 128); }
    { EpiBf16P E{KVb1, 2 * D, 0, 0, nullptr}; GEMM_STATIC_OFF(MEMNb1, Wt_kv1, NB * MEML, 2 * D, D, EpiBf16P, E, 160); }
    BAR();
    { pg8::Gemm g_{UGX, TE, 0, 0, 512, 640, 0}; GroupOrder S_{2, 1, 32, (int)gridDim.x, (int)blockIdx.x}; EpiF32S<true> E{XLOC, 128, 1};
      pg8::gemm_phase<EpiF32S<true>, GroupOrder, PG8_ALIGN, PG8_SP2>(ldsq, g_, S_, E); }
    { const int ev0 = (int)gridDim.x > 128 ? 64 : 0; const int evb = (int)blockIdx.x - ev0, evg = (int)gridDim.x - ev0;
      ph_lora_in(ZAb, INP(I_RW_MU), LA, evb, evg);
      ph_knorm_bf16(KVb0, INP(I_XA_KG), INP(I_XA_QG), evb, evg);
      ph_knorm_bf16(KVb1, INP(I_XA_KG) + 256, INP(I_XA_QG) + 256, evb, evg); }
    BAR();
    { EpiBf16P E{LORA, 1536, 0, 0, nullptr}; GEMM_STATIC(LA, Wt_lora, M, 1536, 384, EpiBf16P, E); }
    ph_s5_state(sp, XLOC, UGX, 128);
    BAR();
    { RwkvP rp{INP(I_RW_MU), INP(I_RW_W0), INP(I_RW_WUP), INP(I_RW_A0), INP(I_RW_AUP), INP(I_RW_GUP), INP(I_RW_KK), INP(I_RW_KA), INP(I_RW_RK), INP(I_RW_LNW), INP(I_RW_LNB)};
      ph_rwkv_chunk_prep2(ZAb, LORA, rp, cb, BON, lds); }
    BAR();
    ph_rwkv_chunk_scan3(cb, Orw, WSB(136), WSB(144), ctl + CW_R2F, opaque_uniform(ctl + CW_BAR), lds, LORA, BON, INP(I_RW_LNW), INP(I_RW_LNB), YMIXb, opaque_uniform(ctl + CW_GLUF), (unsigned)((int)gridDim.x - R2_WGS));
    { const int cv0 = R2_WGS; const int cvg = (int)gridDim.x > cv0 ? (int)gridDim.x - cv0 : 0; const int cvb = (int)blockIdx.x - cv0;
      if (cvg == 0 || cvb >= 0) { int rot1 = 0; const int cvn = cvg ? cvg : (int)gridDim.x;
        { WC w{INP(I_S5_WGLU), 512, 512, 512, 512, Wt_glu, 0, 4, 0, 0, 0, nullptr, 0}; ph_wconv(w, lds, cvg ? cvb : -1, cvg, rot1); rot1 = (rot1 + wc_nblk(w)) % cvn; }
        { WC w{INP(I_HY_WOUT), D, D, D, D, Wt_out, 0, 4, 0, 0, 0, nullptr, 0}; ph_wconv(w, lds, cvg ? cvb : -1, cvg, rot1); rot1 = (rot1 + wc_nblk(w)) % cvn; }
        { WC w{INP(I_XA_WQ), D, D, D, D, Wt_q0, 0, 4, 0, 0, 0, INP(I_NORM_XATTN), 0}; ph_wconv(w, lds, cvg ? cvb : -1, cvg, rot1); rot1 = (rot1 + wc_nblk(w)) % cvn; }
        { WC w{INP(I_XA_WO), D, D, D, D, Wt_o0, 0, 4, 0, 0, 0, nullptr, 0}; ph_wconv(w, lds, cvg ? cvb : -1, cvg, rot1); rot1 = (rot1 + wc_nblk(w)) % cvn; }
        { WC w{INP(I_FF_WG), DFF, D, DFF, DFF, Wt_gu, 0, 8, 0, 0, 0, INP(I_NORM_FFN), 0}; ph_wconv(w, lds, cvg ? cvb : -1, cvg, rot1); rot1 = (rot1 + wc_nblk(w)) % cvn; }
        { WC w{INP(I_FF_WU), DFF, D, DFF, DFF, Wt_gu, 4, 8, 0, 0, 0, INP(I_NORM_FFN), 0}; ph_wconv(w, lds, cvg ? cvb : -1, cvg, rot1); rot1 = (rot1 + wc_nblk(w)) % cvn; }
        { WC w{INP(I_FF_WD), D, DFF, D, D, Wt_dn, 0, 4, 0, 0, 0, nullptr, 0}; ph_wconv(w, lds, cvg ? cvb : -1, cvg, rot1); rot1 = (rot1 + wc_nblk(w)) % cvn; }
        { WC w{INP(I_XA_WQ) + (size_t)D * D, D, D, D, D, Wt_q1, 0, 4, 0, 0, 0, INP(I_NORM_XATTN) + D, 0}; ph_wconv(w, lds, cvg ? cvb : -1, cvg, rot1); rot1 = (rot1 + wc_nblk(w)) % cvn; }
        { WC w{INP(I_XA_WO) + (size_t)D * D, D, D, D, D, Wt_o1, 0, 4, 0, 0, 0, nullptr, 0}; ph_wconv(w, lds, cvg ? cvb : -1, cvg, rot1); rot1 = (rot1 + wc_nblk(w)) % cvn; }
        { WC w{INP(I_DA_WQKV), 3 * D, D, 3 * D, 3 * D, Wt_qkv, 0, 4, 0, 0, 0, INP(I_NORM_MIX) + D, 1}; ph_wconv(w, lds, cvg ? cvb : -1, cvg, rot1); rot1 = (rot1 + wc_nblk(w)) % cvn; }
        { WC w{INP(I_DA_WO), D, D, D, D, Wt_dao, 0, 4, 0, 0, 0, nullptr, 0}; ph_wconv(w, lds, cvg ? cvb : -1, cvg, rot1); rot1 = (rot1 + wc_nblk(w)) % cvn; }
      } }
    __syncthreads();
    { const int gsz = (int)gridDim.x - R2_WGS; pg8::Gemm g_{UGX, TF, 0, 0, 640, 640, 640}; GroupOrder S_{2, 2, 32, gsz > 0 ? gsz : (int)gridDim.x, gsz > 0 ? (int)blockIdx.x - R2_WGS : (int)blockIdx.x};
      EpiS5Y E{UGX, INP(I_S5_D), YS, YSb}; pg8::gemm_phase<EpiS5Y, GroupOrder, PG8_ALIGN, PG8_SP2>(ldsq, g_, S_, E); }
    if ((int)gridDim.x > R2_WGS && (int)blockIdx.x >= R2_WGS) {
        unsigned* barw = opaque_uniform(ctl + CW_BAR); unsigned* gf = opaque_uniform(ctl + CW_GLUF);
        asm volatile("s_waitcnt vmcnt(0)" ::: "memory");
        __syncthreads();
        if (threadIdx.x == 0) {
            __builtin_amdgcn_fence(__ATOMIC_RELEASE, "agent");
            asm volatile("s_waitcnt vmcnt(0)" ::: "memory");
            (void)xb_add(gf, 1u);
            if ((int)blockIdx.x - R2_WGS < 128) { __builtin_amdgcn_fence(__ATOMIC_ACQUIRE, "agent"); asm volatile("s_waitcnt vmcnt(0)" ::: "memory"); XB_SPIN(xb_ld(gf) < (unsigned)((int)gridDim.x - R2_WGS), barw); }
        }
        __syncthreads();
        { pg8::Gemm g_{YSb, Wt_glu, 0, 0, 512, 0, 0}; GroupOrder S_{64, 2, 1, (int)gridDim.x - R2_WGS, (int)blockIdx.x - R2_WGS}; EpiGLU E{YS, INP(I_S5_BGLU), YMIXb};
          pg8::gemm_phase<EpiGLU, GroupOrder, PG8_ALIGN, PG8_SP2>(ldsq, g_, S_, E); }
    }
    BAR();
    { EpiRes E{INP(I_X), Hb, SSQ}; GEMM_STATIC(YMIXb, Wt_out, M, D, D, EpiRes, E); }
    BAR();

#define MEM_XATTN(KVb_, Wq_, Wo_, HbOut, QOFF, AOFF) do { \
            bf16_t* Qb = WSB(QOFF); bf16_t* AOb = WSB(AOFF); \
            { EpiBf16P E{Qb, D, 0, 0, SSQ}; GEMM_STATIC(Hb, Wq_, M, D, D, EpiBf16P, E); } \
            {     \
              int qpm_, qpn_; pg8::static_unit_of(M / 256, D / 256, (int)blockIdx.x, qpm_, qpn_); \
              asm volatile("s_waitcnt vmcnt(0)" ::: "memory"); __syncthreads(); \
              int u0_ = __builtin_amdgcn_readfirstlane((qpm_ >> 4) * 128 + qpn_ * 32 + 2 * (qpm_ & 15)); asm volatile("" : "+s"(u0_)); \
              ph_mem_attn_mfma(Qb, KVb_, AOb, lds, u0_); } \
            BAR(); \
            { EpiRes E{nullptr, Hb, SSQ}; GEMM_STATIC(AOb, Wo_, M, D, D, EpiRes, E); } \
            BAR(); } while (0)

    MEM_XATTN(KVb0, Wt_q0, Wt_o0, Hb, 56, 88);
    {
        bf16_t* H = WSB(88);
        { EpiSwiGLU E{H, DFF, 0, 0, SSQ}; GEMM_STATIC(Hb, Wt_gu, M, 2 * DFF, D, EpiSwiGLU, E); }
        BAR();
        { EpiRes E{nullptr, Hb, SSQ}; GEMM_STATIC(H, Wt_dn, M, D, DFF, EpiRes, E); }
        BAR();
    }
    unsigned char* Wt_mgu8 = (unsigned char*)WSB(265); unsigned char* Wt_mdn8 = (unsigned char*)WSB(468);
    {
        bf16_t* QKVb = WSB(56); bf16_t* AOb = WSB(352);
        { EpiQKV E{QKVb, SSQ, INP(I_DA_QG), INP(I_DA_KG)}; GEMM_STATIC(Hb, Wt_qkv, M, 3 * D, D, EpiQKV, E); }
        BAR();
        { const int ncv = gridDim.x >= 192 ? 64 : 0; const int vb = (int)blockIdx.x - ((int)gridDim.x - ncv);
          if (ncv == 0 || vb >= 0) { int rot8 = 0; const int cvn8 = ncv ? ncv : (int)gridDim.x;
#pragma unroll 1
            for (int e = 0; e < NEXP; ++e) {
                { WC8 w{INP(I_MOE_WG) + (size_t)e * D * DFFE, DFFE, D, DFFE, Wt_mgu8 + (size_t)e * 2 * DFFE * D, 0, 8}; ph_wconv8(w, lds, ncv ? vb : -1, ncv, rot8); rot8 = (rot8 + 112) % cvn8; }
                { WC8 w{INP(I_MOE_WU) + (size_t)e * D * DFFE, DFFE, D, DFFE, Wt_mgu8 + (size_t)e * 2 * DFFE * D, 4, 8}; ph_wconv8(w, lds, ncv ? vb : -1, ncv, rot8); rot8 = (rot8 + 112) % cvn8; }
                { WC8 w{INP(I_MOE_WD) + (size_t)e * DFFE * D, D, DFFE, D, Wt_mdn8 + (size_t)e * D * DFFE, 0, 4}; ph_wconv8(w, lds, ncv ? vb : -1, ncv, rot8); rot8 = (rot8 + 112) % cvn8; }
            }
          } }
        { DAP dp{INP(I_DA_LQ1), INP(I_DA_LK1), INP(I_DA_LQ2), INP(I_DA_LK2), INP(I_DA_SUBG)}; ph_diff_attn_mfma(QKVb, dp, AOb, lds, ctl + CW_ATTQ, INP(I_DA_QG), INP(I_DA_KG)); }
        BAR();
        { EpiRes E{nullptr, Hb, SSQ}; GEMM_STATIC(AOb, Wt_dao, M, D, D, EpiRes, E); }
        BAR();
    }
    MEM_XATTN(KVb1, Wt_q1, Wt_o1, (bf16_t*)nullptr, 56, 88);
    {
        unsigned char* HN8 = (unsigned char*)WSB(13);
        int* tok_e = (int*)WSF(29); float* tok_w = WSF(29) + 2 * M;
        int* tokpos = (int*)WSF(31);
        int* cnt = (int*)(ctl + CW_CNT);
        unsigned char* AS8 = (unsigned char*)WSB(32);
        bf16_t* Ym = WSB(66);
        unsigned char* Hm8 = (unsigned char*)WSB(134);
        int* bcnt = (int*)WSF(30);
        ph_router(Hb, INP(I_NORM_FFN) + D, INP(I_MOE_WR), INP(I_MOE_BR), HN8, tok_e, tok_w, bcnt, lds);
        BAR();
        ph_moe_place8(HN8, bcnt, tok_e, AS8, tokpos, cnt, lds);
        BAR();
        const int vc = (gridDim.x % 8 == 0) ? (int)((blockIdx.x % 8) * (gridDim.x / 8) + blockIdx.x / 8) : (int)blockIdx.x;
        { MoeOrder S_; S_.cnt = cnt; S_.nN = 2 * DFFE / 256; S_.G = (int)gridDim.x; S_.c = vc; S_.t_lo = 0; S_.t_hi = 136; S_.pm_base = 0;
          pg8::Gemm g_{(const bf16_t*)AS8, (const bf16_t*)Wt_mgu8, 0, 0, D / 2, 0, 0}; EpiSwiGLU8 E{Hm8, DFFE, 2 * DFFE / 256};
          pg8::gemm_phase_f8<EpiSwiGLU8, MoeOrder, PG8_ALIGN, PG8_SP2>(ldsq, g_, S_, E); }
        BAR();
        { MoeOrder S_; S_.cnt = cnt; S_.nN = D / 256; S_.G = (int)gridDim.x; S_.c = vc; S_.t_lo = 0; S_.t_hi = 136; S_.pm_base = 0;
          pg8::Gemm g_{(const bf16_t*)Hm8, (const bf16_t*)Wt_mdn8, 0, 0, DFFE / 2, 0, 0}; EpiBf16S E{Ym, D, D / 256, W8_INV};
          pg8::gemm_phase_f8<EpiBf16S, MoeOrder, PG8_ALIGN, PG8_SP2>(ldsq, g_, S_, E); }
        BAR();
        ph_moe_combine(Ym, tokpos, tok_w, Hb, out);
    }
}

extern "C" void kernel_launch(void* const* d_in, const int* in_sizes, int n_in, void* d_out, int out_size, void* d_ws, size_t ws_size, hipStream_t stream) {
    static int grid = 0;
    if (grid == 0) {
        int dev = 0, cus = 0;
        if (n_in != N_IN || ws_size < (size_t)497 * MiB) { fprintf(stderr, "kernel_launch: unexpected n_in %d / ws %zu\n", n_in, ws_size); grid = -1; return; }
        if (hipGetDevice(&dev) != hipSuccess || hipDeviceGetAttribute(&cus, hipDeviceAttributeMultiprocessorCount, dev) != hipSuccess) { grid = -1; return; }
        if (hipFuncSetAttribute((const void*)fwd, hipFuncAttributeMaxDynamicSharedMemorySize, LDS_BYTES) != hipSuccess) { fprintf(stderr, "hipFuncSetAttribute failed\n"); grid = -1; return; }
        int per_cu = 0;
        if (hipOccupancyMaxActiveBlocksPerMultiprocessor(&per_cu, (const void*)fwd, NTHR, LDS_BYTES) != hipSuccess || per_cu < 1) fprintf(stderr, "occupancy query: %d\n", per_cu);
        (void)hipGetLastError();
        grid = cus;
        if (grid != 256) { fprintf(stderr, "kernel_launch: %d CUs (the phase program deals fixed workgroup ranges of a 256-workgroup grid)\n", cus); grid = -1; return; }
    }
    if (grid < 0) return;
    hipMemsetAsync((char*)d_ws + WS_CTL, 0, CTL_BYTES, stream);
    Params p{};
    for (int i = 0; i < N_IN; ++i) p.in[i] = (const float*)d_in[i];
    p.out = (float*)d_out; p.ws = (unsigned char*)d_ws;
    hipLaunchKernelGGL(fwd, dim3(grid), dim3(NTHR), LDS_BYTES, stream, p);
}
```

```cpp
#include <hip/hip_runtime.h>
#include <stdint.h>
#include <stdio.h>

#define LAS __attribute__((address_space(3)))

#define XB_TMO      128
#define XB_XCNT(j)  (256  + 64 * (j))
#define XB_XSUB(j)  (1280 + 64 * (j))
#define XB_XGEN(j)  (2304 + 64 * (j))
#define XB_TOP      3328
#define XB_TOPGEN   3392
#define XCD_BAR_WORDS 3456
#define XB_SPIN_CAP (1u << 25)

__device__ __forceinline__ unsigned xb_ld(unsigned* p)              { return __hip_atomic_load(p, __ATOMIC_RELAXED, __HIP_MEMORY_SCOPE_AGENT); }
__device__ __forceinline__ unsigned xb_add(unsigned* p, unsigned v) { return __hip_atomic_fetch_add(p, v, __ATOMIC_RELAXED, __HIP_MEMORY_SCOPE_AGENT); }
__device__ __forceinline__ unsigned xb_xcc_id() { return (unsigned)__builtin_amdgcn_s_getreg((3 << 11) | 20) & 0xFu; }
#define XB_SPIN(cond, bar) do { unsigned _sp = 0; while (cond) { __builtin_amdgcn_s_sleep(1); \
    if ((++_sp & 255u) == 0u) { if (xb_ld(&(bar)[XB_TMO])) break; if (_sp > XB_SPIN_CAP) { atomicAdd(&(bar)[XB_TMO], 1u); break; } } } } while (0)

struct XcdBarrier { unsigned* bar; unsigned x; volatile LAS unsigned* st; };

__device__ __forceinline__ XcdBarrier xcd_barrier_post(unsigned* bar, volatile LAS unsigned* st) {
    XcdBarrier b; b.bar = bar; b.x = xb_xcc_id(); b.st = st;
    if (threadIdx.x == 0) (void)xb_add(&bar[XB_XCNT(b.x)], 1u);
    return b;
}
__device__ __forceinline__ void xcd_barrier_complete(unsigned* bar, unsigned x, unsigned& nloc, unsigned& nx) {
    const unsigned G = gridDim.x * gridDim.y * gridDim.z;
    unsigned sum, cnt, mine, sp = 0u;
    for (;;) {
        sum = 0u; cnt = 0u; mine = 0u;
#pragma unroll
        for (unsigned j = 0; j < 16; ++j) { const unsigned c = xb_ld(&bar[XB_XCNT(j)]); sum += c; cnt += (c > 0u) ? 1u : 0u; mine = (j == x) ? c : mine; }
        if (sum == G) break;
        __builtin_amdgcn_s_sleep(1);
        if ((++sp & 255u) == 0u) { if (xb_ld(&bar[XB_TMO])) break; if (sp > XB_SPIN_CAP) { atomicAdd(&bar[XB_TMO], 1u); break; } }
    }
    nloc = mine > 0u ? mine : 1u; nx = cnt > 0u ? cnt : 1u;
}
__device__ __forceinline__ void xcd_barrier(const XcdBarrier& b) {
    asm volatile("s_waitcnt vmcnt(0)" ::: "memory");
    __syncthreads();
    if (threadIdx.x == 0) {
        unsigned* bar = b.bar;
        __builtin_amdgcn_s_waitcnt(0);
        unsigned nloc = b.st[0], nx = b.st[1];
        if (nloc == 0u) { xcd_barrier_complete(bar, b.x, nloc, nx); b.st[0] = nloc; b.st[1] = nx; }
        const unsigned old = xb_add(&bar[XB_XSUB(b.x)], 1u);
        const unsigned gen = old / nloc;
        if (old + 1u == (gen + 1u) * nloc) {
            __builtin_amdgcn_fence(__ATOMIC_RELEASE, "agent");
            asm volatile("s_waitcnt vmcnt(0)" ::: "memory");
            const unsigned og = xb_add(&bar[XB_TOP], 1u);
            const unsigned tg = og / nx;
            const bool lastx = (og + 1u == (tg + 1u) * nx);
            if (!lastx) { __builtin_amdgcn_fence(__ATOMIC_ACQUIRE, "agent"); asm volatile("s_waitcnt vmcnt(0)" ::: "memory"); XB_SPIN(xb_ld(&bar[XB_TOP]) < (tg + 1u) * nx, bar); }
            xb_add(&bar[XB_XGEN(b.x)], 1u);
            if (lastx) __builtin_amdgcn_fence(__ATOMIC_ACQUIRE, "agent");
            asm volatile("s_waitcnt vmcnt(0)" ::: "memory");
        } else {
            __builtin_amdgcn_fence(__ATOMIC_ACQUIRE, "agent");
            asm volatile("s_waitcnt vmcnt(0)" ::: "memory");
            XB_SPIN(xb_ld(&bar[XB_XGEN(b.x)]) == gen, bar);
        }
    }
    __syncthreads();
}

constexpr int NB = 4, T = 4096, D = 1024, M = NB * T;
constexpr int RCOLS = 1824, INCOLS = 2336, DFF = 2816, NEXP = 8, DFFE = 3584, MEML = 256;
constexpr int NTHR = 512;
constexpr int LDS_BYTES = 147456;
constexpr float NORM_EPS = 1e-6f;
constexpr float LAMBDA_INIT = 0.35550906f;

enum { I_X = 0, I_MEM, I_NORM_MIX, I_NORM_XATTN, I_NORM_MEM, I_NORM_FFN, I_XA_WQ, I_XA_WKV, I_XA_QG, I_XA_KG, I_XA_WO,
       I_HY_WIN, I_RW_MU, I_RW_W0, I_RW_WUP, I_RW_A0, I_RW_AUP, I_RW_GUP, I_RW_KK, I_RW_KA, I_RW_RK, I_RW_LNW, I_RW_LNB,
       I_S5_LRE, I_S5_LIM, I_S5_LDT, I_S5_BRE, I_S5_BIM, I_S5_CRE, I_S5_CIM, I_S5_D, I_S5_WGLU, I_S5_BGLU, I_HY_WOUT,
       I_FF_WG, I_FF_WU, I_FF_WD, I_DA_WQKV, I_DA_QG, I_DA_KG, I_DA_LQ1, I_DA_LK1, I_DA_LQ2, I_DA_LK2, I_DA_SUBG, I_DA_WO,
       I_MOE_WR, I_MOE_BR, I_MOE_WG, I_MOE_WU, I_MOE_WD, N_IN };

struct Params { const float* in[N_IN]; float* out; unsigned char* ws; };

constexpr size_t MiB = 1u << 20;
constexpr size_t WS_CTL = 0, CTL_BYTES = 1 * MiB;
constexpr size_t CW_BAR = 4096;
constexpr size_t CW_CNT = 16384;
constexpr size_t CW_ATTQ = 16448;
constexpr size_t CW_GLUF = 17088;
constexpr size_t CW_R2F = 16512;
#define WSF(mib) ((float*)(ws + (size_t)(mib) * MiB))

__device__ __forceinline__ int otid() { int t = threadIdx.x; asm volatile("" : "+v"(t)); return t; }
__device__ __forceinline__ float wave_sum(float v) {
#pragma unroll
    for (int o = 1; o < 64; o <<= 1) v += __shfl_xor(v, o);
    return v;
}
__device__ __forceinline__ float row_sum_dpp(float v) {
#define DPP_ROR_ADD(n) v += __builtin_bit_cast(float, __builtin_amdgcn_update_dpp(0, __builtin_bit_cast(int, v), 0x120 + (n), 0xf, 0xf, false))
    DPP_ROR_ADD(8); DPP_ROR_ADD(4); DPP_ROR_ADD(2); DPP_ROR_ADD(1);
#undef DPP_ROR_ADD
    return v;
}
__device__ __forceinline__ float wave_sum_dpp(float v) {
    float o;
    asm("s_nop 1\n\tv_add_f32_dpp %0, %1, %1 row_ror:8 row_mask:0xf bank_mask:0xf\n\t"
        "s_nop 1\n\tv_add_f32_dpp %0, %0, %0 row_ror:4 row_mask:0xf bank_mask:0xf\n\t"
        "s_nop 1\n\tv_add_f32_dpp %0, %0, %0 row_ror:2 row_mask:0xf bank_mask:0xf\n\t"
        "s_nop 1\n\tv_add_f32_dpp %0, %0, %0 row_ror:1 row_mask:0xf bank_mask:0xf\n\t"
        "s_nop 1\n\tv_add_f32_dpp %0, %0, %0 row_bcast:15 row_mask:0xa bank_mask:0xf\n\t"
        "s_nop 1\n\tv_add_f32_dpp %0, %0, %0 row_bcast:31 row_mask:0xc bank_mask:0xf"
        : "=&v"(o) : "v"(v));
    return __builtin_bit_cast(float, __builtin_amdgcn_readlane(__builtin_bit_cast(int, o), 63));
}
__device__ __forceinline__ float wave_max(float v) {
#pragma unroll
    for (int o = 1; o < 64; o <<= 1) v = fmaxf(v, __shfl_xor(v, o));
    return v;
}
__device__ __forceinline__ float sigmoidf_(float x) { return 1.0f / (1.0f + expf(-x)); }
__device__ __forceinline__ float fexp2(float x) { return __builtin_amdgcn_exp2f(x); }
__device__ __forceinline__ float fexp(float x) { return __builtin_amdgcn_exp2f(x * 1.4426950408889634f); }
__device__ __forceinline__ float frcp(float x) { return __builtin_amdgcn_rcpf(x); }
__device__ __forceinline__ float frsq(float x) { return __builtin_amdgcn_rsqf(x); }
__device__ __forceinline__ float fsigmoid(float x) { return frcp(1.0f + fexp(-x)); }
__device__ __forceinline__ float ftanh(float x) { const float a = fminf(fmaxf(x, -15.f), 15.f); return 1.0f - 2.0f * frcp(1.0f + fexp(2.0f * a)); }
__device__ __forceinline__ float fsoftplus(float x) { return x > 20.f ? x : __builtin_amdgcn_logf(1.0f + fexp(x)) * 0.6931471805599453f; }
__device__ __forceinline__ float softplusf_(float x) { return x > 20.f ? x : log1pf(expf(x)); }
__device__ __forceinline__ float gelu_tanh(float y) { return 0.5f * y * (1.0f + ftanh(0.7978845608028654f * (y + 0.044715f * y * y * y))); }

namespace pg8 {
#define PG8_LAS __attribute__((address_space(3)))
typedef unsigned short bf16_t;
typedef short bf16x8 __attribute__((ext_vector_type(8)));
typedef float f32x4 __attribute__((ext_vector_type(4)));
typedef unsigned u32x4 __attribute__((ext_vector_type(4)));
constexpr int BM = 256, BK = 64, HALF = 128, HTB = HALF * BK * 2  , STAGE_BYTES = 8 * HTB, NXCD = 8, WGM = 8;

__host__ __device__ __forceinline__ int lds_byte(int r, int c) { const int st = (r >> 4) * 2 + (c >> 5), rr = r & 15, cc = c & 31, ob = rr * 64 + cc * 2; return st * 1024 + (ob ^ (((ob >> 9) & 1) << 5)); }
__host__ __device__ __forceinline__ void stage_rc(int b, int& R, int& C) { const int st = b / 1024, sb = b % 1024, swz = sb ^ (((sb >> 9) & 1) << 5); R = (st >> 1) * 16 + swz / 64; C = (st & 1) * 32 + (swz % 64) / 2; }
__host__ __device__ __forceinline__ int perm32(int rho) { const int n = rho >> 4, i = rho & 15; return 8 * (i >> 2) + 4 * n + (i & 3); }

struct Unit { int pm, pn; };
struct Gemm { const bf16_t* A; const bf16_t* Bt; int M, N, K; int lda, ldb; };

struct StaticOrder {
    int nM, nN, nwg, G, c;
    __host__ __device__ void init(int M, int N, int G_, int c_) { nM = M / BM; nN = N / BM; nwg = nM * nN; G = G_; c = c_; }
    __host__ __device__ bool next(int i, Unit& u) const {
        const long L = (long)i * G + c; if (L >= nwg) return false;
        int wgid = (int)L; { const int q = nwg / NXCD, r = nwg % NXCD, xcd = wgid % NXCD, off = wgid / NXCD; wgid = (xcd < r ? xcd * (q + 1) : r * (q + 1) + (xcd - r) * q) + off; }
        const int nig = WGM * nN, gid = wgid / nig, fm = gid * WGM, gsz = (nM - fm) < WGM ? (nM - fm) : WGM;
        u.pm = fm + ((wgid % nig) % gsz); u.pn = (wgid % nig) / gsz; return true;
    }
    __device__ __forceinline__ void a_ready(const Unit&) const {}
    __device__ __forceinline__ void done(const Unit&) const {}
};
__device__ __forceinline__ void static_unit_of(int nM, int nN, int c, int& pm, int& pn) {
    const int nwg = nM * nN; const int q = nwg / NXCD, r = nwg % NXCD, xcd = c % NXCD, off = c / NXCD; const int wgid = (xcd < r ? xcd * (q + 1) : r * (q + 1) + (xcd - r) * q) + off;
    const int nig = WGM * nN, gid = wgid / nig, fm = gid * WGM, gsz = (nM - fm) < WGM ? (nM - fm) : WGM; pm = fm + ((wgid % nig) % gsz); pn = (wgid % nig) / gsz;
}
typedef float f32x2c __attribute__((ext_vector_type(2)));
typedef __bf16 bf16x2c __attribute__((ext_vector_type(2)));
__device__ __forceinline__ unsigned cvt_pk_bf16(float lo, float hi) { const f32x2c v = {lo, hi}; const bf16x2c r = __builtin_convertvector(v, bf16x2c); return __builtin_bit_cast(unsigned, r); }
typedef float f32x2 __attribute__((ext_vector_type(2)));
template <class Epi, class Sched, bool ALIGN_EPI = false, bool SP2 = false>
__device__ __forceinline__ void gemm_phase(PG8_LAS unsigned char* lds, const Gemm g, const Sched& S, const Epi& E) {
    const int tid = ::otid(), wid = __builtin_amdgcn_readfirstlane(tid >> 6), lane = tid & 63, wr = wid >> 2, wc = wid & 3, fr = lane & 15, fq = lane >> 4;
    const int K = g.K, nt = K / BK; const int lda = g.lda ? g.lda : K, ldb = g.ldb ? g.ldb : K;
    unsigned voffA[2], voffB[2];
#pragma unroll
    for (int i = 0; i < 2; ++i) { int R, C; stage_rc(tid * 16 + i * 8192, R, C); const int Rb = Epi::PERM ? ((R & ~31) + perm32(R & 31)) : R;
        voffA[i] = (unsigned)(R * lda + C) * 2u; voffB[i] = (unsigned)(Rb * ldb + C) * 2u; }
    const size_t kstep = (size_t)(BK * 2);
    const size_t hstepA = (size_t)HALF * lda * 2, hstepB = (size_t)HALF * ldb * 2;
    const size_t tstepA = 2 * hstepA, tstepB = 2 * hstepB;
    const unsigned ldsw = (unsigned)wid * 1024u; const unsigned ldsb32 = (unsigned)(size_t)lds;
    const int aoff = lds_byte(wr * 64 + fr, fq * 8), boff = lds_byte(wc * 32 + fr, fq * 8);
#define PG8_SA(b, h) (((b) * 2 + (h)) * HTB)
#define PG8_SB(b, h) ((4 + (b) * 2 + (h)) * HTB)
#define PG8_STAGE(bufoff, gbase, voff) do { _Pragma("unroll") for (int _i = 0; _i < 2; ++_i) \
        asm volatile("s_mov_b32 m0, %2\n\tglobal_load_lds_dwordx4 %0, %1" :: "v"((voff)[_i]), "s"((const char*)(gbase)), "s"((unsigned)(ldsb32 + (unsigned)(bufoff) + ldsw + (unsigned)(_i * 8192))) : "memory", "m0"); } while (0)
#define PG8_LDA(dst, b, h) do { _Pragma("unroll") for (int m = 0; m < 4; ++m) _Pragma("unroll") for (int k = 0; k < 2; ++k) dst[m][k] = *(const PG8_LAS bf16x8*)(lds + PG8_SA(b, h) + aoff + m * 2048 + k * 1024); } while (0)
#define PG8_LDB(dst, b, h) do { _Pragma("unroll") for (int n = 0; n < 2; ++n) _Pragma("unroll") for (int k = 0; k < 2; ++k) dst[n][k] = *(const PG8_LAS bf16x8*)(lds + PG8_SB(b, h) + boff + n * 2048 + k * 1024); } while (0)
#define PG8_MMA(ai, bj, At, Bt) do { __builtin_amdgcn_s_setprio(1); _Pragma("unroll") for (int m = 0; m < 4; ++m) _Pragma("unroll") for (int n = 0; n < 2; ++n) _Pragma("unroll") for (int k = 0; k < 2; ++k) \
        acc[ai][bj][m][n] = __builtin_amdgcn_mfma_f32_16x16x32_bf16(Bt[n][k], At[m][k], acc[ai][bj][m][n], 0, 0, 0); __builtin_amdgcn_s_setprio(0); } while (0)
#define PG8_WAIT_V(n) asm volatile("s_waitcnt vmcnt(" #n ")" ::: "memory")
#define PG8_WAIT_L(n) asm volatile("s_waitcnt lgkmcnt(" #n ")" ::: "memory")
#define PG8_BAR __builtin_amdgcn_s_barrier()
#define PG8_SCHED __builtin_amdgcn_sched_barrier(0)
    Unit cur, nxt; int ui = 0;
    if (!S.next(0, cur)) return;
    f32x4 acc[2][2][4][2];
#pragma unroll
    for (int a = 0; a < 2; ++a)
#pragma unroll
        for (int b = 0; b < 2; ++b)
#pragma unroll
            for (int m = 0; m < 4; ++m)
#pragma unroll
                for (int n = 0; n < 2; ++n) acc[a][b][m][n] = (f32x4){0.f, 0.f, 0.f, 0.f};
    bf16x8 At[4][2], B0[2][2], B1[2][2];
    const char* cA = (const char*)g.A + (size_t)cur.pm * tstepA; const char* cB = (const char*)g.Bt + (size_t)cur.pn * tstepB;
    S.a_ready(cur);
    if constexpr (SP2) {
        PG8_STAGE(PG8_SB(0, 0), cB, voffB); PG8_STAGE(PG8_SB(0, 1), cB + hstepB, voffB); PG8_STAGE(PG8_SA(0, 0), cA, voffA); PG8_STAGE(PG8_SA(0, 1), cA + hstepA, voffA);
        if (wr == 1) PG8_BAR;
        PG8_WAIT_V(2); PG8_BAR;
        PG8_STAGE(PG8_SB(1, 0), cB + kstep, voffB); PG8_STAGE(PG8_SA(1, 0), cA + kstep, voffA); PG8_STAGE(PG8_SB(1, 1), cB + hstepB + kstep, voffB);
        PG8_WAIT_V(6); PG8_BAR;
    } else {
        PG8_STAGE(PG8_SB(0, 0), cB, voffB); PG8_STAGE(PG8_SA(0, 0), cA, voffA); PG8_STAGE(PG8_SB(0, 1), cB + hstepB, voffB); PG8_STAGE(PG8_SA(0, 1), cA + hstepA, voffA);
        if (wr == 1) PG8_BAR;
        PG8_WAIT_V(4); PG8_BAR;
        PG8_STAGE(PG8_SB(1, 0), cB + kstep, voffB); PG8_STAGE(PG8_SA(1, 0), cA + kstep, voffA); PG8_STAGE(PG8_SB(1, 1), cB + hstepB + kstep, voffB);
        PG8_WAIT_V(6); PG8_BAR;
    }
    for (;;) {
        const bool has_next = S.next(ui + 1, nxt);
        const char* nA = has_next ? (const char*)g.A + (size_t)nxt.pm * tstepA : cA; const char* nB = has_next ? (const char*)g.Bt + (size_t)nxt.pn * tstepB : cB;
        for (int t = 0; t < nt; t += 2) {
            const bool last = (t == nt - 2);
            const char* a1 = cA + (size_t)(t + 1) * kstep;
            const char* a2 = last ? nA : cA + (size_t)(t + 2) * kstep; const char* b2 = last ? nB : cB + (size_t)(t + 2) * kstep;
            const char* a3 = a2 + kstep; const char* b3 = b2 + kstep;
            if (last && has_next) S.a_ready(nxt);
            if constexpr (SP2) {
            PG8_LDB(B0, 0, 0); PG8_LDB(B1, 0, 1); PG8_SCHED; PG8_LDA(At, 0, 0); PG8_STAGE(PG8_SA(1, 1), a1 + hstepA, voffA);
            PG8_WAIT_V(8); PG8_WAIT_L(0); PG8_BAR; PG8_MMA(0, 0, At, B0); PG8_MMA(0, 1, At, B1); PG8_BAR; PG8_SCHED;
            PG8_LDA(At, 0, 1); PG8_STAGE(PG8_SB(0, 0), b2, voffB); PG8_STAGE(PG8_SB(0, 1), b2 + hstepB, voffB); PG8_STAGE(PG8_SA(0, 0), a2, voffA);
            PG8_WAIT_V(8); PG8_WAIT_L(0); PG8_BAR; PG8_MMA(1, 0, At, B0); PG8_MMA(1, 1, At, B1); PG8_BAR; PG8_SCHED;
            PG8_LDB(B0, 1, 0); PG8_LDB(B1, 1, 1); PG8_SCHED; PG8_LDA(At, 1, 0); PG8_STAGE(PG8_SA(0, 1), a2 + hstepA, voffA);
            PG8_WAIT_V(8); PG8_WAIT_L(0); PG8_BAR; PG8_MMA(0, 0, At, B0); PG8_MMA(0, 1, At, B1); PG8_BAR; PG8_SCHED;
            PG8_LDA(At, 1, 1); PG8_STAGE(PG8_SB(1, 0), b3, voffB); PG8_STAGE(PG8_SB(1, 1), b3 + hstepB, voffB); PG8_STAGE(PG8_SA(1, 0), a3, voffA);
            PG8_WAIT_V(8); PG8_WAIT_L(0); PG8_BAR; PG8_MMA(1, 0, At, B0); PG8_MMA(1, 1, At, B1); PG8_BAR; PG8_SCHED;
            } else {
            PG8_LDB(B0, 0, 0); PG8_SCHED; PG8_LDA(At, 0, 0); PG8_STAGE(PG8_SA(1, 1), a1 + hstepA, voffA);
            PG8_WAIT_L(8); PG8_BAR; PG8_WAIT_L(0); PG8_MMA(0, 0, At, B0); PG8_BAR; PG8_SCHED;
            PG8_LDB(B1, 0, 1); PG8_STAGE(PG8_SB(0, 0), b2, voffB);
            PG8_BAR; PG8_WAIT_L(0); PG8_MMA(0, 1, At, B1); PG8_BAR;
            PG8_LDA(At, 0, 1); PG8_STAGE(PG8_SA(0, 0), a2, voffA);
            PG8_BAR; PG8_WAIT_L(0); PG8_MMA(1, 0, At, B0); PG8_BAR; PG8_SCHED;
            PG8_STAGE(PG8_SB(0, 1), b2 + hstepB, voffB);
            PG8_WAIT_V(6); PG8_BAR; PG8_MMA(1, 1, At, B1); PG8_BAR;
            PG8_LDB(B0, 1, 0); PG8_SCHED; PG8_LDA(At, 1, 0); PG8_STAGE(PG8_SA(0, 1), a2 + hstepA, voffA);
            PG8_WAIT_L(8); PG8_BAR; PG8_WAIT_L(0); PG8_MMA(0, 0, At, B0); PG8_BAR; PG8_SCHED;
            PG8_LDB(B1, 1, 1); PG8_STAGE(PG8_SB(1, 0), b3, voffB);
            PG8_BAR; PG8_WAIT_L(0); PG8_MMA(0, 1, At, B1); PG8_BAR;
            PG8_LDA(At, 1, 1); PG8_STAGE(PG8_SA(1, 0), a3, voffA);
            PG8_BAR; PG8_WAIT_L(0); PG8_MMA(1, 0, At, B0); PG8_BAR; PG8_SCHED;
            PG8_STAGE(PG8_SB(1, 1), b3 + hstepB, voffB);
            PG8_WAIT_V(6); PG8_BAR; PG8_MMA(1, 1, At, B1); PG8_BAR;
            }
        }
        if constexpr (ALIGN_EPI) { if (wr == 0) PG8_BAR; }
        if constexpr (!Epi::AFTER_DRAIN) { const int t2_ = ::otid(), l2_ = t2_ & 63, w2_ = __builtin_amdgcn_readfirstlane(t2_ >> 6);
            E(acc, cur, w2_ >> 2, w2_ & 3, l2_ & 15, l2_ >> 4); S.done(cur); }
        if (!has_next) break;
#pragma unroll
        for (int a = 0; a < 2; ++a)
#pragma unroll
            for (int b = 0; b < 2; ++b)
#pragma unroll
                for (int m = 0; m < 4; ++m)
#pragma unroll
                    for (int n = 0; n < 2; ++n) acc[a][b][m][n] = (f32x4){0.f, 0.f, 0.f, 0.f};
        cur = nxt; cA = nA; cB = nB; ++ui;
        if constexpr (ALIGN_EPI) { if (wr == 1) PG8_BAR; }
    }
    PG8_WAIT_V(0);
    if constexpr (!ALIGN_EPI) { if (wr == 0) PG8_BAR; }
    PG8_BAR;
    if constexpr (Epi::AFTER_DRAIN) { E.fused(acc, cur, wr, wc, fr, fq, lds, wid, lane); S.done(cur); }
#undef PG8_SA
#undef PG8_SB
#undef PG8_STAGE
#undef PG8_LDA
#undef PG8_LDB
#undef PG8_MMA
#undef PG8_WAIT_V
#undef PG8_WAIT_L
#undef PG8_BAR
#undef PG8_SCHED
}
typedef int v8i32 __attribute__((ext_vector_type(8)));
typedef int v4i32 __attribute__((ext_vector_type(4)));
template <class Epi, class Sched, bool ALIGN_EPI = false, bool SP2 = false>
__device__ __forceinline__ void gemm_phase_f8(PG8_LAS unsigned char* lds, const Gemm g, const Sched& S, const Epi& E) {
    const int tid = ::otid(), wid = __builtin_amdgcn_readfirstlane(tid >> 6), lane = tid & 63, wr = wid >> 2, wc = wid & 3, fr = lane & 15, fq = lane >> 4;
    const int K = g.K, nt = K / BK; const int lda = g.lda ? g.lda : K, ldb = g.ldb ? g.ldb : K;
    unsigned voffA[2], voffB[2];
#pragma unroll
    for (int i = 0; i < 2; ++i) { int R, C; stage_rc(tid * 16 + i * 8192, R, C); const int Rb = Epi::PERM ? ((R & ~31) + perm32(R & 31)) : R;
        voffA[i] = (unsigned)(R * lda + C) * 2u; voffB[i] = (unsigned)(Rb * ldb + C) * 2u; }
    const size_t kstep = (size_t)(BK * 2);
    const size_t hstepA = (size_t)HALF * lda * 2, hstepB = (size_t)HALF * ldb * 2;
    const size_t tstepA = 2 * hstepA, tstepB = 2 * hstepB;
    const unsigned ldsw = (unsigned)wid * 1024u; const unsigned ldsb32 = (unsigned)(size_t)lds;
    const int aoff = lds_byte(wr * 64 + fr, 16 * (fq & 1)) + (fq >> 1) * 1024, boff = lds_byte(wc * 32 + fr, 16 * (fq & 1)) + (fq >> 1) * 1024;
#define PG8_SA(b, h) (((b) * 2 + (h)) * HTB)
#define PG8_SB(b, h) ((4 + (b) * 2 + (h)) * HTB)
#define PG8_STAGE(bufoff, gbase, voff) do { _Pragma("unroll") for (int _i = 0; _i < 2; ++_i) \
        asm volatile("s_mov_b32 m0, %2\n\tglobal_load_lds_dwordx4 %0, %1" :: "v"((voff)[_i]), "s"((const char*)(gbase)), "s"((unsigned)(ldsb32 + (unsigned)(bufoff) + ldsw + (unsigned)(_i * 8192))) : "memory", "m0"); } while (0)
#define PG8_LDA(dst, b, h) do { _Pragma("unroll") for (int m = 0; m < 4; ++m) { const v4i32 lo_ = *(const PG8_LAS v4i32*)(lds + PG8_SA(b, h) + aoff + m * 2048), hi_ = *(const PG8_LAS v4i32*)(lds + PG8_SA(b, h) + aoff + m * 2048 + 16); dst[m] = __builtin_shufflevector(lo_, hi_, 0, 1, 2, 3, 4, 5, 6, 7); } } while (0)
#define PG8_LDB(dst, b, h) do { _Pragma("unroll") for (int n = 0; n < 2; ++n) { const v4i32 lo_ = *(const PG8_LAS v4i32*)(lds + PG8_SB(b, h) + boff + n * 2048), hi_ = *(const PG8_LAS v4i32*)(lds + PG8_SB(b, h) + boff + n * 2048 + 16); dst[n] = __builtin_shufflevector(lo_, hi_, 0, 1, 2, 3, 4, 5, 6, 7); } } while (0)
#define PG8_MMA(ai, bj, At, Bt) do { __builtin_amdgcn_s_setprio(1); _Pragma("unroll") for (int m = 0; m < 4; ++m) _Pragma("unroll") for (int n = 0; n < 2; ++n) \
        acc[ai][bj][m][n] = __builtin_amdgcn_mfma_scale_f32_16x16x128_f8f6f4(Bt[n], At[m], acc[ai][bj][m][n], 0, 0, 0, 0x7F7F7F7F, 0, 0x7F7F7F7F); \
          \
        asm volatile("" : "+v"(acc[ai][bj][0][0]), "+v"(acc[ai][bj][0][1]), "+v"(acc[ai][bj][1][0]), "+v"(acc[ai][bj][1][1]), "+v"(acc[ai][bj][2][0]), "+v"(acc[ai][bj][2][1]), "+v"(acc[ai][bj][3][0]), "+v"(acc[ai][bj][3][1])); \
        __builtin_amdgcn_s_setprio(0); } while (0)
#define PG8_WAIT_V(n) asm volatile("s_waitcnt vmcnt(" #n ")" ::: "memory")
#define PG8_WAIT_L(n) asm volatile("s_waitcnt lgkmcnt(" #n ")" ::: "memory")
#define PG8_BAR __builtin_amdgcn_s_barrier()
#define PG8_SCHED __builtin_amdgcn_sched_barrier(0)
    Unit cur, nxt; int ui = 0;
    if (!S.next(0, cur)) return;
    f32x4 acc[2][2][4][2];
#pragma unroll
    for (int a = 0; a < 2; ++a)
#pragma unroll
        for (int b = 0; b < 2; ++b)
#pragma unroll
            for (int m = 0; m < 4; ++m)
#pragma unroll
                for (int n = 0; n < 2; ++n) acc[a][b][m][n] = (f32x4){0.f, 0.f, 0.f, 0.f};
    v8i32 At[4], B0[2], B1[2];
    const char* cA = (const char*)g.A + (size_t)cur.pm * tstepA; const char* cB = (const char*)g.Bt + (size_t)cur.pn * tstepB;
    S.a_ready(cur);
    if constexpr (SP2) {
        PG8_STAGE(PG8_SB(0, 0), cB, voffB); PG8_STAGE(PG8_SB(0, 1), cB + hstepB, voffB); PG8_STAGE(PG8_SA(0, 0), cA, voffA); PG8_STAGE(PG8_SA(0, 1), cA + hstepA, voffA);
        if (wr == 1) PG8_BAR;
        PG8_WAIT_V(2); PG8_BAR;
        PG8_STAGE(PG8_SB(1, 0), cB + kstep, voffB); PG8_STAGE(PG8_SA(1, 0), cA + kstep, voffA); PG8_STAGE(PG8_SB(1, 1), cB + hstepB + kstep, voffB);
        PG8_WAIT_V(6); PG8_BAR;
    } else {
        PG8_STAGE(PG8_SB(0, 0), cB, voffB); PG8_STAGE(PG8_SA(0, 0), cA, voffA); PG8_STAGE(PG8_SB(0, 1), cB + hstepB, voffB); PG8_STAGE(PG8_SA(0, 1), cA + hstepA, voffA);
        if (wr == 1) PG8_BAR;
        PG8_WAIT_V(4); PG8_BAR;
        PG8_STAGE(PG8_SB(1, 0), cB + kstep, voffB); PG8_STAGE(PG8_SA(1, 0), cA + kstep, voffA); PG8_STAGE(PG8_SB(1, 1), cB + hstepB + kstep, voffB);
        PG8_WAIT_V(6); PG8_BAR;
    }
    for (;;) {
        const bool has_next = S.next(ui + 1, nxt);
        const char* nA = has_next ? (const char*)g.A + (size_t)nxt.pm * tstepA : cA; const char* nB = has_next ? (const char*)g.Bt + (size_t)nxt.pn * tstepB : cB;
#pragma unroll 1
        for (int t = 0; t < nt; t += 2) {
            const bool last = (t == nt - 2);
            const char* a1 = cA + (size_t)(t + 1) * kstep;
            const char* a2 = last ? nA : cA + (size_t)(t + 2) * kstep; const char* b2 = last ? nB : cB + (size_t)(t + 2) * kstep;
            const char* a3 = a2 + kstep; const char* b3 = b2 + kstep;
            if (last && has_next) S.a_ready(nxt);
            if constexpr (SP2) {
            PG8_LDB(B0, 0, 0); PG8_LDB(B1, 0, 1); PG8_SCHED; PG8_LDA(At, 0, 0); PG8_STAGE(PG8_SA(1, 1), a1 + hstepA, voffA);
            PG8_WAIT_V(8); PG8_WAIT_L(0); PG8_BAR; PG8_MMA(0, 0, At, B0); PG8_MMA(0, 1, At, B1); PG8_BAR; PG8_SCHED;
            PG8_LDA(At, 0, 1); PG8_STAGE(PG8_SB(0, 0), b2, voffB); PG8_STAGE(PG8_SB(0, 1), b2 + hstepB, voffB); PG8_STAGE(PG8_SA(0, 0), a2, voffA);
            PG8_WAIT_V(8); PG8_WAIT_L(0); PG8_BAR; PG8_MMA(1, 0, At, B0); PG8_MMA(1, 1, At, B1); PG8_BAR; PG8_SCHED;
            PG8_LDB(B0, 1, 0); PG8_LDB(B1, 1, 1); PG8_SCHED; PG8_LDA(At, 1, 0); PG8_STAGE(PG8_SA(0, 1), a2 + hstepA, voffA);
            PG8_WAIT_V(8); PG8_WAIT_L(0); PG8_BAR; PG8_MMA(0, 0, At, B0); PG8_MMA(0, 1, At, B1); PG8_BAR; PG8_SCHED;
            PG8_LDA(At, 1, 1); PG8_STAGE(PG8_SB(1, 0), b3, voffB); PG8_STAGE(PG8_SB(1, 1), b3 + hstepB, voffB); PG8_STAGE(PG8_SA(1, 0), a3, voffA);
            PG8_WAIT_V(8); PG8_WAIT_L(0); PG8_BAR; PG8_MMA(1, 0, At, B0); PG8_MMA(1, 1, At, B1); PG8_BAR; PG8_SCHED;
            } else {
            PG8_LDB(B0, 0, 0); PG8_SCHED; PG8_LDA(At, 0, 0); PG8_STAGE(PG8_SA(1, 1), a1 + hstepA, voffA);
            PG8_WAIT_L(8); PG8_BAR; PG8_WAIT_L(0); PG8_MMA(0, 0, At, B0); PG8_BAR; PG8_SCHED;
            PG8_LDB(B1, 0, 1); PG8_STAGE(PG8_SB(0, 0), b2, voffB);
            PG8_BAR; PG8_WAIT_L(0); PG8_MMA(0, 1, At, B1); PG8_BAR;
            PG8_LDA(At, 0, 1); PG8_STAGE(PG8_SA(0, 0), a2, voffA);
            PG8_BAR; PG8_WAIT_L(0); PG8_MMA(1, 0, At, B0); PG8_BAR; PG8_SCHED;
            PG8_STAGE(PG8_SB(0, 1), b2 + hstepB, voffB);
            PG8_WAIT_V(6); PG8_BAR; PG8_MMA(1, 1, At, B1); PG8_BAR;
            PG8_LDB(B0, 1, 0); PG8_SCHED; PG8_LDA(At, 1, 0); PG8_STAGE(PG8_SA(0, 1), a2 + hstepA, voffA);
            PG8_WAIT_L(8); PG8_BAR; PG8_WAIT_L(0); PG8_MMA(0, 0, At, B0); PG8_BAR; PG8_SCHED;
            PG8_LDB(B1, 1, 1); PG8_STAGE(PG8_SB(1, 0), b3, voffB);
            PG8_BAR; PG8_WAIT_L(0); PG8_MMA(0, 1, At, B1); PG8_BAR;
            PG8_LDA(At, 1, 1); PG8_STAGE(PG8_SA(1, 0), a3, voffA);
            PG8_BAR; PG8_WAIT_L(0); PG8_MMA(1, 0, At, B0); PG8_BAR; PG8_SCHED;
            PG8_STAGE(PG8_SB(1, 1), b3 + hstepB, voffB);
            PG8_WAIT_V(6); PG8_BAR; PG8_MMA(1, 1, At, B1); PG8_BAR;
            }
        }
        if constexpr (ALIGN_EPI) { if (wr == 0) PG8_BAR; }
        if constexpr (!Epi::AFTER_DRAIN) { const int t2_ = ::otid(), l2_ = t2_ & 63, w2_ = __builtin_amdgcn_readfirstlane(t2_ >> 6);
            E(acc, cur, w2_ >> 2, w2_ & 3, l2_ & 15, l2_ >> 4); S.done(cur); }
        if (!has_next) break;
#pragma unroll
        for (int a = 0; a < 2; ++a)
#pragma unroll
            for (int b = 0; b < 2; ++b)
#pragma unroll
                for (int m = 0; m < 4; ++m)
#pragma unroll
                    for (int n = 0; n < 2; ++n) acc[a][b][m][n] = (f32x4){0.f, 0.f, 0.f, 0.f};
        cur = nxt; cA = nA; cB = nB; ++ui;
        if constexpr (ALIGN_EPI) { if (wr == 1) PG8_BAR; }
    }
    PG8_WAIT_V(0);
    if constexpr (!ALIGN_EPI) { if (wr == 0) PG8_BAR; }
    PG8_BAR;
    if constexpr (Epi::AFTER_DRAIN) { E.fused(acc, cur, wr, wc, fr, fq, lds, wid, lane); S.done(cur); }
#undef PG8_SA
#undef PG8_SB
#undef PG8_STAGE
#undef PG8_LDA
#undef PG8_LDB
#undef PG8_MMA
#undef PG8_WAIT_V
#undef PG8_WAIT_L
#undef PG8_BAR
#undef PG8_SCHED
}
}

#ifndef PG8_SP2
#define PG8_SP2 true
#endif
#ifndef PG8_ALIGN
#define PG8_ALIGN true
#endif
typedef pg8::bf16_t bf16_t;
__device__ __forceinline__ unsigned f2bf(float f) { return pg8::cvt_pk_bf16(f, f) & 0xffffu; }
__device__ __forceinline__ unsigned pk2(float lo, float hi) { return pg8::cvt_pk_bf16(lo, hi); }
__device__ __forceinline__ float bf2f(unsigned short b) { return __builtin_bit_cast(float, ((unsigned)b) << 16); }
__device__ __forceinline__ unsigned pk4_fp8(float a, float b, float c, float d) { unsigned r = 0; r = __builtin_amdgcn_cvt_pk_fp8_f32(a, b, r, false); r = __builtin_amdgcn_cvt_pk_fp8_f32(c, d, r, true); return r; }

struct EpiF32R {
    static constexpr bool PERM = false, AFTER_DRAIN = false;
    float* C; int ldc; const float* R; int ncols; float* C2; int ldc2; int split; int nN;
    __device__ __forceinline__ void operator()(const pg8::f32x4 (&acc)[2][2][4][2], const pg8::Unit& u, int wr, int wc, int fr, int fq) const {
        const int row0 = u.pm * 256 + wr * 64 + fr, col0 = (nN ? (u.pn % nN) : u.pn) * 256 + wc * 32 + 4 * fq;
#pragma unroll
        for (int ai = 0; ai < 2; ++ai)
#pragma unroll
            for (int m = 0; m < 4; ++m) { const size_t row = (size_t)(row0 + ai * 128 + m * 16);
#pragma unroll
                for (int bj = 0; bj < 2; ++bj)
#pragma unroll
                    for (int n = 0; n < 2; ++n) { const int col = col0 + bj * 128 + n * 16;
                        if (col < ncols) {
                            pg8::f32x4 v = acc[ai][bj][m][n];
                            if (col < split) { if (R) v += *(const pg8::f32x4*)(R + row * ldc + col); *(pg8::f32x4*)(C + row * ldc + col) = v; }
                            else *(pg8::f32x4*)(C2 + row * ldc2 + (col - split)) = v;
                        } } }
    }
};
__device__ __forceinline__ float row_rstd(const float* ssq, int row) {
    const pg8::f32x4* p4 = (const pg8::f32x4*)(ssq + (size_t)row * 16); const pg8::f32x4 a = p4[0], b = p4[1], c = p4[2], d = p4[3];
    const float t = ((a[0] + a[1]) + (a[2] + a[3])) + ((b[0] + b[1]) + (b[2] + b[3])) + ((c[0] + c[1]) + (c[2] + c[3])) + ((d[0] + d[1]) + (d[2] + d[3]));
    return 1.0f / sqrtf(t * (1.0f / 1024.0f) + NORM_EPS);
}
struct EpiSwiGLU {
    static constexpr bool PERM = true, AFTER_DRAIN = false;
    bf16_t* H; int ldh; int nN; int row_shift; const float* ssq;
    __device__ __forceinline__ void operator()(const pg8::f32x4 (&acc)[2][2][4][2], const pg8::Unit& u, int wr, int wc, int fr, int fq) const {
        const int row0 = u.pm * 256 + wr * 64 + fr + row_shift; const int pnl = nN ? (u.pn % nN) : u.pn;
        const int hc0 = (pnl * 256 + wc * 32 + 8 * fq) >> 1;
#pragma unroll
        for (int ai = 0; ai < 2; ++ai)
#pragma unroll
            for (int m = 0; m < 4; ++m) { bf16_t* rowp = H + (size_t)(row0 + ai * 128 + m * 16) * ldh + hc0; const float rs = ssq ? row_rstd(ssq, row0 + ai * 128 + m * 16) : 1.0f;
#pragma unroll
                for (int bj = 0; bj < 2; ++bj) { const pg8::f32x4 g = acc[ai][bj][m][0] * rs, up = acc[ai][bj][m][1] * rs; float o[4];
#pragma unroll
                    for (int j = 0; j < 4; ++j) o[j] = g[j] * __builtin_amdgcn_rcpf(1.0f + __expf(-g[j])) * up[j];
                    uint2 w; w.x = pg8::cvt_pk_bf16(o[0], o[1]); w.y = pg8::cvt_pk_bf16(o[2], o[3]);
                    *(uint2*)(rowp + bj * 64) = w; } }
    }
};
struct EpiBf16P {
    static constexpr bool PERM = true, AFTER_DRAIN = false;
    bf16_t* O; int ldc; int nN; int row_shift; const float* ssq;
    __device__ __forceinline__ void operator()(const pg8::f32x4 (&acc)[2][2][4][2], const pg8::Unit& u, int wr, int wc, int fr, int fq) const {
        const int row0 = u.pm * 256 + wr * 64 + fr + row_shift; const int pnl = nN ? (u.pn % nN) : u.pn;
        const int col0 = pnl * 256 + wc * 32 + 8 * fq;
#pragma unroll
        for (int ai = 0; ai < 2; ++ai)
#pragma unroll
            for (int m = 0; m < 4; ++m) { bf16_t* rowp = O + (size_t)(row0 + ai * 128 + m * 16) * ldc + col0; const float rs = ssq ? row_rstd(ssq, row0 + ai * 128 + m * 16) : 1.0f;
#pragma unroll
                for (int bj = 0; bj < 2; ++bj) { const pg8::f32x4 v0 = acc[ai][bj][m][0] * rs, v1 = acc[ai][bj][m][1] * rs;
                    pg8::u32x4 w; w.x = pg8::cvt_pk_bf16(v0[0], v0[1]); w.y = pg8::cvt_pk_bf16(v0[2], v0[3]); w.z = pg8::cvt_pk_bf16(v1[0], v1[1]); w.w = pg8::cvt_pk_bf16(v1[2], v1[3]);
                    *(pg8::u32x4*)(rowp + bj * 128) = w; } }
    }
};


template <bool HALFN> struct EpiF32S {
    static constexpr bool PERM = false, AFTER_DRAIN = false;
    float* C; int ldc; int nN;
    __device__ __forceinline__ void operator()(const pg8::f32x4 (&acc)[2][2][4][2], const pg8::Unit& u, int wr, int wc, int fr, int fq) const {
        const int row0 = u.pm * 256 + wr * 64 + fr, col0 = (nN ? (u.pn % nN) : u.pn) * 256 + wc * 32 + 4 * fq;
#pragma unroll
        for (int ai = 0; ai < 2; ++ai)
#pragma unroll
            for (int m = 0; m < 4; ++m) { float* rowp = C + (size_t)(row0 + ai * 128 + m * 16) * ldc + col0;
#pragma unroll
                for (int bj = 0; bj < (HALFN ? 1 : 2); ++bj)
#pragma unroll
                    for (int n = 0; n < 2; ++n) *(pg8::f32x4*)(rowp + bj * 128 + n * 16) = acc[ai][bj][m][n]; }
    }
};
struct EpiRes {
    static constexpr bool PERM = false, AFTER_DRAIN = false;
    const float* R32; bf16_t* Hb; float* ssq;
    __device__ __forceinline__ void operator()(const pg8::f32x4 (&acc)[2][2][4][2], const pg8::Unit& u, int wr, int wc, int fr, int fq) const {
        const int row0 = u.pm * 256 + wr * 64 + fr, col0 = u.pn * 256 + wc * 32 + 4 * fq;
#pragma unroll
        for (int ai = 0; ai < 2; ++ai)
#pragma unroll
            for (int m = 0; m < 4; ++m) { const size_t row = (size_t)(row0 + ai * 128 + m * 16); float sq = 0.f;
#pragma unroll
                for (int bj = 0; bj < 2; ++bj)
#pragma unroll
                    for (int n = 0; n < 2; ++n) { const int col = col0 + bj * 128 + n * 16;
                        pg8::f32x4 v = acc[ai][bj][m][n];
                        if (R32) v += *(const pg8::f32x4*)(R32 + row * D + col);
                        else { const uint2 rw = *(const uint2*)(Hb + row * D + col);
                            v[0] += bf2f((unsigned short)(rw.x & 0xffff)); v[1] += bf2f((unsigned short)(rw.x >> 16)); v[2] += bf2f((unsigned short)(rw.y & 0xffff)); v[3] += bf2f((unsigned short)(rw.y >> 16)); }
                        uint2 w; w.x = pg8::cvt_pk_bf16(v[0], v[1]); w.y = pg8::cvt_pk_bf16(v[2], v[3]); *(uint2*)(Hb + row * D + col) = w;
                        sq += (v[0] * v[0] + v[1] * v[1]) + (v[2] * v[2] + v[3] * v[3]); }
                sq += __shfl_xor(sq, 16); sq += __shfl_xor(sq, 32); if (fq == 0) ssq[row * 16 + u.pn * 4 + wc] = sq; }
    }
};
struct EpiGLU {
    static constexpr bool PERM = true, AFTER_DRAIN = false;
    const float* YS; const float* bglu; bf16_t* YMIX;
    __device__ __forceinline__ void operator()(const pg8::f32x4 (&acc)[2][2][4][2], const pg8::Unit& u, int wr, int wc, int fr, int fq) const {
        const int row0 = u.pm * 256 + wr * 64 + fr, col0 = u.pn * 256 + wc * 32 + 8 * fq;
#pragma unroll
        for (int ai = 0; ai < 2; ++ai)
#pragma unroll
            for (int m = 0; m < 4; ++m) { const size_t row = (size_t)(row0 + ai * 128 + m * 16);
#pragma unroll
                for (int bj = 0; bj < 2; ++bj) { const int col = col0 + bj * 128;
                    const pg8::f32x4 y0 = *(const pg8::f32x4*)(YS + row * 512 + col), y1 = *(const pg8::f32x4*)(YS + row * 512 + col + 4);
                    const pg8::f32x4 b0 = *(const pg8::f32x4*)(bglu + col), b1 = *(const pg8::f32x4*)(bglu + col + 4);
                    const pg8::f32x4 a0 = acc[ai][bj][m][0] + b0, a1 = acc[ai][bj][m][1] + b1; float o[8];
#pragma unroll
                    for (int j = 0; j < 4; ++j) { o[j] = y0[j] * __builtin_amdgcn_rcpf(1.0f + __expf(-a0[j])); o[4 + j] = y1[j] * __builtin_amdgcn_rcpf(1.0f + __expf(-a1[j])); }
                    pg8::u32x4 w; w.x = pg8::cvt_pk_bf16(o[0], o[1]); w.y = pg8::cvt_pk_bf16(o[2], o[3]); w.z = pg8::cvt_pk_bf16(o[4], o[5]); w.w = pg8::cvt_pk_bf16(o[6], o[7]);
                    *(pg8::u32x4*)(YMIX + row * 1024 + 512 + col) = w; } }
    }
};

struct EpiQKV {
    static constexpr bool PERM = true, AFTER_DRAIN = false;
    bf16_t* O; const float* ssq; const float* qg; const float* kg;
    __device__ __forceinline__ void operator()(const pg8::f32x4 (&acc)[2][2][4][2], const pg8::Unit& u, int wr, int wc, int fr, int fq) const {
        const int row0 = u.pm * 256 + wr * 64 + fr; const int G = 4 * u.pn + wc;
        const float* gp = G < 16 ? qg : kg; const float post = G < 16 ? 0.125f * 1.4426950408889634f : 1.0f;
        pg8::f32x4 gv[2][2];
#pragma unroll
        for (int bj = 0; bj < 2; ++bj)
#pragma unroll
            for (int n = 0; n < 2; ++n) gv[bj][n] = (G < 32) ? *(const pg8::f32x4*)(gp + 32 * bj + 8 * fq + 4 * n) * post : (pg8::f32x4){1.f, 1.f, 1.f, 1.f};
#pragma unroll
        for (int ai = 0; ai < 2; ++ai)
#pragma unroll
            for (int m = 0; m < 4; ++m) { const int row = row0 + ai * 128 + m * 16; const float rs = row_rstd(ssq, row);
                pg8::f32x4 v[2][2]; float sq = 0.f;
#pragma unroll
                for (int bj = 0; bj < 2; ++bj)
#pragma unroll
                    for (int n = 0; n < 2; ++n) { v[bj][n] = acc[ai][bj][m][n] * rs; sq += (v[bj][n][0] * v[bj][n][0] + v[bj][n][1] * v[bj][n][1]) + (v[bj][n][2] * v[bj][n][2] + v[bj][n][3] * v[bj][n][3]); }
                sq += __shfl_xor(sq, 16); sq += __shfl_xor(sq, 32);
                const float rn = (G < 32) ? frsq(sq * (1.0f / 64.0f) + NORM_EPS) : 1.0f;
                bf16_t* rowp = O + (size_t)row * 3072 + 64 * G + 8 * fq;
#pragma unroll
                for (int bj = 0; bj < 2; ++bj) { const pg8::f32x4 a = v[bj][0] * rn * gv[bj][0], b = v[bj][1] * rn * gv[bj][1];
                    pg8::u32x4 w; w.x = pg8::cvt_pk_bf16(a[0], a[1]); w.y = pg8::cvt_pk_bf16(a[2], a[3]); w.z = pg8::cvt_pk_bf16(b[0], b[1]); w.w = pg8::cvt_pk_bf16(b[2], b[3]);
                    *(pg8::u32x4*)(rowp + 32 * bj) = w; } }
    }
};
struct MoeOrder {
    const int* cnt; int nN, G, c, t_lo, t_hi, pm_base;
    __device__ __forceinline__ bool next(int i, pg8::Unit& u) const {
        int ts[9]; ts[0] = 0;
#pragma unroll
        for (int e = 0; e < 8; ++e) ts[e + 1] = ts[e] + ((__builtin_amdgcn_readfirstlane(cnt[e]) + 255) >> 8);
        const int tend = t_hi < ts[8] ? t_hi : ts[8]; const int nt = tend - t_lo; if (nt <= 0) return false;
        const long L = (long)i * G + c; if (L >= (long)nt * nN) return false;
        const int per = 8 * nN; const int grp = (int)(L / per), r = (int)(L % per);
        const int gt0 = grp * 8; const int gsz = (nt - gt0) < 8 ? (nt - gt0) : 8;
        const int tile = t_lo + gt0 + (r % gsz), pn = r / gsz;
        int e = 0;
#pragma unroll
        for (int j = 1; j < 8; ++j) e += (tile >= ts[j]) ? 1 : 0;
        u.pm = __builtin_amdgcn_readfirstlane(tile - pm_base); u.pn = __builtin_amdgcn_readfirstlane(e * nN + pn); return true;
    }
    __device__ __forceinline__ void a_ready(const pg8::Unit&) const {}
    __device__ __forceinline__ void done(const pg8::Unit&) const {}
};

struct WC { const float* W; int ldw; int K; int ncols; int npad; bf16_t* WT; int rbase; int rs4; int ldt; int koff; int nkt_out; const float* kscale; int qkvmap; };
__device__ __forceinline__ int wc_nblk(const WC& w) { const int nkt = w.ldt ? w.nkt_out : w.K / 64, nnt = (w.npad + 63) / 64; return (nkt >> 1) * (nnt >> 2); }
__device__ __forceinline__ void ph_wconv(const WC w, float* lds, int vb = -1, int vg = 0, int rot = 0) {
    const int TIDX = otid();
    const int lane = TIDX & 63, wave = TIDX >> 6;
    unsigned char* scr = (unsigned char*)lds + wave * 9216;
    const int nwg = vb >= 0 ? vg : (int)gridDim.x; int wgid = (vb >= 0 ? vb : (int)blockIdx.x) - rot; if (wgid < 0) wgid += nwg;
    const int nkt = w.ldt ? w.nkt_out : w.K / 64, nnt = (w.npad + 63) / 64; const int ldt = w.ldt ? w.ldt : w.K;
    const int bk = nkt >> 1, bn = nnt >> 2;
    const int g = lane >> 4, l15 = lane & 15;
    float4 va[8], vb4[8];
#define WCONV_LOAD(bt) do { const int kt_ = 2 * ((bt) % bk) + (wave & 1), nt_ = 4 * ((bt) / bk) + (wave >> 1); const int k0_ = kt_ * 64, ncol_ = nt_ * 64 + 4 * l15; const bool cv_ = ncol_ < w.ncols; \
        const float* wp_ = w.W + (size_t)(k0_ + 2 * g) * w.ldw + ncol_; \
        _Pragma("unroll") for (int j = 0; j < 8; ++j) { va[j] = make_float4(0.f, 0.f, 0.f, 0.f); vb4[j] = va[j]; \
            if (cv_ && k0_ + 8 * j + 2 * g < w.K) va[j] = *(const float4*)(wp_ + (size_t)(8 * j) * w.ldw); \
            if (cv_ && k0_ + 8 * j + 2 * g + 1 < w.K) vb4[j] = *(const float4*)(wp_ + (size_t)(8 * j + 1) * w.ldw); } } while (0)
    int bt = wgid;
    if (bt < bk * bn) WCONV_LOAD(bt);
#pragma unroll 1
    for (; bt < bk * bn; bt += nwg) {
        const int kt = 2 * (bt % bk) + (wave & 1), nt = 4 * (bt / bk) + (wave >> 1); const int k0 = kt * 64, n0 = nt * 64;
#pragma unroll
        for (int j = 0; j < 8; ++j) {
            float4 a = va[j], b = vb4[j];
            if (w.kscale) { const float sa = w.kscale[k0 + 8 * j + 2 * g], sb = w.kscale[k0 + 8 * j + 2 * g + 1]; a.x *= sa; a.y *= sa; a.z *= sa; a.w *= sa; b.x *= sb; b.y *= sb; b.z *= sb; b.w *= sb; }
            const int kb = (8 * j + 2 * g) * 2;
            *(unsigned*)(scr + (4 * l15 + 0) * 144 + kb) = pk2(a.x, b.x);
            *(unsigned*)(scr + (4 * l15 + 1) * 144 + kb) = pk2(a.y, b.y);
            *(unsigned*)(scr + (4 * l15 + 2) * 144 + kb) = pk2(a.z, b.z);
            *(unsigned*)(scr + (4 * l15 + 3) * 144 + kb) = pk2(a.w, b.w);
        }
        if (bt + nwg < bk * bn) WCONV_LOAD(bt + nwg);
        asm volatile("s_waitcnt lgkmcnt(0)" ::: "memory");
#pragma unroll
        for (int i = 0; i < 8; ++i) {
            const int nl = 8 * i + (lane >> 3), ch = lane & 7; const int n = n0 + nl;
            const uint4 v = *(const uint4*)(scr + nl * 144 + ch * 16);
            if (n < w.npad) { int drow = w.rbase + (n >> 2) * w.rs4 + (n & 3); if (w.qkvmap) { const int G_ = n >> 6, d_ = n & 63; drow = 256 * (G_ >> 2) + 128 * (d_ >> 5) + 32 * (G_ & 3) + (d_ & 31); }
                int dk = w.koff + k0; if (dk >= ldt) dk -= ldt; *(uint4*)(w.WT + (size_t)drow * ldt + dk + 8 * ch) = v; }
        }
        asm volatile("s_waitcnt lgkmcnt(0)" ::: "memory");
    }
#undef WCONV_LOAD
}

__device__ __forceinline__ void ph_rmsnorm(const float* __restrict__ x, const float* __restrict__ gain, bf16_t* __restrict__ out, int rows) {
    const int TIDX = otid();
    const int lane = TIDX & 63, wave = TIDX >> 6;
    const int gw = blockIdx.x * 8 + wave, NGW = gridDim.x * 8;
#pragma unroll 2
    for (int r = gw; r < rows; r += NGW) {
        const float4* xr = (const float4*)(x + (size_t)r * D) + lane;
        float4 v[4]; float s = 0.f;
#pragma unroll
        for (int j = 0; j < 4; ++j) { v[j] = xr[64 * j]; s += v[j].x * v[j].x + v[j].y * v[j].y + v[j].z * v[j].z + v[j].w * v[j].w; }
        s = wave_sum(s);
        const float rs = 1.0f / sqrtf(s * (1.0f / D) + NORM_EPS);
        uint2* o = (uint2*)(out + (size_t)r * D) + lane;
#pragma unroll
        for (int j = 0; j < 4; ++j) { const float4 g = ((const float4*)gain)[lane + 64 * j]; uint2 w; w.x = pk2(v[j].x * rs * g.x, v[j].y * rs * g.y); w.y = pk2(v[j].z * rs * g.z, v[j].w * rs * g.w); o[64 * j] = w; }
    }
}

struct GD { const float* A; int lda; const int* arow; const int* mcnt; int M; const float* B; const float* B2; int ldb; int K; int N;
            float* C; int ldc; int mode; const float* R; const float* gw; const int* crow; };
struct RwkvP { const float *mu, *w0, *w_up, *a0, *a_up, *g_up, *k_k, *k_a, *r_k, *ln_w, *ln_b; };
struct S5P { const float *lre, *lim, *ldt, *bre, *bim, *cre, *cim, *dsk; };
struct DAP { const float *lq1, *lk1, *lq2, *lk2, *subg; };
typedef short bf16x8_t __attribute__((ext_vector_type(8)));
typedef short s16x4_t __attribute__((ext_vector_type(4)));
typedef float f32x16_t __attribute__((ext_vector_type(16)));
#define MFMA32(a, b, c) __builtin_amdgcn_mfma_f32_32x32x16_bf16((a), (b), (c), 0, 0, 0)
__device__ __forceinline__ bf16x8_t pack8(float a0, float a1, float a2, float a3, float a4, float a5, float a6, float a7) {
    pg8::u32x4 p; p.x = pg8::cvt_pk_bf16(a0, a1); p.y = pg8::cvt_pk_bf16(a2, a3); p.z = pg8::cvt_pk_bf16(a4, a5); p.w = pg8::cvt_pk_bf16(a6, a7);
    return __builtin_bit_cast(bf16x8_t, p);
}
constexpr int DA_KROW = 144, DA_VROW = 288, DA_KT = 64 * DA_KROW, DA_VT = 64 * DA_VROW, DA_BUF = 2 * DA_KT + DA_VT;
__device__ __forceinline__ void ph_diff_attn_mfma(const bf16_t* __restrict__ QKVb, const DAP p, bf16_t* __restrict__ AO, float* ldsf, unsigned* qctr, const float* __restrict__ qgain, const float* __restrict__ kgain) {
    const int TIDX = otid();
    const int tid = TIDX, lane = tid & 63, wave = __builtin_amdgcn_readfirstlane(tid >> 6);
    const int sub = wave & 3, map = wave >> 2;
    const int r = lane & 31, hh = lane >> 5, blk = (lane >> 4) & 1, i16 = lane & 15, tq = i16 >> 2, tp = i16 & 3;
    unsigned char* lds = (unsigned char*)ldsf;
    float d1 = 0.f, d2 = 0.f;
    for (int i = 0; i < 64; ++i) { d1 += p.lq1[i] * p.lk1[i]; d2 += p.lq2[i] * p.lk2[i]; }
    const float lam = expf(d1) - expf(d2) + LAMBDA_INIT;
    float gqm = 0.f, gkm = 0.f;
    for (int i = 0; i < 64; ++i) { gqm = fmaxf(gqm, fabsf(qgain[i])); gkm = fmaxf(gkm, fabsf(kgain[i])); }
    const float wnum = 2.0f * (8.0f * gqm * gkm * 1.02f) + 8.3178f + 18.0219f;
    const int kr = tid >> 3, c8 = tid & 7;
    volatile int* unit_word = (volatile int*)(lds + 2 * DA_BUF);
#pragma unroll 1
    for (;;) {
        __syncthreads();
        if (tid == 0) *unit_word = (int)atomicAdd(qctr, 1u);
        __syncthreads();
        const int rank = *unit_word;
        if (rank >= NB * 8 * 32) break;
        {
            const int qb = 31 - (rank >> 5); const int bh = rank & 31; const int b = bh >> 3, h = 7 - (bh & 7);
            const float slope = fexp2(-(float)(h + 1));
            const float slope2 = slope * 1.4426950408889634f;
            const float wf = ceilf(wnum / (64.0f * slope)); const int Wh = wf > 64.f ? 64 : (int)wf;
            const int row0 = qb * 128 + sub * 32; const int cq = qb * 2 + (sub >> 1); const int nt = qb * 2 + 2;
            const int t_first = (qb * 2 - Wh) > 0 ? (qb * 2 - Wh) : 0;
            const size_t tokb = (size_t)b * T;
            bf16x8_t qf[4];
            { const bf16_t* qp = QKVb + (tokb + row0 + r) * 3072 + h * 128 + map * 64 + 8 * hh;
#pragma unroll
              for (int s = 0; s < 4; ++s) qf[s] = *(const bf16x8_t*)(qp + 16 * s); }
            const float qpos = (float)(row0 + r);
            f32x16_t O[4];
#pragma unroll
            for (int dt = 0; dt < 4; ++dt)
#pragma unroll
                for (int i = 0; i < 16; ++i) O[dt][i] = 0.f;
            float m = -1e30f, l = 0.f;
            typedef unsigned u32x4b __attribute__((ext_vector_type(4)));
            const __amdgpu_buffer_rsrc_t rsrc = __builtin_amdgcn_make_buffer_rsrc((void*)QKVb, 0, (int)((size_t)M * 3072 * 2), 0x00020000);
            const int voK = (kr * 3072 + h * 128 + c8 * 8 + 1024) * 2, voV0 = ((tid >> 4) * 3072 + 2048 + h * 128 + (tid & 15) * 8) * 2, voV1 = voV0 + 32 * 3072 * 2;
            u32x4b g0, g1, g2, g3;
            { const int so = (int)((tokb + (size_t)t_first * 64) * 3072 * 2);
              g0 = __builtin_amdgcn_raw_buffer_load_b128(rsrc, voK, so, 0); g1 = __builtin_amdgcn_raw_buffer_load_b128(rsrc, voK + 128, so, 0);
              g2 = __builtin_amdgcn_raw_buffer_load_b128(rsrc, voV0, so, 0); g3 = __builtin_amdgcn_raw_buffer_load_b128(rsrc, voV1, so, 0); }
            __syncthreads();
            { unsigned char* bufp = lds + (t_first & 1) * DA_BUF;
              *(u32x4b*)(bufp + kr * DA_KROW + c8 * 16) = g0; *(u32x4b*)(bufp + DA_KT + kr * DA_KROW + c8 * 16) = g1;
              *(u32x4b*)(bufp + 2 * DA_KT + (tid >> 4) * DA_VROW + (tid & 15) * 16) = g2; *(u32x4b*)(bufp + 2 * DA_KT + ((tid + 512) >> 4) * DA_VROW + (tid & 15) * 16) = g3; }
            __syncthreads();
#pragma unroll 1
            for (int t = t_first; t < nt; ++t) {
                const bool more = (t + 1 < nt);
                if (more) { const int so = (int)((tokb + (size_t)(t + 1) * 64) * 3072 * 2);
                    g0 = __builtin_amdgcn_raw_buffer_load_b128(rsrc, voK, so, 0); g1 = __builtin_amdgcn_raw_buffer_load_b128(rsrc, voK + 128, so, 0);
                    g2 = __builtin_amdgcn_raw_buffer_load_b128(rsrc, voV0, so, 0); g3 = __builtin_amdgcn_raw_buffer_load_b128(rsrc, voV1, so, 0); }
                if (t <= cq && t >= cq - Wh) {
                    const unsigned char* bufp = lds + (t & 1) * DA_BUF;
                    const unsigned char* kp = bufp + map * DA_KT + r * DA_KROW + 16 * hh;
                    f32x16_t x0, x1;
#pragma unroll
                    for (int i = 0; i < 16; ++i) { x0[i] = 0.f; x1[i] = 0.f; }
#pragma unroll
                    for (int s = 0; s < 4; ++s) {
                        const bf16x8_t a0 = *(const bf16x8_t*)(kp + 32 * s), a1 = *(const bf16x8_t*)(kp + 32 * DA_KROW + 32 * s);
                        x0 = MFMA32(a0, qf[s], x0); x1 = MFMA32(a1, qf[s], x1);
                    }
                    const float kb0 = (float)(t * 64 + 4 * hh) - qpos;
                    float mx = -1e30f;
#pragma unroll
                    for (int i = 0; i < 16; ++i) {
                        const float dk = kb0 + (float)((i & 3) + 8 * (i >> 2));
                        x0[i] = __builtin_fmaf(-slope2, fabsf(dk), x0[i]);
                        x1[i] = __builtin_fmaf(-slope2, fabsf(dk + 32.f), x1[i]);
                        mx = fmaxf(mx, fmaxf(x0[i], x1[i]));
                    }
                    mx = fmaxf(mx, __shfl_xor(mx, 32));
                    const float mn = fmaxf(m, mx);
                    const float alpha = fexp2(m - mn);
                    m = mn;
                    float rsum = 0.f;
#pragma unroll
                    for (int i = 0; i < 16; ++i) { x0[i] = fexp2(x0[i] - mn); x1[i] = fexp2(x1[i] - mn); rsum += x0[i] + x1[i]; }
                    l = l * alpha + rsum;
                    if (__any(alpha != 1.0f)) {
#pragma unroll
                        for (int dt = 0; dt < 4; ++dt)
#pragma unroll
                            for (int i = 0; i < 16; ++i) O[dt][i] *= alpha;
                    }
                    const bf16x8_t p00 = pack8(x0[0], x0[1], x0[2], x0[3], x0[4], x0[5], x0[6], x0[7]);
                    const bf16x8_t p01 = pack8(x0[8], x0[9], x0[10], x0[11], x0[12], x0[13], x0[14], x0[15]);
                    const bf16x8_t p10 = pack8(x1[0], x1[1], x1[2], x1[3], x1[4], x1[5], x1[6], x1[7]);
                    const bf16x8_t p11 = pack8(x1[8], x1[9], x1[10], x1[11], x1[12], x1[13], x1[14], x1[15]);
                    const unsigned vbase = (unsigned)(size_t)(bufp + 2 * DA_KT) + (unsigned)((4 * hh + tq) * DA_VROW + 32 * blk + 8 * tp);
#define DA_VREAD(va_, A0, A1, A2, A3, A4, A5, A6, A7) asm volatile("ds_read_b64_tr_b16 %0, %8\n\tds_read_b64_tr_b16 %1, %8 offset:%9\n\tds_read_b64_tr_b16 %2, %8 offset:%10\n\tds_read_b64_tr_b16 %3, %8 offset:%11\n\t" \
                                     "ds_read_b64_tr_b16 %4, %8 offset:%12\n\tds_read_b64_tr_b16 %5, %8 offset:%13\n\tds_read_b64_tr_b16 %6, %8 offset:%14\n\tds_read_b64_tr_b16 %7, %8 offset:%15" \
                                     : "=&v"(A0), "=&v"(A1), "=&v"(A2), "=&v"(A3), "=&v"(A4), "=&v"(A5), "=&v"(A6), "=&v"(A7) \
                                     : "v"(va_), "n"(8 * DA_VROW), "n"(16 * DA_VROW), "n"(24 * DA_VROW), "n"(32 * DA_VROW), "n"(40 * DA_VROW), "n"(48 * DA_VROW), "n"(56 * DA_VROW) : "memory")
#define DA_VWAIT(N, A0, A1, A2, A3, A4, A5, A6, A7) asm volatile("s_waitcnt lgkmcnt(" #N ")" : "+v"(A0), "+v"(A1), "+v"(A2), "+v"(A3), "+v"(A4), "+v"(A5), "+v"(A6), "+v"(A7) :: "memory")
#define DA_PV(dt_, A0, A1, A2, A3, A4, A5, A6, A7) do { \
                        const bf16x8_t a00 = __builtin_shufflevector(A0, A1, 0, 1, 2, 3, 4, 5, 6, 7), a01 = __builtin_shufflevector(A2, A3, 0, 1, 2, 3, 4, 5, 6, 7); \
                        const bf16x8_t a10 = __builtin_shufflevector(A4, A5, 0, 1, 2, 3, 4, 5, 6, 7), a11 = __builtin_shufflevector(A6, A7, 0, 1, 2, 3, 4, 5, 6, 7); \
                        O[dt_] = MFMA32(a00, p00, O[dt_]); O[dt_] = MFMA32(a01, p01, O[dt_]); O[dt_] = MFMA32(a10, p10, O[dt_]); O[dt_] = MFMA32(a11, p11, O[dt_]); } while (0)
                    {
                        s16x4_t e0, e1, e2, e3, e4, e5, e6, e7, f0, f1, f2, f3, f4, f5, f6, f7;
                        DA_VREAD(vbase, e0, e1, e2, e3, e4, e5, e6, e7);
                        DA_VREAD(vbase + 64, f0, f1, f2, f3, f4, f5, f6, f7);
                        DA_VWAIT(8, e0, e1, e2, e3, e4, e5, e6, e7);
                        DA_PV(0, e0, e1, e2, e3, e4, e5, e6, e7);
                        DA_VREAD(vbase + 128, e0, e1, e2, e3, e4, e5, e6, e7);
                        DA_VWAIT(8, f0, f1, f2, f3, f4, f5, f6, f7);
                        DA_PV(1, f0, f1, f2, f3, f4, f5, f6, f7);
                        DA_VREAD(vbase + 192, f0, f1, f2, f3, f4, f5, f6, f7);
                        DA_VWAIT(8, e0, e1, e2, e3, e4, e5, e6, e7);
                        DA_PV(2, e0, e1, e2, e3, e4, e5, e6, e7);
                        DA_VWAIT(0, f0, f1, f2, f3, f4, f5, f6, f7);
                        DA_PV(3, f0, f1, f2, f3, f4, f5, f6, f7);
                    }
                }
                if (more) { unsigned char* bufp = lds + ((t + 1) & 1) * DA_BUF;
                    *(u32x4b*)(bufp + kr * DA_KROW + c8 * 16) = g0; *(u32x4b*)(bufp + DA_KT + kr * DA_KROW + c8 * 16) = g1;
                    *(u32x4b*)(bufp + 2 * DA_KT + (tid >> 4) * DA_VROW + (tid & 15) * 16) = g2; *(u32x4b*)(bufp + 2 * DA_KT + ((tid + 512) >> 4) * DA_VROW + (tid & 15) * 16) = g3; }
                __syncthreads();
            }
            const float lt = l + __shfl_xor(l, 32); const float inv = 1.0f / lt;
            float* xch = ldsf + (size_t)sub * 4096;
            if (map == 1) {
#pragma unroll
                for (int dt = 0; dt < 4; ++dt)
#pragma unroll
                    for (int i = 0; i < 16; ++i) xch[(dt * 16 + i) * 64 + lane] = O[dt][i] * inv;
            }
            __syncthreads();
            if (map == 0) {
                float ss = 0.f;
#pragma unroll
                for (int dt = 0; dt < 4; ++dt)
#pragma unroll
                    for (int i = 0; i < 16; ++i) { const float o = O[dt][i] * inv - lam * xch[(dt * 16 + i) * 64 + lane]; O[dt][i] = o; ss += o * o; }
                ss += __shfl_xor(ss, 32);
                const float rs = (1.0f / sqrtf(ss * (1.0f / 128.0f) + NORM_EPS)) * (1.0f - LAMBDA_INIT);
                bf16_t* op = AO + (tokb + row0 + r) * 1024 + h * 128;
#pragma unroll
                for (int dt = 0; dt < 4; ++dt)
#pragma unroll
                    for (int gq = 0; gq < 4; ++gq) { const int dim = dt * 32 + 8 * gq + 4 * hh; const float4 sg = *(const float4*)(p.subg + dim);
                        uint2 w; w.x = pk2(O[dt][4 * gq] * rs * sg.x, O[dt][4 * gq + 1] * rs * sg.y); w.y = pk2(O[dt][4 * gq + 2] * rs * sg.z, O[dt][4 * gq + 3] * rs * sg.w);
                        *(uint2*)(op + dim) = w; }
            }
        }
    }
    __syncthreads();
}


struct RwkvChunkBufs { bf16_t* AR; bf16_t* BKh; bf16_t* VT; bf16_t* MK; bf16_t* MB; bf16_t* IT; float* bL; };
struct RwkvOps { bf16x8_t ar0, ar1, ar2, ar3, mk, it, mb, bb0, bk0, bb1, bk1, vt; };
__device__ __forceinline__ void ph_knorm_bf16(bf16_t* __restrict__ KVb, const float* __restrict__ kg, const float* __restrict__ qg, int vb, int vg) {
    const int TIDX = otid();
    const int lane = TIDX & 63, wave = TIDX >> 6;
    if (vb < 0) return;
    const int gw = vb * 8 + wave, NGW = vg * 8;
    for (int row = gw; row < NB * MEML; row += NGW) {
        uint4* rowp = (uint4*)(KVb + (size_t)row * 2048);
#pragma unroll
        for (int j = 0; j < 2; ++j) {
            const int ch = lane + 64 * j;
            const uint4 v = rowp[ch];
            const unsigned w[4] = {v.x, v.y, v.z, v.w}; float f[8]; float ss = 0.f;
#pragma unroll
            for (int q = 0; q < 4; ++q) { f[2 * q] = bf2f((unsigned short)(w[q] & 0xffff)); f[2 * q + 1] = bf2f((unsigned short)(w[q] >> 16)); ss += f[2 * q] * f[2 * q] + f[2 * q + 1] * f[2 * q + 1]; }
            ss += __shfl_xor(ss, 1); ss += __shfl_xor(ss, 2); ss += __shfl_xor(ss, 4); ss += __shfl_xor(ss, 8); ss += __shfl_xor(ss, 16);
            const float rs = 1.0f / sqrtf(ss * (1.0f / 256.0f) + NORM_EPS);
            const int d0 = (ch & 31) * 8;
            const float4 k0 = *(const float4*)(kg + d0), k1 = *(const float4*)(kg + d0 + 4), q0 = *(const float4*)(qg + d0), q1 = *(const float4*)(qg + d0 + 4);
            uint4 o; o.x = pk2(f[0] * rs * k0.x * q0.x, f[1] * rs * k0.y * q0.y); o.y = pk2(f[2] * rs * k0.z * q0.z, f[3] * rs * k0.w * q0.w);
            o.z = pk2(f[4] * rs * k1.x * q1.x, f[5] * rs * k1.y * q1.y); o.w = pk2(f[6] * rs * k1.z * q1.z, f[7] * rs * k1.w * q1.w);
            rowp[ch] = o;
        }
    }
}
constexpr int MA_KROW = 528, MA_VROW = 544, MA_KT = 64 * MA_KROW, MA_VT = 64 * MA_VROW;
__device__ __forceinline__ void ph_mem_attn_mfma(const bf16_t* __restrict__ Qb, const bf16_t* __restrict__ KVb, bf16_t* __restrict__ AO, float* ldsf, int u0) {
    const int TIDX = otid();
    const int tid = TIDX, lane = tid & 63, wave = __builtin_amdgcn_readfirstlane(tid >> 6);
    const int sub = wave & 3, dh = wave >> 2;
    const int r = lane & 31, hh = lane >> 5, blk = (lane >> 4) & 1, i16 = lane & 15, tq = i16 >> 2, tp = i16 & 3;
    unsigned char* lds = (unsigned char*)ldsf;
    typedef unsigned u32x4b __attribute__((ext_vector_type(4)));
    const __amdgpu_buffer_rsrc_t rsrc = __builtin_amdgcn_make_buffer_rsrc((void*)KVb, 0, NB * MEML * 2048 * 2, 0x00020000);
#pragma unroll 1
    for (int unit = u0; unit < u0 + 2; ++unit) {
        const int b = unit >> 7, head = (unit >> 5) & 3, qb = unit & 31;
        const int row0 = qb * 128 + sub * 32; const size_t tok = (size_t)b * T + row0 + r;
        bf16x8_t qf[16]; float ss = 0.f;
        { const bf16_t* qp = Qb + tok * 1024 + head * 256 + 8 * hh;
#pragma unroll
          for (int s = 0; s < 16; ++s) { qf[s] = *(const bf16x8_t*)(qp + 16 * s);
#pragma unroll
              for (int j = 0; j < 8; ++j) { const float f = bf2f((unsigned short)qf[s][j]); ss += f * f; } } }
        ss += __shfl_xor(ss, 32);
        const float rq = (1.0f / sqrtf(ss * (1.0f / 256.0f) + NORM_EPS)) * 0.0625f * 1.4426950408889634f;
        f32x16_t O[4];
#pragma unroll
        for (int dt = 0; dt < 4; ++dt)
#pragma unroll
            for (int i = 0; i < 16; ++i) O[dt][i] = 0.f;
        float m = -1e30f, l = 0.f;
        u32x4b g[8];
        const int vo = ((tid >> 5) * 2048 + head * 256 + (tid & 31) * 8) * 2;
#pragma unroll 1
        for (int kt = 0; kt < 4; ++kt) {
            { const int so = (b * MEML + kt * 64) * 2048 * 2;
#pragma unroll
              for (int j = 0; j < 4; ++j) { g[j] = __builtin_amdgcn_raw_buffer_load_b128(rsrc, vo + j * 16 * 4096, so, 0); g[4 + j] = __builtin_amdgcn_raw_buffer_load_b128(rsrc, vo + j * 16 * 4096 + 2048, so, 0); } }
            __syncthreads();
#pragma unroll
            for (int j = 0; j < 4; ++j) { *(u32x4b*)(lds + ((tid >> 5) + 16 * j) * MA_KROW + (tid & 31) * 16) = g[j]; *(u32x4b*)(lds + MA_KT + ((tid >> 5) + 16 * j) * MA_VROW + (tid & 31) * 16) = g[4 + j]; }
            __syncthreads();
            const unsigned char* kp = lds + r * MA_KROW + 16 * hh;
            f32x16_t x0, x1;
#pragma unroll
            for (int i = 0; i < 16; ++i) { x0[i] = 0.f; x1[i] = 0.f; }
#pragma unroll
            for (int s = 0; s < 16; ++s) {
                const bf16x8_t a0 = *(const bf16x8_t*)(kp + 32 * s), a1 = *(const bf16x8_t*)(kp + 32 * MA_KROW + 32 * s);
                x0 = MFMA32(a0, qf[s], x0); x1 = MFMA32(a1, qf[s], x1);
            }
            float mx = -1e30f;
#pragma unroll
            for (int i = 0; i < 16; ++i) { x0[i] *= rq; x1[i] *= rq; mx = fmaxf(mx, fmaxf(x0[i], x1[i])); }
            mx = fmaxf(mx, __shfl_xor(mx, 32));
            const float mn = fmaxf(m, mx); const float alpha = fexp2(m - mn); m = mn;
            float rsum = 0.f;
#pragma unroll
            for (int i = 0; i < 16; ++i) { x0[i] = fexp2(x0[i] - mn); x1[i] = fexp2(x1[i] - mn); rsum += x0[i] + x1[i]; }
            l = l * alpha + rsum;
            if (__any(alpha != 1.0f)) {
#pragma unroll
                for (int dt = 0; dt < 4; ++dt)
#pragma unroll
                    for (int i = 0; i < 16; ++i) O[dt][i] *= alpha;
            }
            const bf16x8_t p00 = pack8(x0[0], x0[1], x0[2], x0[3], x0[4], x0[5], x0[6], x0[7]);
            const bf16x8_t p01 = pack8(x0[8], x0[9], x0[10], x0[11], x0[12], x0[13], x0[14], x0[15]);
            const bf16x8_t p10 = pack8(x1[0], x1[1], x1[2], x1[3], x1[4], x1[5], x1[6], x1[7]);
            const bf16x8_t p11 = pack8(x1[8], x1[9], x1[10], x1[11], x1[12], x1[13], x1[14], x1[15]);
            const unsigned vbase = (unsigned)(size_t)(lds + MA_KT) + (unsigned)((4 * hh + tq) * MA_VROW + dh * 256 + 32 * blk + 8 * tp);
#pragma unroll
            for (int dt = 0; dt < 4; ++dt) {
                s16x4_t v0, v1, v2, v3, v4, v5, v6, v7;
                const unsigned va = vbase + dt * 64;
                asm volatile("ds_read_b64_tr_b16 %0, %8\n\tds_read_b64_tr_b16 %1, %8 offset:%9\n\tds_read_b64_tr_b16 %2, %8 offset:%10\n\tds_read_b64_tr_b16 %3, %8 offset:%11\n\t"
                             "ds_read_b64_tr_b16 %4, %8 offset:%12\n\tds_read_b64_tr_b16 %5, %8 offset:%13\n\tds_read_b64_tr_b16 %6, %8 offset:%14\n\tds_read_b64_tr_b16 %7, %8 offset:%15\n\ts_waitcnt lgkmcnt(0)"
                             : "=&v"(v0), "=&v"(v1), "=&v"(v2), "=&v"(v3), "=&v"(v4), "=&v"(v5), "=&v"(v6), "=&v"(v7)
                             : "v"(va), "n"(8 * MA_VROW), "n"(16 * MA_VROW), "n"(24 * MA_VROW), "n"(32 * MA_VROW), "n"(40 * MA_VROW), "n"(48 * MA_VROW), "n"(56 * MA_VROW) : "memory");
                const bf16x8_t a00 = __builtin_shufflevector(v0, v1, 0, 1, 2, 3, 4, 5, 6, 7), a01 = __builtin_shufflevector(v2, v3, 0, 1, 2, 3, 4, 5, 6, 7);
                const bf16x8_t a10 = __builtin_shufflevector(v4, v5, 0, 1, 2, 3, 4, 5, 6, 7), a11 = __builtin_shufflevector(v6, v7, 0, 1, 2, 3, 4, 5, 6, 7);
                O[dt] = MFMA32(a00, p00, O[dt]); O[dt] = MFMA32(a01, p01, O[dt]); O[dt] = MFMA32(a10, p10, O[dt]); O[dt] = MFMA32(a11, p11, O[dt]);
            }
        }
        const float lt = l + __shfl_xor(l, 32); const float inv = 1.0f / lt;
        bf16_t* op = AO + tok * 1024 + head * 256 + dh * 128;
#pragma unroll
        for (int dt = 0; dt < 4; ++dt)
#pragma unroll
            for (int gq = 0; gq < 4; ++gq) { const int dim = dt * 32 + 8 * gq + 4 * hh;
                uint2 w; w.x = pk2(O[dt][4 * gq] * inv, O[dt][4 * gq + 1] * inv); w.y = pk2(O[dt][4 * gq + 2] * inv, O[dt][4 * gq + 3] * inv);
                *(uint2*)(op + dim) = w; }
    }
    __syncthreads();
}


__device__ __forceinline__ void ph_lora_in(const bf16_t* __restrict__ ZA, const float* __restrict__ mu, bf16_t* __restrict__ LA, int vb, int vg) {
    const int TIDX = otid();
    const size_t n = (size_t)M * 384;
    if (vb < 0) return;
    for (size_t i = (size_t)vb * NTHR + TIDX; i < n; i += (size_t)vg * NTHR) {
        const int tok = (int)(i / 384), c = (int)(i % 384);
        float val = 0.f;
        if (c < 288) {
            const float cur = bf2f(ZA[(size_t)tok * RCOLS + 1536 + c]); const float prev = (tok % T) ? bf2f(ZA[(size_t)(tok - 1) * RCOLS + 1536 + c]) : 0.f;
            const float m = cur + (prev - cur) * mu[1536 + c];
            val = c < 64 ? ftanh(m) : (c < 128 ? m : fsigmoid(m));
        }
        LA[i] = (bf16_t)f2bf(val);
    }
}
__device__ __forceinline__ void ph_rwkv_chunk_prep2(const bf16_t* __restrict__ ZA, const bf16_t* __restrict__ LORA, const RwkvP p, const RwkvChunkBufs cb, bf16_t* __restrict__ BON, float* ldsf) {
    const int TIDX = otid();
    const int lane = TIDX & 63, wave = __builtin_amdgcn_readfirstlane(TIDX >> 6);
    const int r = lane & 31, hh = lane >> 5;
    unsigned char* scr = (unsigned char*)ldsf + wave * 10240;
    unsigned char* ARs = scr; unsigned char* BKs = scr + 4608; float* Mf = (float*)(scr + 9216);
    const int gw = blockIdx.x * 8 + wave, NGW = gridDim.x * 8;
    const int pos = (lane & ~15) + 8 * ((lane >> 2) & 1) + (lane & 3) + 4 * ((lane >> 3) & 1);
    unsigned short zr[17], zk[17], zv[17], lw[16], la[16];
#define R1_LOAD(chx) do { const int bh_ = (chx) >> 8, c_ = (chx) & 255; const int col_ = (bh_ & 7) * 64 + lane; const size_t tok0_ = (size_t)(bh_ >> 3) * T + c_ * 16; \
        zr[0] = 0; zk[0] = 0; zv[0] = 0; \
        if (c_ > 0) { const bf16_t* zp_ = ZA + (tok0_ - 1) * RCOLS + col_; zr[0] = zp_[0]; zk[0] = zp_[512]; zv[0] = zp_[1024]; } \
        _Pragma("unroll") for (int t = 0; t < 16; ++t) { const bf16_t* z_ = ZA + (tok0_ + t) * RCOLS + col_; const bf16_t* lo_ = LORA + (tok0_ + t) * 1536 + col_; \
            zr[t + 1] = z_[0]; zk[t + 1] = z_[512]; zv[t + 1] = z_[1024]; lw[t] = lo_[0]; la[t] = lo_[512]; } } while (0)
    if (gw < NB * 8 * 256) R1_LOAD(gw);
#pragma unroll 1
    for (int ch = gw; ch < NB * 8 * 256; ch += NGW) {
        const int bh = ch >> 8, c = ch & 255; const int b = bh >> 3, h = bh & 7; const int col = h * 64 + lane;
        const float mu_r = p.mu[col], mu_k = p.mu[512 + col], mu_v = p.mu[1024 + col], w0 = p.w0[col], a0 = p.a0[col], k_k = p.k_k[col], k_a = p.k_a[col], r_k = p.r_k[col];
        const size_t tok0 = (size_t)b * T + c * 16;
        float at[16], rt[16], bt[16], kt[16], vv[16]; float bcum = 1.0f;
        float pr = bf2f(zr[0]), pk = bf2f(zk[0]), pv = bf2f(zv[0]);
        float rr[16], kk2[16], vraw[16], wp[16], ap[16];
#pragma unroll
        for (int t = 0; t < 16; ++t) { const float cr = bf2f(zr[t + 1]), ck = bf2f(zk[t + 1]), cv = bf2f(zv[t + 1]);
            rr[t] = cr + (pr - cr) * mu_r; kk2[t] = ck + (pk - ck) * mu_k; vraw[t] = cv + (pv - cv) * mu_v; pr = cr; pk = ck; pv = cv; wp[t] = w0 + bf2f(lw[t]); ap[t] = a0 + bf2f(la[t]); }
        if (ch + NGW < NB * 8 * 256) R1_LOAD(ch + NGW);
#pragma unroll
        for (int t = 0; t < 16; ++t) {
            const float r_ = rr[t], k_ = kk2[t], v_ = vraw[t];
            const float wpre = wp[t], apre = ap[t];
            const float kkr = k_ * k_k; const float ss = wave_sum_dpp(kkr * kkr);
            const float kkv = kkr * frsq(fmaxf(ss, 1e-24f));
            const float a = fsigmoid(apre); const float kmod = k_ * (1.0f + (a - 1.0f) * k_a);
            const float w = fexp(-fexp(-fsoftplus(-wpre) - 0.5f));
            const float bon = wave_sum_dpp(r_ * kmod * r_k) * v_;
            BON[(tok0 + t) * 512 + col] = (bf16_t)f2bf(bon);
            const float ka = kkv * a;
            vv[t] = v_; at[t] = -bcum * kkv; bcum *= w; rt[t] = bcum * r_; const float ib = frcp(bcum); bt[t] = ka * ib; kt[t] = kmod * ib;
        }
        const float bL = bcum;
#pragma unroll
        for (int t = 0; t < 16; ++t) {
            *(bf16_t*)(ARs + t * 144 + pos * 2) = (bf16_t)f2bf(at[t]); *(bf16_t*)(ARs + (16 + t) * 144 + pos * 2) = (bf16_t)f2bf(rt[t]);
            *(bf16_t*)(BKs + t * 144 + pos * 2) = (bf16_t)f2bf(bt[t]); *(bf16_t*)(BKs + (16 + t) * 144 + pos * 2) = (bf16_t)f2bf(kt[t]);
        }
        asm volatile("s_waitcnt lgkmcnt(0)" ::: "memory");
        f32x16_t x;
#pragma unroll
        for (int i = 0; i < 16; ++i) x[i] = 0.f;
#pragma unroll
        for (int ks = 0; ks < 4; ++ks) {
            const bf16x8_t a = *(const bf16x8_t*)(BKs + r * 144 + ks * 32 + hh * 16), bq = *(const bf16x8_t*)(ARs + r * 144 + ks * 32 + hh * 16);
            x = MFMA32(a, bq, x);
        }
#pragma unroll
        for (int j = 0; j < 8; ++j) { const int sidx = (j & 3) + 8 * (j >> 2) + 4 * hh; const bool keep = (r < 16) ? (sidx < r) : (sidx <= r - 16);
            x[j] = keep ? x[j] : 0.f; x[8 + j] = keep ? x[8 + j] : 0.f; }
        *(bf16x8_t*)(cb.MK + (size_t)ch * 512 + r * 16 + hh * 8) = pack8(x[8], x[9], x[10], x[11], x[12], x[13], x[14], x[15]);
        if (r >= 16) *(bf16x8_t*)(cb.MB + (size_t)ch * 256 + (r - 16) * 16 + hh * 8) = pack8(x[0], x[1], x[2], x[3], x[4], x[5], x[6], x[7]);
        else {
#pragma unroll
            for (int j = 0; j < 8; ++j) Mf[((j & 3) + 8 * (j >> 2) + 4 * hh) * 16 + r] = x[j];
        }
#pragma unroll
        for (int i = 0; i < 4; ++i) { const int q = lane + 64 * i; *(uint4*)((unsigned char*)cb.AR + (size_t)ch * 4096 + q * 16) = *(const uint4*)(ARs + (q >> 3) * 144 + (q & 7) * 16); }
        { bf16_t* bk = cb.BKh + (size_t)ch * 2048 + lane * 32;
#pragma unroll
          for (int hp = 0; hp < 2; ++hp) {
              *(bf16x8_t*)(bk + hp * 8) = pack8(bL * bt[4 * hp], bL * bt[4 * hp + 1], bL * bt[4 * hp + 2], bL * bt[4 * hp + 3], bL * bt[8 + 4 * hp], bL * bt[9 + 4 * hp], bL * bt[10 + 4 * hp], bL * bt[11 + 4 * hp]);
              *(bf16x8_t*)(bk + 16 + hp * 8) = pack8(bL * kt[4 * hp], bL * kt[4 * hp + 1], bL * kt[4 * hp + 2], bL * kt[4 * hp + 3], bL * kt[8 + 4 * hp], bL * kt[9 + 4 * hp], bL * kt[10 + 4 * hp], bL * kt[11 + 4 * hp]);
              *(bf16x8_t*)(cb.VT + (size_t)ch * 1024 + lane * 16 + hp * 8) = pack8(vv[4 * hp], vv[4 * hp + 1], vv[4 * hp + 2], vv[4 * hp + 3], vv[8 + 4 * hp], vv[9 + 4 * hp], vv[10 + 4 * hp], vv[11 + 4 * hp]);
          } }
        cb.bL[(size_t)ch * 64 + lane] = bL;
        asm volatile("s_waitcnt lgkmcnt(0)" ::: "memory");
        if (lane < 16) {
            float inv[16];
#pragma unroll
            for (int q = 0; q < 16; ++q) inv[q] = (q == lane) ? 1.0f : 0.0f;
#pragma unroll
            for (int q = 14; q >= 0; --q) { float acc = 0.f;
#pragma unroll
                for (int j = q + 1; j < 16; ++j) acc += Mf[q * 16 + j] * inv[j];
                inv[q] += acc; }
            bf16_t* ip = cb.IT + (size_t)ch * 256 + lane * 16;
            *(bf16x8_t*)(ip) = pack8(inv[0], inv[1], inv[2], inv[3], inv[8], inv[9], inv[10], inv[11]);
            *(bf16x8_t*)(ip + 8) = pack8(inv[4], inv[5], inv[6], inv[7], inv[12], inv[13], inv[14], inv[15]);
        }
        asm volatile("s_waitcnt lgkmcnt(0)" ::: "memory");
    }
}
#undef R1_LOAD
__device__ __forceinline__ void ph_rwkv_fin2(const float* __restrict__ O, const bf16_t* __restrict__ LORA, const bf16_t* __restrict__ BON, const float* __restrict__ ln_w, const float* __restrict__ ln_b, bf16_t* __restrict__ YMIX) {
    const int TIDX = otid();
    const int c = TIDX;
#pragma unroll 4
    for (int tok = blockIdx.x; tok < M; tok += gridDim.x) {
        const size_t o = (size_t)tok * 512 + c;
        const float v = O[o];
        const float mean = wave_sum_dpp(v) * (1.0f / 64.0f);
        const float d = v - mean;
        const float var = wave_sum_dpp(d * d) * (1.0f / 64.0f);
        const float on = d * frsq(var + 64e-5f);
        YMIX[(size_t)tok * 1024 + c] = (bf16_t)f2bf((on * ln_w[c] + ln_b[c] + bf2f(BON[o])) * bf2f(LORA[(size_t)tok * 1536 + 1024 + c]));
    }
}
constexpr int S5L = 32, S5NC = M / S5L;
struct EpiZ {
    static constexpr bool PERM = false, AFTER_DRAIN = false;
    bf16_t* ZA; bf16_t* UGX;
    __device__ __forceinline__ void operator()(const pg8::f32x4 (&acc)[2][2][4][2], const pg8::Unit& u, int wr, int wc, int fr, int fq) const {
        const int row0 = u.pm * 256 + wr * 64 + fr, col0 = u.pn * 256 + wc * 32 + 4 * fq;
#pragma unroll
        for (int ai = 0; ai < 2; ++ai)
#pragma unroll
            for (int m = 0; m < 4; ++m) { const int row = row0 + ai * 128 + m * 16;
#pragma unroll
                for (int bj = 0; bj < 2; ++bj)
#pragma unroll
                    for (int n = 0; n < 2; ++n) { const int col = col0 + bj * 128 + n * 16; const pg8::f32x4 v = acc[ai][bj][m][n];
                        if (col < RCOLS) { uint2 w; w.x = pg8::cvt_pk_bf16(v[0], v[1]); w.y = pg8::cvt_pk_bf16(v[2], v[3]); *(uint2*)(ZA + (size_t)row * RCOLS + col) = w; }
                        else if (col < INCOLS) { const int cc = col - RCOLS; const int g = cc >> 4, i = cc & 15;
                            uint2 w; w.x = pg8::cvt_pk_bf16(v[0], v[1]); w.y = pg8::cvt_pk_bf16(v[2], v[3]);
                            *(uint2*)(UGX + ((size_t)(g * S5NC + (row >> 5)) * 640 + (row & 31) * 16 + i)) = w; } } }
    }
};
struct EpiS5Y {
    static constexpr bool PERM = false, AFTER_DRAIN = false;
    const bf16_t* UGX; const float* dsk; float* YS; bf16_t* YSb;
    __device__ __forceinline__ void operator()(const pg8::f32x4 (&acc)[2][2][4][2], const pg8::Unit& u, int wr, int wc, int fr, int fq) const {
        const int g = u.pn >> 1; const int row0 = u.pm * 256 + wr * 64 + fr, col0 = (u.pn & 1) * 256 + wc * 32 + 4 * fq;
#pragma unroll
        for (int ai = 0; ai < 2; ++ai)
#pragma unroll
            for (int m = 0; m < 4; ++m) { const int R = row0 + ai * 128 + m * 16; const int chunk = R & (S5NC - 1);
#pragma unroll
                for (int bj = 0; bj < 2; ++bj)
#pragma unroll
                    for (int n = 0; n < 2; ++n) { const int col = col0 + bj * 128 + n * 16; const int t = col >> 4, j = col & 15; const pg8::f32x4 v = acc[ai][bj][m][n];
                        const uint2 uw = *(const uint2*)(UGX + (size_t)R * 640 + col);
                        const pg8::f32x4 dv = *(const pg8::f32x4*)(dsk + g * 16 + j);
                        pg8::f32x4 y;
                        y[0] = gelu_tanh(v[0] + dv[0] * bf2f((unsigned short)(uw.x & 0xffff))); y[1] = gelu_tanh(v[1] + dv[1] * bf2f((unsigned short)(uw.x >> 16)));
                        y[2] = gelu_tanh(v[2] + dv[2] * bf2f((unsigned short)(uw.y & 0xffff))); y[3] = gelu_tanh(v[3] + dv[3] * bf2f((unsigned short)(uw.y >> 16)));
                        const size_t o = (size_t)(chunk * S5L + t) * 512 + g * 16 + j;
                        *(pg8::f32x4*)(YS + o) = y;
                        uint2 w; w.x = pg8::cvt_pk_bf16(y[0], y[1]); w.y = pg8::cvt_pk_bf16(y[2], y[3]); *(uint2*)(YSb + o) = w; } }
    }
};
struct GroupOrder {
    int nm, nn, ng, G, c;
    __device__ __forceinline__ bool next(int i, pg8::Unit& u) const {
        if (c < 0) return false;
        const long L = (long)i * G + c; if (L >= (long)ng * nm * nn) return false;
        const int per = nm * nn; const int g = (int)(L / per), rem = (int)(L % per);
        u.pm = g * nm + rem / nn; u.pn = g * nn + rem % nn; return true;
    }
    __device__ __forceinline__ void a_ready(const pg8::Unit&) const {}
    __device__ __forceinline__ void done(const pg8::Unit&) const {}
};
__device__ __forceinline__ void ph_s5_mats(const S5P p, bf16_t* __restrict__ TE, bf16_t* __restrict__ TF, float* ldsf) {
    const int TIDX = otid();
    const int tid = TIDX;
    float* pwr = ldsf;
    float* pwi = pwr + 33 * 64;
    float* bbr = pwi + 33 * 64;
    float* bbi = bbr + 1024;
    float* crs = bbi + 1024;
    float* cis = crs + 1024;
    float* kt = cis + 1024;
#pragma unroll 1
    for (int item = blockIdx.x; item < 256; item += gridDim.x) {
        const int g = item >> 3, part = item & 7;
        __syncthreads();
        const float dt = expf(p.ldt[g]);
        for (int idx = tid; idx < 33 * 64; idx += NTHR) { const int n = idx >> 6, pp = idx & 63;
            const float are = p.lre[g * 64 + pp], aim = p.lim[g * 64 + pp];
            const float mag = expf((float)n * are * dt); float sn, cs; sincosf((float)n * aim * dt, &sn, &cs);
            pwr[idx] = mag * cs; pwi[idx] = mag * sn; }
        for (int idx = tid; idx < 1024; idx += NTHR) { const int pp = idx >> 4, i = idx & 15;
            const float are = p.lre[g * 64 + pp], aim = p.lim[g * 64 + pp];
            const float mag = expf(are * dt); float sn, cs; sincosf(aim * dt, &sn, &cs);
            const float nr_ = mag * cs - 1.0f, ni_ = mag * sn; const float den = are * are + aim * aim;
            const float cr_ = (nr_ * are + ni_ * aim) / den, ci_ = (ni_ * are - nr_ * aim) / den;
            const float br = p.bre[(g * 64 + pp) * 16 + i], bi = p.bim[(g * 64 + pp) * 16 + i];
            bbr[idx] = cr_ * br - ci_ * bi; bbi[idx] = cr_ * bi + ci_ * br;
            crs[idx] = p.cre[(size_t)g * 1024 + idx]; cis[idx] = p.cim[(size_t)g * 1024 + idx]; }
        __syncthreads();
        for (int idx = tid; idx < 4 * 256; idx += NTHR) { const int tau = 4 * part + (idx >> 8), j = (idx >> 4) & 15, i = idx & 15; float acc = 0.f;
#pragma unroll 4
            for (int pp = 0; pp < 64; ++pp) { const float pr = pwr[tau * 64 + pp], pi = pwi[tau * 64 + pp], br = bbr[pp * 16 + i], bi = bbi[pp * 16 + i];
                const float gr = pr * br - pi * bi, gi = pr * bi + pi * br; acc += crs[j * 64 + pp] * gr - cis[j * 64 + pp] * gi; }
            kt[idx] = acc; }
        __syncthreads();
        for (int q = tid; q < 8 * 32 * 32; q += NTHR) { const int lg = q >> 10, t = (q >> 5) & 31, j = (q >> 1) & 15, hf = q & 1; int sidx; float v[8];
            if (lg < 4) { sidx = t - (4 * part + lg);
#pragma unroll
                for (int e = 0; e < 8; ++e) v[e] = kt[(lg * 16 + j) * 16 + hf * 8 + e]; }
            else { sidx = t + 4 * part + (lg - 4) + 1;
#pragma unroll
                for (int e = 0; e < 8; ++e) v[e] = 0.f; }
            if (sidx >= 0 && sidx < 32) { uint4 o; o.x = pk2(v[0], v[1]); o.y = pk2(v[2], v[3]); o.z = pk2(v[4], v[5]); o.w = pk2(v[6], v[7]);
                *(uint4*)(TF + ((size_t)g * 512 + t * 16 + j) * 640 + sidx * 16 + hf * 8) = o; } }
        for (int q = tid; q < 64 * 16; q += NTHR) { const int row = part * 64 + (q >> 4), c8 = 64 + (q & 15); const int t = row >> 4, j = row & 15; float v[8];
            { const int n0 = (c8 - 64) * 8;
#pragma unroll
                for (int e = 0; e < 8; ++e) { const int n = n0 + e; const int pp = n & 63; const float cr = crs[j * 64 + pp], ci = cis[j * 64 + pp], pr = pwr[(t + 1) * 64 + pp], pi = pwi[(t + 1) * 64 + pp];
                    v[e] = (n < 64) ? (cr * pr - ci * pi) : -(cr * pi + ci * pr); } }
            uint4 o; o.x = pk2(v[0], v[1]); o.y = pk2(v[2], v[3]); o.z = pk2(v[4], v[5]); o.w = pk2(v[6], v[7]);
            *(uint4*)(TF + ((size_t)g * 512 + row) * 640 + c8 * 8) = o; }
        for (int q = tid; q < 32 * 64; q += NTHR) { const int n = part * 32 + (q >> 6), c8 = q & 63; const int sidx = c8 >> 1, i0 = (c8 & 1) * 8; float v[8];
#pragma unroll
            for (int e = 0; e < 8; ++e) { float val = 0.f;
                if (n < 128) { const int pp = n & 63; const float pr = pwr[(S5L - 1 - sidx) * 64 + pp], pi = pwi[(S5L - 1 - sidx) * 64 + pp], br = bbr[pp * 16 + i0 + e], bi = bbi[pp * 16 + i0 + e];
                    val = (n < 64) ? (pr * br - pi * bi) : (pr * bi + pi * br); }
                v[e] = val; }
            uint4 o; o.x = pk2(v[0], v[1]); o.y = pk2(v[2], v[3]); o.z = pk2(v[4], v[5]); o.w = pk2(v[6], v[7]);
            *(uint4*)(TE + ((size_t)g * 256 + n) * 512 + c8 * 8) = o; }
    }
    __syncthreads();
}
__device__ __forceinline__ void ph_s5_state(const S5P p, const float* __restrict__ XLOC, bf16_t* __restrict__ UGX, int blk0) {
    const int TIDX = otid();
    const int lane = TIDX & 63, wave = TIDX >> 6;
    const int vb = ((int)blockIdx.x + (int)gridDim.x - (blk0 % (int)gridDim.x)) % (int)gridDim.x;
    const int gw = vb * 8 + wave, NGW = gridDim.x * 8;
    for (int it = gw; it < NB * 32; it += NGW) {
        const int b = it >> 5, g = it & 31;
        const float are = p.lre[g * 64 + lane], aim = p.lim[g * 64 + lane]; const float dt = expf(p.ldt[g]);
        const float mag = expf((float)S5L * are * dt); float sn, cs; sincosf((float)S5L * aim * dt, &sn, &cs);
        const float lr = mag * cs, li = mag * sn;
        float xr = 0.f, xi = 0.f;
        const size_t row0 = (size_t)g * S5NC + b * (T / S5L);
#pragma unroll 4
        for (int c = 0; c < T / S5L; ++c) {
            UGX[(row0 + c) * 640 + 512 + lane] = (bf16_t)f2bf(xr); UGX[(row0 + c) * 640 + 576 + lane] = (bf16_t)f2bf(xi);
            const float ar = XLOC[(row0 + c) * 128 + lane], ai = XLOC[(row0 + c) * 128 + 64 + lane];
            const float nxr = lr * xr - li * xi + ar, nxi = lr * xi + li * xr + ai; xr = nxr; xi = nxi;
        }
    }
}


constexpr int R2_SLOT = 11520, R2_WAVE = 4 * R2_SLOT;
constexpr int R2_HALF = 128, R2_WGS = 96;
__device__ __forceinline__ void ph_rwkv_chunk_scan3(const RwkvChunkBufs cb, float* __restrict__ O, bf16_t* __restrict__ CP, bf16_t* __restrict__ SSTt, unsigned* flags, unsigned* barw, float* ldsf,
                                                    const bf16_t* __restrict__ LORA, const bf16_t* __restrict__ BON, const float* __restrict__ ln_w, const float* __restrict__ ln_b, bf16_t* __restrict__ YMIX, unsigned* othersdone, unsigned nothers) {
    const int TIDX = otid();
    const int lane = TIDX & 63, wave = __builtin_amdgcn_readfirstlane(TIDX >> 6);
    if ((int)blockIdx.x >= R2_WGS) return;
    const int role = (int)blockIdx.x >> 5, bh = (int)blockIdx.x & 31;
    const int b = bh >> 3, h = bh & 7;
    const int r = lane & 31, hh = lane >> 5;
    if (wave < 2) {
        const int vt = wave;
        LAS unsigned char* ldsw = (LAS unsigned char*)((LAS unsigned char*)ldsf + wave * R2_WAVE);
        const unsigned char* ldsg = (const unsigned char*)ldsf + wave * R2_WAVE;
#define R2_DMA16(gp, off) __builtin_amdgcn_global_load_lds((const unsigned*)(gp), (LAS unsigned*)(ldsw + (off)), 16, 0, 0)
#define R2_ISSUE(chx, slot) do { const size_t ch_ = (size_t)(chx); const int sb_ = (slot) * R2_SLOT; \
        const unsigned char* ar_ = (const unsigned char*)cb.AR + ch_ * 4096 + r * 128 + hh * 16; \
        R2_DMA16(ar_, sb_); R2_DMA16(ar_ + 32, sb_ + 1024); R2_DMA16(ar_ + 64, sb_ + 2048); R2_DMA16(ar_ + 96, sb_ + 3072); \
        R2_DMA16((const unsigned char*)cb.MK + ch_ * 1024 + r * 32 + hh * 16, sb_ + 4096); \
        R2_DMA16((r < 16) ? ((const unsigned char*)cb.IT + ch_ * 512 + r * 32 + hh * 16) : ((const unsigned char*)cb.MB + ch_ * 512 + (r - 16) * 32 + hh * 16), sb_ + 5120); \
        const unsigned char* bk_ = (const unsigned char*)cb.BKh + ch_ * 4096 + r * 64 + hh * 16; \
        R2_DMA16(bk_, sb_ + 6144); R2_DMA16(bk_ + 32, sb_ + 7168); R2_DMA16(bk_ + 2048, sb_ + 8192); R2_DMA16(bk_ + 2048 + 32, sb_ + 9216); \
        R2_DMA16((const unsigned char*)cb.VT + ch_ * 2048 + (32 * vt + r) * 32 + hh * 16, sb_ + 10240); \
        __builtin_amdgcn_global_load_lds((const unsigned*)(cb.bL + ch_ * 64 + lane), (LAS unsigned*)(ldsw + sb_ + 11264), 4, 0, 0); } while (0)
        f32x16_t S0, S1;
#pragma unroll
        for (int i = 0; i < 16; ++i) { const bool dg = (role == 2) && (((i & 3) + 8 * (i >> 2) + 4 * hh) == r); S0[i] = (dg && vt == 0) ? 1.f : 0.f; S1[i] = (dg && vt == 1) ? 1.f : 0.f; }
        const int cbeg = role ? R2_HALF : 0;
        const int ch0 = bh * 256 + cbeg;
        R2_ISSUE(ch0, 0); R2_ISSUE(ch0 + 1, 1); R2_ISSUE(ch0 + 2, 2);
#pragma unroll 1
        for (int c = 0; c < R2_HALF; ++c) {
            asm volatile("s_waitcnt vmcnt(24)" ::: "memory");
            const unsigned char* sp = ldsg + (c & 3) * R2_SLOT + lane * 16;
            RwkvOps cur;
            cur.ar0 = *(const bf16x8_t*)(sp); cur.ar1 = *(const bf16x8_t*)(sp + 1024); cur.ar2 = *(const bf16x8_t*)(sp + 2048); cur.ar3 = *(const bf16x8_t*)(sp + 3072);
            cur.mk = *(const bf16x8_t*)(sp + 4096);
            { const bf16x8_t v = *(const bf16x8_t*)(sp + 5120); const bf16x8_t z = {0, 0, 0, 0, 0, 0, 0, 0}; cur.it = (r < 16) ? v : z; cur.mb = (r < 16) ? z : v; }
            cur.bb0 = *(const bf16x8_t*)(sp + 6144); cur.bk0 = *(const bf16x8_t*)(sp + 7168); cur.bb1 = *(const bf16x8_t*)(sp + 8192); cur.bk1 = *(const bf16x8_t*)(sp + 9216);
            { const bf16x8_t v = *(const bf16x8_t*)(sp + 10240); const bf16x8_t z = {0, 0, 0, 0, 0, 0, 0, 0}; cur.vt = (role == 2) ? z : v; }
            float4 bl[8];
            { const unsigned char* bp = ldsg + (c & 3) * R2_SLOT + 11264 + 16 * hh;
#pragma unroll
              for (int g = 0; g < 8; ++g) bl[g] = *(const float4*)(bp + 32 * g); }
            asm volatile("s_waitcnt lgkmcnt(0)" ::: "memory");
            if (c + 3 < R2_HALF) R2_ISSUE(ch0 + c + 3, (c + 3) & 3);
            else { R2_ISSUE(ch0 + c, (c + 3) & 3); }
            const bf16x8_t s00 = pack8(S0[0], S0[1], S0[2], S0[3], S0[4], S0[5], S0[6], S0[7]), s01 = pack8(S0[8], S0[9], S0[10], S0[11], S0[12], S0[13], S0[14], S0[15]);
            const bf16x8_t s10 = pack8(S1[0], S1[1], S1[2], S1[3], S1[4], S1[5], S1[6], S1[7]), s11 = pack8(S1[8], S1[9], S1[10], S1[11], S1[12], S1[13], S1[14], S1[15]);
            f32x16_t Ya, Yb;
#pragma unroll
            for (int i = 0; i < 16; ++i) { Ya[i] = 0.f; Yb[i] = 0.f; }
            Ya = MFMA32(cur.ar0, s00, Ya); Yb = MFMA32(cur.ar2, s10, Yb);
            Ya = MFMA32(cur.ar1, s01, Ya); Yb = MFMA32(cur.ar3, s11, Yb);
            Ya = MFMA32(cur.mk, cur.vt, Ya);
#pragma unroll
            for (int i = 0; i < 16; ++i) Ya[i] += Yb[i];
            const bf16x8_t rhs = pack8(Ya[0], Ya[1], Ya[2], Ya[3], Ya[4], Ya[5], Ya[6], Ya[7]);
            f32x16_t Ut;
#pragma unroll
            for (int i = 0; i < 16; ++i) Ut[i] = 0.f;
            Ut = MFMA32(cur.it, rhs, Ut);
            const bf16x8_t uf = pack8(Ut[0], Ut[1], Ut[2], Ut[3], Ut[4], Ut[5], Ut[6], Ut[7]);
#pragma unroll
            for (int g = 0; g < 4; ++g) {
                S0[4 * g] *= bl[g].x; S0[4 * g + 1] *= bl[g].y; S0[4 * g + 2] *= bl[g].z; S0[4 * g + 3] *= bl[g].w;
                S1[4 * g] *= bl[4 + g].x; S1[4 * g + 1] *= bl[4 + g].y; S1[4 * g + 2] *= bl[4 + g].z; S1[4 * g + 3] *= bl[4 + g].w;
            }
            S0 = MFMA32(cur.bb0, uf, S0); S1 = MFMA32(cur.bb1, uf, S1);
            S0 = MFMA32(cur.bk0, cur.vt, S0); S1 = MFMA32(cur.bk1, cur.vt, S1);
            Ya = MFMA32(cur.mb, uf, Ya);
            if (role == 2) {
                bf16_t* cp = CP + ((size_t)bh * (R2_HALF * 16) + c * 16) * 64 + 32 * vt + r;
#pragma unroll
                for (int j = 0; j < 8; ++j) cp[(size_t)((j & 3) + 8 * (j >> 2) + 4 * hh) * 64] = (bf16_t)f2bf(Ya[8 + j]);
            } else {
                float* op = O + ((size_t)b * T + (cbeg + c) * 16) * 512 + h * 64 + 32 * vt + r;
#pragma unroll
                for (int j = 0; j < 8; ++j) op[(size_t)((j & 3) + 8 * (j >> 2) + 4 * hh) * 512] = Ya[8 + j];
            }
        }
        if (role == 0) {
            bf16_t* st = SSTt + ((size_t)bh * 64 + 32 * vt + r) * 64 + 4 * hh;
#pragma unroll
            for (int g = 0; g < 4; ++g) {
                uint2 w0, w1; w0.x = pg8::cvt_pk_bf16(S0[4 * g], S0[4 * g + 1]); w0.y = pg8::cvt_pk_bf16(S0[4 * g + 2], S0[4 * g + 3]);
                w1.x = pg8::cvt_pk_bf16(S1[4 * g], S1[4 * g + 1]); w1.y = pg8::cvt_pk_bf16(S1[4 * g + 2], S1[4 * g + 3]);
                *(uint2*)(st + 8 * g) = w0; *(uint2*)(st + 32 + 8 * g) = w1;
            }
        }
        asm volatile("s_waitcnt vmcnt(0)" ::: "memory");
#undef R2_ISSUE
#undef R2_DMA16
    }
    __syncthreads();
    if (threadIdx.x == 0) {
        __builtin_amdgcn_fence(__ATOMIC_RELEASE, "agent");
        asm volatile("s_waitcnt vmcnt(0)" ::: "memory");
        (void)xb_add(&flags[bh * 16], 1u);
        if (role) { XB_SPIN(xb_ld(&flags[bh * 16]) < 3u, barw); __builtin_amdgcn_fence(__ATOMIC_ACQUIRE, "agent"); asm volatile("s_waitcnt vmcnt(0)" ::: "memory"); }
    }
    __syncthreads();
    if (role) {
#pragma unroll 1
        for (int q = wave; q < 32; q += 8) {
            const int tb = (role - 1) * 32 + q;
            const bf16_t* ap = CP + ((size_t)bh * (R2_HALF * 16) + tb * 32 + r) * 64 + 8 * hh;
            const bf16x8_t a0 = *(const bf16x8_t*)(ap), a1 = *(const bf16x8_t*)(ap + 16), a2 = *(const bf16x8_t*)(ap + 32), a3 = *(const bf16x8_t*)(ap + 48);
#pragma unroll
            for (int nb = 0; nb < 2; ++nb) {
                const bf16_t* bp = SSTt + ((size_t)bh * 64 + 32 * nb + r) * 64 + 8 * hh;
                f32x16_t acc;
#pragma unroll
                for (int i = 0; i < 16; ++i) acc[i] = 0.f;
                acc = MFMA32(a0, *(const bf16x8_t*)(bp), acc); acc = MFMA32(a1, *(const bf16x8_t*)(bp + 16), acc);
                acc = MFMA32(a2, *(const bf16x8_t*)(bp + 32), acc); acc = MFMA32(a3, *(const bf16x8_t*)(bp + 48), acc);
                float* op = O + ((size_t)b * T + R2_HALF * 16 + tb * 32) * 512 + h * 64 + 32 * nb + r;
#pragma unroll
                for (int i = 0; i < 16; ++i) { float* o1 = op + (size_t)((i & 3) + 8 * (i >> 2) + 4 * hh) * 512; *o1 = *o1 + acc[i]; }
            }
        }
    }
    asm volatile("s_waitcnt vmcnt(0)" ::: "memory");
    __syncthreads();
    if (threadIdx.x == 0) { XB_SPIN(xb_ld(othersdone) < nothers, barw); }
    __syncthreads();
    {
        const int t0 = role == 0 ? 0 : (R2_HALF * 16 + (role - 1) * 1024), ntok = role == 0 ? R2_HALF * 16 : 1024;
        const int tq = lane >> 4, l = lane & 15; const int colb = h * 64 + 4 * l;
        const float4 lw = *(const float4*)(ln_w + colb), lb = *(const float4*)(ln_b + colb);
#pragma unroll 2
        for (int tt = wave * 4; tt < ntok; tt += 32) {
            const size_t tok = (size_t)b * T + t0 + tt + tq;
            const float4 o = *(const float4*)(O + tok * 512 + colb);
            const uint2 bw = *(const uint2*)(BON + tok * 512 + colb), gw = *(const uint2*)(LORA + tok * 1536 + 1024 + colb);
            const float mean = row_sum_dpp((o.x + o.y) + (o.z + o.w)) * (1.0f / 64.0f);
            const float d0 = o.x - mean, d1 = o.y - mean, d2 = o.z - mean, d3 = o.w - mean;
            const float var = row_sum_dpp((d0 * d0 + d1 * d1) + (d2 * d2 + d3 * d3)) * (1.0f / 64.0f);
            const float rs = frsq(var + 64e-5f);
            const float y0 = (d0 * rs * lw.x + lb.x + bf2f((unsigned short)(bw.x & 0xffff))) * bf2f((unsigned short)(gw.x & 0xffff));
            const float y1 = (d1 * rs * lw.y + lb.y + bf2f((unsigned short)(bw.x >> 16))) * bf2f((unsigned short)(gw.x >> 16));
            const float y2 = (d2 * rs * lw.z + lb.z + bf2f((unsigned short)(bw.y & 0xffff))) * bf2f((unsigned short)(gw.y & 0xffff));
            const float y3 = (d3 * rs * lw.w + lb.w + bf2f((unsigned short)(bw.y >> 16))) * bf2f((unsigned short)(gw.y >> 16));
            uint2 w; w.x = pg8::cvt_pk_bf16(y0, y1); w.y = pg8::cvt_pk_bf16(y2, y3);
            *(uint2*)(YMIX + tok * 1024 + colb) = w;
        }
    }
}

__device__ __forceinline__ void ph_router(const bf16_t* __restrict__ x, const float* __restrict__ gain, const float* __restrict__ wr, const float* __restrict__ br, unsigned char* __restrict__ HN, int* __restrict__ tok_e, float* __restrict__ tok_w, int* __restrict__ bcnt, float* ldsf) {
    const int TIDX = otid();
    const int lane = TIDX & 63, wave = TIDX >> 6;
    volatile int* hist = (volatile int*)ldsf;
    if (TIDX < 8) hist[TIDX] = 0;
    __syncthreads();
    const int TPB = (M + (int)gridDim.x - 1) / (int)gridDim.x; const int t_beg = (int)blockIdx.x * TPB, t_end = (t_beg + TPB) < M ? (t_beg + TPB) : M;
#pragma unroll 2
    for (int r = t_beg + wave; r < t_end; r += 8) {
        const uint2* xr = (const uint2*)(x + (size_t)r * D) + lane;
        float4 v[4]; float s = 0.f;
#pragma unroll
        for (int j = 0; j < 4; ++j) { const uint2 w = xr[64 * j]; v[j] = make_float4(bf2f((unsigned short)(w.x & 0xffff)), bf2f((unsigned short)(w.x >> 16)), bf2f((unsigned short)(w.y & 0xffff)), bf2f((unsigned short)(w.y >> 16)));
            s += v[j].x * v[j].x + v[j].y * v[j].y + v[j].z * v[j].z + v[j].w * v[j].w; }
        s = wave_sum(s);
        const float rs = 1.0f / sqrtf(s * (1.0f / D) + NORM_EPS);
        float lg[8];
#pragma unroll
        for (int e = 0; e < 8; ++e) lg[e] = 0.f;
        unsigned* o = (unsigned*)(HN + (size_t)r * D) + lane;
#pragma unroll
        for (int j = 0; j < 4; ++j) {
            const float4 g = ((const float4*)gain)[lane + 64 * j];
            const float4 hn = make_float4(v[j].x * rs * g.x, v[j].y * rs * g.y, v[j].z * rs * g.z, v[j].w * rs * g.w);
            o[64 * j] = pk4_fp8(hn.x, hn.y, hn.z, hn.w);
            const int d0 = 4 * (lane + 64 * j);
            const float hv[4] = {hn.x, hn.y, hn.z, hn.w};
#pragma unroll
            for (int i = 0; i < 4; ++i) {
                const float4 w0 = *(const float4*)(wr + (size_t)(d0 + i) * 8), w1 = *(const float4*)(wr + (size_t)(d0 + i) * 8 + 4);
                lg[0] += hv[i] * w0.x; lg[1] += hv[i] * w0.y; lg[2] += hv[i] * w0.z; lg[3] += hv[i] * w0.w;
                lg[4] += hv[i] * w1.x; lg[5] += hv[i] * w1.y; lg[6] += hv[i] * w1.z; lg[7] += hv[i] * w1.w;
            }
        }
#pragma unroll
        for (int e = 0; e < 8; ++e) lg[e] = wave_sum(lg[e]) + br[e];
        if (lane == 0) {
            int i1 = 0; float l1 = lg[0];
#pragma unroll
            for (int e = 1; e < 8; ++e) if (lg[e] > l1) { l1 = lg[e]; i1 = e; }
            int i2 = -1; float l2 = -3.0e38f;
#pragma unroll
            for (int e = 0; e < 8; ++e) if (e != i1 && lg[e] > l2) { l2 = lg[e]; i2 = e; }
            if (i2 < 0) { i2 = (i1 + 1) & 7; l2 = l1; }
            const float ex = expf(l2 - l1); const float w1 = 1.0f / (1.0f + ex);
            tok_e[r * 2] = i1; tok_e[r * 2 + 1] = i2; tok_w[r * 2] = w1; tok_w[r * 2 + 1] = ex * w1;
            atomicAdd((int*)&hist[i1], 1); atomicAdd((int*)&hist[i2], 1);
        }
    }
    __syncthreads();
    if (TIDX < 8) bcnt[blockIdx.x * 8 + TIDX] = hist[TIDX];
}
__device__ __forceinline__ void moe_prefix(const int* cnt, int (&ts)[9]) {
    ts[0] = 0;
#pragma unroll
    for (int e = 0; e < NEXP; ++e) ts[e + 1] = ts[e] + ((__builtin_amdgcn_readfirstlane(cnt[e]) + 255) >> 8);
}
__device__ __forceinline__ void ph_moe_combine(const bf16_t* __restrict__ Y, const int* __restrict__ tokpos, const float* __restrict__ tok_w, const bf16_t* __restrict__ Hb, float* __restrict__ out) {
    const int TIDX = otid();
    const int lane = TIDX & 63, wave = TIDX >> 6;
    const int gw = blockIdx.x * 8 + wave, NGW = gridDim.x * 8;
#pragma unroll 2
    for (int tok = gw; tok < M; tok += NGW) {
        const int p0 = tokpos[tok * 2], p1 = tokpos[tok * 2 + 1]; const float w0 = tok_w[tok * 2], w1 = tok_w[tok * 2 + 1];
        const uint4* y0 = (const uint4*)(Y + (size_t)p0 * D); const uint4* y1 = (const uint4*)(Y + (size_t)p1 * D); const uint4* hr = (const uint4*)(Hb + (size_t)tok * D);
        float4* op = (float4*)(out + (size_t)tok * D);
#pragma unroll
        for (int j = 0; j < 2; ++j) {
            const uint4 a = y0[lane + 64 * j], b = y1[lane + 64 * j], hv = hr[lane + 64 * j];
            const unsigned aw[4] = {a.x, a.y, a.z, a.w}, bw[4] = {b.x, b.y, b.z, b.w}, hw[4] = {hv.x, hv.y, hv.z, hv.w};
#pragma unroll
            for (int q = 0; q < 2; ++q) {
                const unsigned a0 = aw[2 * q], a1 = aw[2 * q + 1], b0 = bw[2 * q], b1 = bw[2 * q + 1], h0 = hw[2 * q], h1 = hw[2 * q + 1];
                float4 o;
                o.x = bf2f((unsigned short)(h0 & 0xffff)) + w0 * bf2f((unsigned short)(a0 & 0xffff)) + w1 * bf2f((unsigned short)(b0 & 0xffff));
                o.y = bf2f((unsigned short)(h0 >> 16)) + w0 * bf2f((unsigned short)(a0 >> 16)) + w1 * bf2f((unsigned short)(b0 >> 16));
                o.z = bf2f((unsigned short)(h1 & 0xffff)) + w0 * bf2f((unsigned short)(a1 & 0xffff)) + w1 * bf2f((unsigned short)(b1 & 0xffff));
                o.w = bf2f((unsigned short)(h1 >> 16)) + w0 * bf2f((unsigned short)(a1 >> 16)) + w1 * bf2f((unsigned short)(b1 >> 16));
                op[(lane + 64 * j) * 2 + q] = o;
            }
        }
    }
}


constexpr float W8_SCALE = 64.0f, W8_INV = 1.0f / 64.0f;
struct WC8 { const float* W; int ldw; int K; int ncols; unsigned char* WT; int rbase; int rs4; };
__device__ __forceinline__ void ph_wconv8(const WC8 w, float* lds, int vb, int vg, int rot) {
    const int TIDX = otid();
    const int lane = TIDX & 63, wave = TIDX >> 6;
    unsigned char* scr = (unsigned char*)lds + wave * 9216;
    const int nwg = vb >= 0 ? vg : (int)gridDim.x; int wgid = (vb >= 0 ? vb : (int)blockIdx.x) - rot; if (wgid < 0) wgid += nwg;
    const int nkt = w.K / 64, nnt = w.ncols / 64; const int bk = nkt >> 1, bn = nnt >> 2;
    const int g = lane >> 4, l15 = lane & 15;
    float4 v[4][4];
#define WC8_LOAD(bt) do { const int kt_ = 2 * ((bt) % bk) + (wave & 1), nt_ = 4 * ((bt) / bk) + (wave >> 1); \
        const float* wp_ = w.W + (size_t)(kt_ * 64 + 4 * g) * w.ldw + nt_ * 64 + 4 * l15; \
        _Pragma("unroll") for (int j = 0; j < 4; ++j) _Pragma("unroll") for (int q = 0; q < 4; ++q) v[j][q] = *(const float4*)(wp_ + (size_t)(16 * j + q) * w.ldw); } while (0)
    int bt = wgid;
    if (bt < bk * bn) WC8_LOAD(bt);
#pragma unroll 1
    for (; bt < bk * bn; bt += nwg) {
        const int kt = 2 * (bt % bk) + (wave & 1), nt = 4 * (bt / bk) + (wave >> 1); const int k0 = kt * 64, n0 = nt * 64;
#pragma unroll
        for (int j = 0; j < 4; ++j) { const int kb = 16 * j + 4 * g;
            *(unsigned*)(scr + (4 * l15 + 0) * 80 + kb) = pk4_fp8(v[j][0].x * W8_SCALE, v[j][1].x * W8_SCALE, v[j][2].x * W8_SCALE, v[j][3].x * W8_SCALE);
            *(unsigned*)(scr + (4 * l15 + 1) * 80 + kb) = pk4_fp8(v[j][0].y * W8_SCALE, v[j][1].y * W8_SCALE, v[j][2].y * W8_SCALE, v[j][3].y * W8_SCALE);
            *(unsigned*)(scr + (4 * l15 + 2) * 80 + kb) = pk4_fp8(v[j][0].z * W8_SCALE, v[j][1].z * W8_SCALE, v[j][2].z * W8_SCALE, v[j][3].z * W8_SCALE);
            *(unsigned*)(scr + (4 * l15 + 3) * 80 + kb) = pk4_fp8(v[j][0].w * W8_SCALE, v[j][1].w * W8_SCALE, v[j][2].w * W8_SCALE, v[j][3].w * W8_SCALE); }
        if (bt + nwg < bk * bn) WC8_LOAD(bt + nwg);
        asm volatile("s_waitcnt lgkmcnt(0)" ::: "memory");
#pragma unroll
        for (int i = 0; i < 4; ++i) { const int q = lane + 64 * i; const int nl = q >> 2, ch = q & 3; const int n = n0 + nl;
            const uint4 o = *(const uint4*)(scr + nl * 80 + ch * 16);
            const int drow = w.rbase + (n >> 2) * w.rs4 + (n & 3); *(uint4*)(w.WT + (size_t)drow * w.K + k0 + 16 * ch) = o; }
        asm volatile("s_waitcnt lgkmcnt(0)" ::: "memory");
    }
#undef WC8_LOAD
}
struct EpiSwiGLU8 {
    static constexpr bool PERM = true, AFTER_DRAIN = false;
    unsigned char* H; int ldh; int nN;
    __device__ __forceinline__ void operator()(const pg8::f32x4 (&acc)[2][2][4][2], const pg8::Unit& u, int wr, int wc, int fr, int fq) const {
        const int row0 = u.pm * 256 + wr * 64 + fr; const int pnl = u.pn % nN;
        const int hc0 = (pnl * 256 + wc * 32 + 8 * fq) >> 1;
#pragma unroll
        for (int ai = 0; ai < 2; ++ai)
#pragma unroll
            for (int m = 0; m < 4; ++m) { unsigned char* rowp = H + (size_t)(row0 + ai * 128 + m * 16) * ldh + hc0;
#pragma unroll
                for (int bj = 0; bj < 2; ++bj) { const pg8::f32x4 g = acc[ai][bj][m][0] * W8_INV, up = acc[ai][bj][m][1] * W8_INV; float o[4];
#pragma unroll
                    for (int j = 0; j < 4; ++j) o[j] = g[j] * __builtin_amdgcn_rcpf(1.0f + __expf(-g[j])) * up[j];
                    *(unsigned*)(rowp + bj * 64) = pk4_fp8(o[0], o[1], o[2], o[3]); } }
    }
};
struct EpiBf16S {
    static constexpr bool PERM = true, AFTER_DRAIN = false;
    bf16_t* O; int ldc; int nN; float scale;
    __device__ __forceinline__ void operator()(const pg8::f32x4 (&acc)[2][2][4][2], const pg8::Unit& u, int wr, int wc, int fr, int fq) const {
        const int row0 = u.pm * 256 + wr * 64 + fr; const int col0 = (u.pn % nN) * 256 + wc * 32 + 8 * fq;
#pragma unroll
        for (int ai = 0; ai < 2; ++ai)
#pragma unroll
            for (int m = 0; m < 4; ++m) { bf16_t* rowp = O + (size_t)(row0 + ai * 128 + m * 16) * ldc + col0;
#pragma unroll
                for (int bj = 0; bj < 2; ++bj) { const pg8::f32x4 v0 = acc[ai][bj][m][0] * scale, v1 = acc[ai][bj][m][1] * scale;
                    pg8::u32x4 w; w.x = pg8::cvt_pk_bf16(v0[0], v0[1]); w.y = pg8::cvt_pk_bf16(v0[2], v0[3]); w.z = pg8::cvt_pk_bf16(v1[0], v1[1]); w.w = pg8::cvt_pk_bf16(v1[2], v1[3]);
                    *(pg8::u32x4*)(rowp + bj * 128) = w; } }
    }
};
__device__ __forceinline__ void ph_moe_place8(const unsigned char* __restrict__ HN8, const int* __restrict__ bcnt, const int* __restrict__ tok_e, unsigned char* __restrict__ AS8, int* __restrict__ tokpos, int* __restrict__ cnt, float* ldsf) {
    const int TIDX = otid();
    const int lane = TIDX & 63, wave = TIDX >> 6;
    volatile int* sh = (volatile int*)ldsf;
    const int G = (int)gridDim.x;
    if (wave == 0) {
        float tot[8], off[8];
#pragma unroll
        for (int e = 0; e < 8; ++e) { tot[e] = 0.f; off[e] = 0.f; }
        for (int bb = lane; bb < G; bb += 64) { const int4 c0 = *(const int4*)(bcnt + bb * 8), c1 = *(const int4*)(bcnt + bb * 8 + 4); const int cc[8] = {c0.x, c0.y, c0.z, c0.w, c1.x, c1.y, c1.z, c1.w};
#pragma unroll
            for (int e = 0; e < 8; ++e) { tot[e] += (float)cc[e]; if (bb < (int)blockIdx.x) off[e] += (float)cc[e]; } }
        int ts = 0;
#pragma unroll
        for (int e = 0; e < 8; ++e) { const int te = (int)(wave_sum_dpp(tot[e]) + 0.5f), oe = (int)(wave_sum_dpp(off[e]) + 0.5f);
            if (lane == 0) { sh[e] = ts * 256 + oe; sh[8 + e] = te; sh[16 + e] = ts; if (blockIdx.x == 0) cnt[e] = te; }
            ts += (te + 255) >> 8; }
        if (lane == 0) sh[24] = ts;
    }
    __syncthreads();
    const int TPB = (M + G - 1) / G; const int t_beg = (int)blockIdx.x * TPB, t_end = (t_beg + TPB) < M ? (t_beg + TPB) : M;
    for (int g0 = t_beg; g0 < t_end; g0 += 64) {
        const int tk = g0 + lane; int e1 = -1, e2 = -1;
        if (tk < t_end) { e1 = tok_e[tk * 2]; e2 = tok_e[tk * 2 + 1]; }
        unsigned long long mk[8];
#pragma unroll
        for (int e = 0; e < 8; ++e) mk[e] = __ballot(e1 == e || e2 == e);
        const int n_here = (t_end - g0) < 64 ? (t_end - g0) : 64;
        for (int tl = wave; tl < n_here; tl += 8) {
            const int tok = g0 + tl;
            const int ea = __builtin_amdgcn_readlane(e1, tl), eb = __builtin_amdgcn_readlane(e2, tl);
            const unsigned long long below = (1ull << tl) - 1ull;
            int pa = 0, pb = 0;
#pragma unroll
            for (int e = 0; e < 8; ++e) { const int rk = __popcll(mk[e] & below); if (e == ea) pa = sh[e] + rk; if (e == eb) pb = sh[e] + rk; }
            const uint4 row = ((const uint4*)(HN8 + (size_t)tok * D))[lane];
            ((uint4*)(AS8 + (size_t)pa * D))[lane] = row; ((uint4*)(AS8 + (size_t)pb * D))[lane] = row;
            if (lane == 0) { tokpos[tok * 2] = pa; tokpos[tok * 2 + 1] = pb; }
        }
        __syncthreads();
        if (TIDX < 8) sh[TIDX] += __popcll(mk[TIDX]);
        __syncthreads();
    }
    const int gw = blockIdx.x * 8 + wave, NGW = G * 8;
#pragma unroll 1
    for (int e = 0; e < 8; ++e) { const int r0 = sh[16 + e] * 256 + sh[8 + e], r1 = (e < 7 ? sh[16 + e + 1] : sh[24]) * 256;
        for (int rr = r0 + gw; rr < r1; rr += NGW) ((uint4*)(AS8 + (size_t)rr * D))[lane] = make_uint4(0u, 0u, 0u, 0u); }
    __syncthreads();
}
#define WSB(mib) ((bf16_t*)(ws + (size_t)(mib) * MiB))
#define GEMM_STATIC(Aptr, Btptr, Mr, Nc, Kd, EpiT, Eobj) do { \
        pg8::Gemm g_{(const bf16_t*)(Aptr), (const bf16_t*)(Btptr), (Mr), (Nc), (Kd), 0, 0}; pg8::StaticOrder S_; S_.init((Mr), (Nc), (int)gridDim.x, (int)blockIdx.x); \
        pg8::gemm_phase<EpiT, pg8::StaticOrder, PG8_ALIGN, PG8_SP2>(ldsq, g_, S_, (Eobj)); } while (0)

#define GEMM_STATIC_OFF(Aptr, Btptr, Mr, Nc, Kd, EpiT, Eobj, COFF) do { \
        pg8::Gemm g_{(const bf16_t*)(Aptr), (const bf16_t*)(Btptr), (Mr), (Nc), (Kd), 0, 0}; pg8::StaticOrder S_; S_.init((Mr), (Nc), (int)gridDim.x, (int)((blockIdx.x + gridDim.x - ((COFF) % gridDim.x)) % gridDim.x)); \
        pg8::gemm_phase<EpiT, pg8::StaticOrder, PG8_ALIGN, PG8_SP2>(ldsq, g_, S_, (Eobj)); } while (0)

template <class T> __device__ __forceinline__ T* opaque_uniform(T* p) {
    const unsigned long long v = (unsigned long long)p;
    unsigned lo = __builtin_amdgcn_readfirstlane((unsigned)v), hi = __builtin_amdgcn_readfirstlane((unsigned)(v >> 32));
    asm volatile("" : "+s"(lo), "+s"(hi));
    return (T*)(((unsigned long long)hi << 32) | lo);
}
__device__ __forceinline__ const float* ld_in(const float* const* t, int i) { t = opaque_uniform(t);
    typedef const float* __attribute__((address_space(4))) const* cptr_t;
    return ((cptr_t)(unsigned long long)t)[i]; }
__global__ void __launch_bounds__(NTHR, 2) fwd(Params P) {
    extern __shared__ __attribute__((aligned(16))) unsigned char lds_raw[];
    float* lds = (float*)lds_raw;
    PG8_LAS unsigned char* ldsq = (PG8_LAS unsigned char*)lds_raw;
    volatile LAS unsigned* MISC = (volatile LAS unsigned*)((LAS unsigned char*)lds_raw + (LDS_BYTES - 64));
    if (threadIdx.x < 16) MISC[threadIdx.x] = 0u;
    __syncthreads();
    unsigned char* ws = P.ws;
    unsigned* ctl = (unsigned*)(ws + WS_CTL);
    XcdBarrier bar = xcd_barrier_post(ctl + CW_BAR, MISC + 8);
#define BAR() do { XcdBarrier b2_ = bar; b2_.bar = opaque_uniform(b2_.bar); xcd_barrier(b2_); } while (0)
    const float* const* in = (const float* const*)__builtin_amdgcn_kernarg_segment_ptr();
#define INP(i) ld_in(in, (i))
    float* out = P.out;

    bf16_t* MEMNb0 = WSB(1); bf16_t* MEMNb1 = WSB(3); bf16_t* KVb0 = WSB(5); bf16_t* KVb1 = WSB(9);
    bf16_t* Wt_in = WSB(13); bf16_t* Wt_glu = WSB(18); bf16_t* Wt_out = WSB(19); bf16_t* Wt_q0 = WSB(21); bf16_t* Wt_kv0 = WSB(23); bf16_t* Wt_o0 = WSB(27); bf16_t* Wt_gu = WSB(29); bf16_t* Wt_dn = WSB(40);
    bf16_t* Wt_lora = WSB(46); bf16_t* Wt_q1 = WSB(48); bf16_t* Wt_kv1 = WSB(50); bf16_t* Wt_o1 = WSB(54);
    bf16_t* HNb = WSB(56);
    bf16_t* ZAb = WSB(88); bf16_t* UGX = WSB(145); float* XLOC = WSF(165); bf16_t* TE = WSB(173); bf16_t* TF = WSB(181); bf16_t* LORA = WSB(201); bf16_t* BON = WSB(249);
    const RwkvChunkBufs cb{WSB(329), WSB(361), WSB(393), WSB(409), WSB(417), WSB(421), WSF(425)};
    bf16_t* LA = WSB(329);
    bf16_t* Hb = WSB(427); float* SSQ = WSF(459);
    bf16_t* Wt_qkv = WSB(460); bf16_t* Wt_dao = WSB(466);
    float* Orw = WSF(56); float* YS = WSF(88); bf16_t* YSb = WSB(120); bf16_t* YMIXb = WSB(168);
    const S5P sp{INP(I_S5_LRE), INP(I_S5_LIM), INP(I_S5_LDT), INP(I_S5_BRE), INP(I_S5_BIM), INP(I_S5_CRE), INP(I_S5_CIM), INP(I_S5_D)};
#pragma unroll 1
    for (int step = 0; step < 2; ++step) {
        const bool mats = (((int)blockIdx.x & 1) == 0) == (step == 0);
        if (mats) ph_s5_mats(sp, TE, TF, lds); else ph_rmsnorm(INP(I_X), INP(I_NORM_MIX), HNb, M);
        __syncthreads();
        if (step == 0) {
        int rot0 = 32 % (int)gridDim.x;
        { WC w{INP(I_HY_WIN), INCOLS, D, INCOLS, 2560, Wt_in, 0, 4, 0, 0, 0, nullptr, 0}; ph_wconv(w, lds, -1, 0, rot0); rot0 = (rot0 + wc_nblk(w)) % (int)gridDim.x; }
        { WC w{INP(I_XA_WKV), 2 * D, D, 2 * D, 2 * D, Wt_kv0, 0, 4, 0, 0, 0, nullptr, 0}; ph_wconv(w, lds, -1, 0, rot0); rot0 = (rot0 + wc_nblk(w)) % (int)gridDim.x; }
        { WC w{INP(I_RW_WUP), 512, 64, 512, 512, Wt_lora, 0, 4, 384, 0, 6, nullptr, 0}; ph_wconv(w, lds, -1, 0, rot0); rot0 = (rot0 + wc_nblk(w)) % (int)gridDim.x; }
        { WC w{INP(I_RW_AUP), 512, 64, 512, 512, Wt_lora, 512, 4, 384, 64, 6, nullptr, 0}; ph_wconv(w, lds, -1, 0, rot0); rot0 = (rot0 + wc_nblk(w)) % (int)gridDim.x; }
        { WC w{INP(I_RW_GUP), 512, 160, 512, 512, Wt_lora, 1024, 4, 384, 128, 6, nullptr, 0}; ph_wconv(w, lds, -1, 0, rot0); rot0 = (rot0 + wc_nblk(w)) % (int)gridDim.x; }
        { WC w{INP(I_XA_WKV) + (size_t)D * 2 * D, 2 * D, D, 2 * D, 2 * D, Wt_kv1, 0, 4, 0, 0, 0, nullptr, 0}; ph_wconv(w, lds, -1, 0, rot0); rot0 = (rot0 + wc_nblk(w)) % (int)gridDim.x; }
            __syncthreads();
        }
    }
    ph_rmsnorm(INP(I_MEM), INP(I_NORM_MEM), MEMNb0, NB * MEML);
    ph_rmsnorm(INP(I_MEM), INP(I_NORM_MEM) + D, MEMNb1, NB * MEML);
    BAR();
    { EpiZ E{ZAb, UGX}; GEMM_STATIC(HNb, Wt_in, M, 2560, D, EpiZ, E); }
    { EpiBf16P E{KVb0, 2 * D, 0, 0, nullptr}; GEMM_STATIC_OFF(MEMNb0, Wt_kv0, NB * MEML, 2 * D, D, EpiBf16P, E, 128); }
    { EpiBf16P E{KVb1, 2 * D, 0, 0, nullptr}; GEMM_STATIC_OFF(MEMNb1, Wt_kv1, NB * MEML, 2 * D, D, EpiBf16P, E, 160); }
    BAR();
    { pg8::Gemm g_{UGX, TE, 0, 0, 512, 640, 0}; GroupOrder S_{2, 1, 32, (int)gridDim.x, (int)blockIdx.x}; EpiF32S<true> E{XLOC, 128, 1};
      pg8::gemm_phase<EpiF32S<true>, GroupOrder, PG8_ALIGN, PG8_SP2>(ldsq, g_, S_, E); }
    { const int ev0 = (int)gridDim.x > 128 ? 64 : 0; const int evb = (int)blockIdx.x - ev0, evg = (int)gridDim.x - ev0;
      ph_lora_in(ZAb, INP(I_RW_MU), LA, evb, evg);
      ph_knorm_bf16(KVb0, INP(I_XA_KG), INP(I_XA_QG), evb, evg);
      ph_knorm_bf16(KVb1, INP(I_XA_KG) + 256, INP(I_XA_QG) + 256, evb, evg); }
    BAR();
    { EpiBf16P E{LORA, 1536, 0, 0, nullptr}; GEMM_STATIC(LA, Wt_lora, M, 1536, 384, EpiBf16P, E); }
    ph_s5_state(sp, XLOC, UGX, 128);
    BAR();
    { RwkvP rp{INP(I_RW_MU), INP(I_RW_W0), INP(I_RW_WUP), INP(I_RW_A0), INP(I_RW_AUP), INP(I_RW_GUP), INP(I_RW_KK), INP(I_RW_KA), INP(I_RW_RK), INP(I_RW_LNW), INP(I_RW_LNB)};
      ph_rwkv_chunk_prep2(ZAb, LORA, rp, cb, BON, lds); }
    BAR();
    ph_rwkv_chunk_scan3(cb, Orw, WSB(136), WSB(144), ctl + CW_R2F, opaque_uniform(ctl + CW_BAR), lds, LORA, BON, INP(I_RW_LNW), INP(I_RW_LNB), YMIXb, opaque_uniform(ctl + CW_GLUF), (unsigned)((int)gridDim.x - R2_WGS));
    { const int cv0 = R2_WGS; const int cvg = (int)gridDim.x > cv0 ? (int)gridDim.x - cv0 : 0; const int cvb = (int)blockIdx.x - cv0;
      if (cvg == 0 || cvb >= 0) { int rot1 = 0; const int cvn = cvg ? cvg : (int)gridDim.x;
        { WC w{INP(I_S5_WGLU), 512, 512, 512, 512, Wt_glu, 0, 4, 0, 0, 0, nullptr, 0}; ph_wconv(w, lds, cvg ? cvb : -1, cvg, rot1); rot1 = (rot1 + wc_nblk(w)) % cvn; }
        { WC w{INP(I_HY_WOUT), D, D, D, D, Wt_out, 0, 4, 0, 0, 0, nullptr, 0}; ph_wconv(w, lds, cvg ? cvb : -1, cvg, rot1); rot1 = (rot1 + wc_nblk(w)) % cvn; }
        { WC w{INP(I_XA_WQ), D, D, D, D, Wt_q0, 0, 4, 0, 0, 0, INP(I_NORM_XATTN), 0}; ph_wconv(w, lds, cvg ? cvb : -1, cvg, rot1); rot1 = (rot1 + wc_nblk(w)) % cvn; }
        { WC w{INP(I_XA_WO), D, D, D, D, Wt_o0, 0, 4, 0, 0, 0, nullptr, 0}; ph_wconv(w, lds, cvg ? cvb : -1, cvg, rot1); rot1 = (rot1 + wc_nblk(w)) % cvn; }
        { WC w{INP(I_FF_WG), DFF, D, DFF, DFF, Wt_gu, 0, 8, 0, 0, 0, INP(I_NORM_FFN), 0}; ph_wconv(w, lds, cvg ? cvb : -1, cvg, rot1); rot1 = (rot1 + wc_nblk(w)) % cvn; }
        { WC w{INP(I_FF_WU), DFF, D, DFF, DFF, Wt_gu, 4, 8, 0, 0, 0, INP(I_NORM_FFN), 0}; ph_wconv(w, lds, cvg ? cvb : -1, cvg, rot1); rot1 = (rot1 + wc_nblk(w)) % cvn; }
        { WC w{INP(I_FF_WD), D, DFF, D, D, Wt_dn, 0, 4, 0, 0, 0, nullptr, 0}; ph_wconv(w, lds, cvg ? cvb : -1, cvg, rot1); rot1 = (rot1 + wc_nblk(w)) % cvn; }
        { WC w{INP(I_XA_WQ) + (size_t)D * D, D, D, D, D, Wt_q1, 0, 4, 0, 0, 0, INP(I_NORM_XATTN) + D, 0}; ph_wconv(w, lds, cvg ? cvb : -1, cvg, rot1); rot1 = (rot1 + wc_nblk(w)) % cvn; }
        { WC w{INP(I_XA_WO) + (size_t)D * D, D, D, D, D, Wt_o1, 0, 4, 0, 0, 0, nullptr, 0}; ph_wconv(w, lds, cvg ? cvb : -1, cvg, rot1); rot1 = (rot1 + wc_nblk(w)) % cvn; }
        { WC w{INP(I_DA_WQKV), 3 * D, D, 3 * D, 3 * D, Wt_qkv, 0, 4, 0, 0, 0, INP(I_NORM_MIX) + D, 1}; ph_wconv(w, lds, cvg ? cvb : -1, cvg, rot1); rot1 = (rot1 + wc_nblk(w)) % cvn; }
        { WC w{INP(I_DA_WO), D, D, D, D, Wt_dao, 0, 4, 0, 0, 0, nullptr, 0}; ph_wconv(w, lds, cvg ? cvb : -1, cvg, rot1); rot1 = (rot1 + wc_nblk(w)) % cvn; }
      } }
    __syncthreads();
    { const int gsz = (int)gridDim.x - R2_WGS; pg8::Gemm g_{UGX, TF, 0, 0, 640, 640, 640}; GroupOrder S_{2, 2, 32, gsz > 0 ? gsz : (int)gridDim.x, gsz > 0 ? (int)blockIdx.x - R2_WGS : (int)blockIdx.x};
      EpiS5Y E{UGX, INP(I_S5_D), YS, YSb}; pg8::gemm_phase<EpiS5Y, GroupOrder, PG8_ALIGN, PG8_SP2>(ldsq, g_, S_, E); }
    if ((int)gridDim.x > R2_WGS && (int)blockIdx.x >= R2_WGS) {
        unsigned* barw = opaque_uniform(ctl + CW_BAR); unsigned* gf = opaque_uniform(ctl + CW_GLUF);
        asm volatile("s_waitcnt vmcnt(0)" ::: "memory");
        __syncthreads();
        if (threadIdx.x == 0) {
            __builtin_amdgcn_fence(__ATOMIC_RELEASE, "agent");
            asm volatile("s_waitcnt vmcnt(0)" ::: "memory");
            (void)xb_add(gf, 1u);
            if ((int)blockIdx.x - R2_WGS < 128) { XB_SPIN(xb_ld(gf) < (unsigned)((int)gridDim.x - R2_WGS), barw); __builtin_amdgcn_fence(__ATOMIC_ACQUIRE, "agent"); asm volatile("s_waitcnt vmcnt(0)" ::: "memory"); }
        }
        __syncthreads();
        { pg8::Gemm g_{YSb, Wt_glu, 0, 0, 512, 0, 0}; GroupOrder S_{64, 2, 1, (int)gridDim.x - R2_WGS, (int)blockIdx.x - R2_WGS}; EpiGLU E{YS, INP(I_S5_BGLU), YMIXb};
          pg8::gemm_phase<EpiGLU, GroupOrder, PG8_ALIGN, PG8_SP2>(ldsq, g_, S_, E); }
    }
    BAR();
    { EpiRes E{INP(I_X), Hb, SSQ}; GEMM_STATIC(YMIXb, Wt_out, M, D, D, EpiRes, E); }
    BAR();

#define MEM_XATTN(KVb_, Wq_, Wo_, HbOut, QOFF, AOFF) do { \
            bf16_t* Qb = WSB(QOFF); bf16_t* AOb = WSB(AOFF); \
            { EpiBf16P E{Qb, D, 0, 0, SSQ}; GEMM_STATIC(Hb, Wq_, M, D, D, EpiBf16P, E); } \
            {     \
              int qpm_, qpn_; pg8::static_unit_of(M / 256, D / 256, (int)blockIdx.x, qpm_, qpn_); \
              asm volatile("s_waitcnt vmcnt(0)" ::: "memory"); __syncthreads(); \
              int u0_ = __builtin_amdgcn_readfirstlane((qpm_ >> 4) * 128 + qpn_ * 32 + 2 * (qpm_ & 15)); asm volatile("" : "+s"(u0_)); \
              ph_mem_attn_mfma(Qb, KVb_, AOb, lds, u0_); } \
            BAR(); \
            { EpiRes E{nullptr, Hb, SSQ}; GEMM_STATIC(AOb, Wo_, M, D, D, EpiRes, E); } \
            BAR(); } while (0)

    MEM_XATTN(KVb0, Wt_q0, Wt_o0, Hb, 56, 88);
    {
        bf16_t* H = WSB(88);
        { EpiSwiGLU E{H, DFF, 0, 0, SSQ}; GEMM_STATIC(Hb, Wt_gu, M, 2 * DFF, D, EpiSwiGLU, E); }
        BAR();
        { EpiRes E{nullptr, Hb, SSQ}; GEMM_STATIC(H, Wt_dn, M, D, DFF, EpiRes, E); }
        BAR();
    }
    unsigned char* Wt_mgu8 = (unsigned char*)WSB(265); unsigned char* Wt_mdn8 = (unsigned char*)WSB(468);
    {
        bf16_t* QKVb = WSB(56); bf16_t* AOb = WSB(352);
        { EpiQKV E{QKVb, SSQ, INP(I_DA_QG), INP(I_DA_KG)}; GEMM_STATIC(Hb, Wt_qkv, M, 3 * D, D, EpiQKV, E); }
        BAR();
        { const int ncv = gridDim.x >= 192 ? 64 : 0; const int vb = (int)blockIdx.x - ((int)gridDim.x - ncv);
          if (ncv == 0 || vb >= 0) { int rot8 = 0; const int cvn8 = ncv ? ncv : (int)gridDim.x;
#pragma unroll 1
            for (int e = 0; e < NEXP; ++e) {
                { WC8 w{INP(I_MOE_WG) + (size_t)e * D * DFFE, DFFE, D, DFFE, Wt_mgu8 + (size_t)e * 2 * DFFE * D, 0, 8}; ph_wconv8(w, lds, ncv ? vb : -1, ncv, rot8); rot8 = (rot8 + 112) % cvn8; }
                { WC8 w{INP(I_MOE_WU) + (size_t)e * D * DFFE, DFFE, D, DFFE, Wt_mgu8 + (size_t)e * 2 * DFFE * D, 4, 8}; ph_wconv8(w, lds, ncv ? vb : -1, ncv, rot8); rot8 = (rot8 + 112) % cvn8; }
                { WC8 w{INP(I_MOE_WD) + (size_t)e * DFFE * D, D, DFFE, D, Wt_mdn8 + (size_t)e * D * DFFE, 0, 4}; ph_wconv8(w, lds, ncv ? vb : -1, ncv, rot8); rot8 = (rot8 + 112) % cvn8; }
            }
          } }
        { DAP dp{INP(I_DA_LQ1), INP(I_DA_LK1), INP(I_DA_LQ2), INP(I_DA_LK2), INP(I_DA_SUBG)}; ph_diff_attn_mfma(QKVb, dp, AOb, lds, ctl + CW_ATTQ, INP(I_DA_QG), INP(I_DA_KG)); }
        BAR();
        { EpiRes E{nullptr, Hb, SSQ}; GEMM_STATIC(AOb, Wt_dao, M, D, D, EpiRes, E); }
        BAR();
    }
    MEM_XATTN(KVb1, Wt_q1, Wt_o1, (bf16_t*)nullptr, 56, 88);
    {
        unsigned char* HN8 = (unsigned char*)WSB(13);
        int* tok_e = (int*)WSF(29); float* tok_w = WSF(29) + 2 * M;
        int* tokpos = (int*)WSF(31);
        int* cnt = (int*)(ctl + CW_CNT);
        unsigned char* AS8 = (unsigned char*)WSB(32);
        bf16_t* Ym = WSB(66);
        unsigned char* Hm8 = (unsigned char*)WSB(134);
        int* bcnt = (int*)WSF(30);
        ph_router(Hb, INP(I_NORM_FFN) + D, INP(I_MOE_WR), INP(I_MOE_BR), HN8, tok_e, tok_w, bcnt, lds);
        BAR();
        ph_moe_place8(HN8, bcnt, tok_e, AS8, tokpos, cnt, lds);
        BAR();
        const int vc = (gridDim.x % 8 == 0) ? (int)((blockIdx.x % 8) * (gridDim.x / 8) + blockIdx.x / 8) : (int)blockIdx.x;
        { MoeOrder S_; S_.cnt = cnt; S_.nN = 2 * DFFE / 256; S_.G = (int)gridDim.x; S_.c = vc; S_.t_lo = 0; S_.t_hi = 136; S_.pm_base = 0;
          pg8::Gemm g_{(const bf16_t*)AS8, (const bf16_t*)Wt_mgu8, 0, 0, D / 2, 0, 0}; EpiSwiGLU8 E{Hm8, DFFE, 2 * DFFE / 256};
          pg8::gemm_phase_f8<EpiSwiGLU8, MoeOrder, PG8_ALIGN, PG8_SP2>(ldsq, g_, S_, E); }
        BAR();
        { MoeOrder S_; S_.cnt = cnt; S_.nN = D / 256; S_.G = (int)gridDim.x; S_.c = vc; S_.t_lo = 0; S_.t_hi = 136; S_.pm_base = 0;
          pg8::Gemm g_{(const bf16_t*)Hm8, (const bf16_t*)Wt_mdn8, 0, 0, DFFE / 2, 0, 0}; EpiBf16S E{Ym, D, D / 256, W8_INV};
          pg8::gemm_phase_f8<EpiBf16S, MoeOrder, PG8_ALIGN, PG8_SP2>(ldsq, g_, S_, E); }
        BAR();
        ph_moe_combine(Ym, tokpos, tok_w, Hb, out);
    }
}

extern "C" void kernel_launch(void* const* d_in, const int* in_sizes, int n_in, void* d_out, int out_size, void* d_ws, size_t ws_size, hipStream_t stream) {
    static int grid = 0;
    if (grid == 0) {
        int dev = 0, cus = 0;
        if (n_in != N_IN || ws_size < (size_t)497 * MiB) { fprintf(stderr, "kernel_launch: unexpected n_in %d / ws %zu\n", n_in, ws_size); grid = -1; return; }
        if (hipGetDevice(&dev) != hipSuccess || hipDeviceGetAttribute(&cus, hipDeviceAttributeMultiprocessorCount, dev) != hipSuccess) { grid = -1; return; }
        if (hipFuncSetAttribute((const void*)fwd, hipFuncAttributeMaxDynamicSharedMemorySize, LDS_BYTES) != hipSuccess) { fprintf(stderr, "hipFuncSetAttribute failed\n"); grid = -1; return; }
        int per_cu = 0;
        if (hipOccupancyMaxActiveBlocksPerMultiprocessor(&per_cu, (const void*)fwd, NTHR, LDS_BYTES) != hipSuccess || per_cu < 1) fprintf(stderr, "occupancy query: %d\n", per_cu);
        (void)hipGetLastError();
        grid = cus;
        if (grid != 256) { fprintf(stderr, "kernel_launch: %d CUs (the phase program deals fixed workgroup ranges of a 256-workgroup grid)\n", cus); grid = -1; return; }
    }
    if (grid < 0) return;
    hipMemsetAsync((char*)d_ws + WS_CTL, 0, CTL_BYTES, stream);
    Params p{};
    for (int i = 0; i < N_IN; ++i) p.in[i] = (const float*)d_in[i];
    p.out = (float*)d_out; p.ws = (unsigned char*)d_ws;
    hipLaunchKernelGGL(fwd, dim3(grid), dim3(NTHR), LDS_BYTES, stream, p);
}
```

```cpp
#include <hip/hip_runtime.h>
#include <stdint.h>
#include <stdio.h>

#define LAS __attribute__((address_space(3)))

#define XB_TMO      128
#define XB_XCNT(j)  (256  + 64 * (j))
#define XB_XSUB(j)  (1280 + 64 * (j))
#define XB_XGEN(j)  (2304 + 64 * (j))
#define XB_TOP      3328
#define XB_TOPGEN   3392
#define XCD_BAR_WORDS 3456
#define XB_SPIN_CAP (1u << 25)

__device__ __forceinline__ unsigned xb_ld(unsigned* p)              { return __hip_atomic_load(p, __ATOMIC_RELAXED, __HIP_MEMORY_SCOPE_AGENT); }
__device__ __forceinline__ unsigned xb_add(unsigned* p, unsigned v) { return __hip_atomic_fetch_add(p, v, __ATOMIC_RELAXED, __HIP_MEMORY_SCOPE_AGENT); }
__device__ __forceinline__ unsigned xb_xcc_id() { return (unsigned)__builtin_amdgcn_s_getreg((3 << 11) | 20) & 0xFu; }
#define XB_SPIN(cond, bar) do { unsigned _sp = 0; while (cond) { __builtin_amdgcn_s_sleep(1); \
    if ((++_sp & 255u) == 0u) { if (xb_ld(&(bar)[XB_TMO])) break; if (_sp > XB_SPIN_CAP) { atomicAdd(&(bar)[XB_TMO], 1u); break; } } } } while (0)

struct XcdBarrier { unsigned* bar; unsigned x; volatile LAS unsigned* st; };

__device__ __forceinline__ XcdBarrier xcd_barrier_post(unsigned* bar, volatile LAS unsigned* st) {
    XcdBarrier b; b.bar = bar; b.x = xb_xcc_id(); b.st = st;
    if (threadIdx.x == 0) st[2] = xb_add(&bar[XB_XCNT(b.x)], 1u);
    return b;
}
__device__ __forceinline__ void xcd_barrier_complete(unsigned* bar, unsigned x, unsigned& nloc, unsigned& nx, unsigned& even) {
    const unsigned G = gridDim.x * gridDim.y * gridDim.z;
    unsigned sum, cnt, mine, cmax, sp = 0u;
    for (;;) {
        sum = 0u; cnt = 0u; mine = 0u; cmax = 0u;
#pragma unroll
        for (unsigned j = 0; j < 16; ++j) { const unsigned c = xb_ld(&bar[XB_XCNT(j)]); sum += c; cnt += (c > 0u) ? 1u : 0u; mine = (j == x) ? c : mine; cmax = c > cmax ? c : cmax; }
        if (sum == G) break;
        __builtin_amdgcn_s_sleep(1);
        if ((++sp & 255u) == 0u) { if (xb_ld(&bar[XB_TMO])) break; if (sp > XB_SPIN_CAP) { atomicAdd(&bar[XB_TMO], 1u); break; } }
    }
    nloc = mine > 0u ? mine : 1u; nx = cnt > 0u ? cnt : 1u; even = (cmax * cnt == sum && sum == G) ? 1u : 0u;
}
__device__ __forceinline__ void xcd_barrier(const XcdBarrier& b) {
    asm volatile("s_waitcnt vmcnt(0)" ::: "memory");
    __syncthreads();
    if (threadIdx.x == 0) {
        unsigned* bar = b.bar;
        __builtin_amdgcn_s_waitcnt(0);
        unsigned nloc = b.st[0], nx = b.st[1];
        if (nloc == 0u) { unsigned even; xcd_barrier_complete(bar, b.x, nloc, nx, even); b.st[0] = nloc; b.st[1] = nx; b.st[3] = even; }
        const unsigned old = xb_add(&bar[XB_XSUB(b.x)], 1u);
        const unsigned gen = old / nloc;
        if (old + 1u == (gen + 1u) * nloc) {
            __builtin_amdgcn_fence(__ATOMIC_RELEASE, "agent");
            asm volatile("s_waitcnt vmcnt(0)" ::: "memory");
            const unsigned og = xb_add(&bar[XB_TOP], 1u);
            const unsigned tg = og / nx;
            const bool lastx = (og + 1u == (tg + 1u) * nx);
            if (!lastx) { __builtin_amdgcn_fence(__ATOMIC_ACQUIRE, "agent"); asm volatile("s_waitcnt vmcnt(0)" ::: "memory"); XB_SPIN(xb_ld(&bar[XB_TOP]) < (tg + 1u) * nx, bar); }
            xb_add(&bar[XB_XGEN(b.x)], 1u);
            if (lastx) __builtin_amdgcn_fence(__ATOMIC_ACQUIRE, "agent");
            asm volatile("s_waitcnt vmcnt(0)" ::: "memory");
        } else {
            __builtin_amdgcn_fence(__ATOMIC_ACQUIRE, "agent");
            asm volatile("s_waitcnt vmcnt(0)" ::: "memory");
            XB_SPIN(xb_ld(&bar[XB_XGEN(b.x)]) == gen, bar);
        }
    }
    __syncthreads();
}

#define XB_XLOC(j)  (3456 + 64 * (j))
__device__ __forceinline__ void xcd_local_barrier(const XcdBarrier& b) {
    asm volatile("s_waitcnt vmcnt(0)" ::: "memory");
    __syncthreads();
    if (threadIdx.x == 0) {
        unsigned* bar = b.bar;
        __builtin_amdgcn_s_waitcnt(0);
        const unsigned nloc = b.st[0];
        const unsigned old = xb_add(&bar[XB_XLOC(b.x)], 1u);
        const unsigned gen = old / nloc;
        __builtin_amdgcn_fence(__ATOMIC_ACQUIRE, "agent");
        asm volatile("s_waitcnt vmcnt(0)" ::: "memory");
        XB_SPIN(xb_ld(&bar[XB_XLOC(b.x)]) < (gen + 1u) * nloc, bar);
    }
    __syncthreads();
}

constexpr int NB = 4, T = 4096, D = 1024, M = NB * T;
constexpr int RCOLS = 1824, INCOLS = 2336, DFF = 2816, NEXP = 8, DFFE = 3584, MEML = 256;
constexpr int NTHR = 512;
constexpr int LDS_BYTES = 147456;
constexpr float NORM_EPS = 1e-6f;
constexpr float LAMBDA_INIT = 0.35550906f;

enum { I_X = 0, I_MEM, I_NORM_MIX, I_NORM_XATTN, I_NORM_MEM, I_NORM_FFN, I_XA_WQ, I_XA_WKV, I_XA_QG, I_XA_KG, I_XA_WO,
       I_HY_WIN, I_RW_MU, I_RW_W0, I_RW_WUP, I_RW_A0, I_RW_AUP, I_RW_GUP, I_RW_KK, I_RW_KA, I_RW_RK, I_RW_LNW, I_RW_LNB,
       I_S5_LRE, I_S5_LIM, I_S5_LDT, I_S5_BRE, I_S5_BIM, I_S5_CRE, I_S5_CIM, I_S5_D, I_S5_WGLU, I_S5_BGLU, I_HY_WOUT,
       I_FF_WG, I_FF_WU, I_FF_WD, I_DA_WQKV, I_DA_QG, I_DA_KG, I_DA_LQ1, I_DA_LK1, I_DA_LQ2, I_DA_LK2, I_DA_SUBG, I_DA_WO,
       I_MOE_WR, I_MOE_BR, I_MOE_WG, I_MOE_WU, I_MOE_WD, N_IN };

struct Params { const float* in[N_IN]; float* out; unsigned char* ws; };

constexpr size_t MiB = 1u << 20;
constexpr size_t WS_CTL = 0, CTL_BYTES = 1 * MiB;
constexpr size_t CW_BAR = 4096;
constexpr size_t CW_CNT = 16384;
constexpr size_t CW_ATTQ = 16448;
constexpr size_t CW_GLUF = 17088;
constexpr size_t CW_R2F = 16512;
#define WSF(mib) ((float*)(ws + (size_t)(mib) * MiB))

__device__ __forceinline__ int otid() { int t = threadIdx.x; asm volatile("" : "+v"(t)); return t; }
__device__ __forceinline__ float wave_sum(float v) {
#pragma unroll
    for (int o = 1; o < 64; o <<= 1) v += __shfl_xor(v, o);
    return v;
}
__device__ __forceinline__ float row_sum_dpp(float v) {
#define DPP_ROR_ADD(n) v += __builtin_bit_cast(float, __builtin_amdgcn_update_dpp(0, __builtin_bit_cast(int, v), 0x120 + (n), 0xf, 0xf, false))
    DPP_ROR_ADD(8); DPP_ROR_ADD(4); DPP_ROR_ADD(2); DPP_ROR_ADD(1);
#undef DPP_ROR_ADD
    return v;
}
__device__ __forceinline__ float wave_sum_dpp(float v) {
    float o;
    asm("s_nop 1\n\tv_add_f32_dpp %0, %1, %1 row_ror:8 row_mask:0xf bank_mask:0xf\n\t"
        "s_nop 1\n\tv_add_f32_dpp %0, %0, %0 row_ror:4 row_mask:0xf bank_mask:0xf\n\t"
        "s_nop 1\n\tv_add_f32_dpp %0, %0, %0 row_ror:2 row_mask:0xf bank_mask:0xf\n\t"
        "s_nop 1\n\tv_add_f32_dpp %0, %0, %0 row_ror:1 row_mask:0xf bank_mask:0xf\n\t"
        "s_nop 1\n\tv_add_f32_dpp %0, %0, %0 row_bcast:15 row_mask:0xa bank_mask:0xf\n\t"
        "s_nop 1\n\tv_add_f32_dpp %0, %0, %0 row_bcast:31 row_mask:0xc bank_mask:0xf"
        : "=&v"(o) : "v"(v));
    return __builtin_bit_cast(float, __builtin_amdgcn_readlane(__builtin_bit_cast(int, o), 63));
}
__device__ __forceinline__ float wave_max(float v) {
#pragma unroll
    for (int o = 1; o < 64; o <<= 1) v = fmaxf(v, __shfl_xor(v, o));
    return v;
}
__device__ __forceinline__ float sigmoidf_(float x) { return 1.0f / (1.0f + expf(-x)); }
__device__ __forceinline__ float fexp2(float x) { return __builtin_amdgcn_exp2f(x); }
__device__ __forceinline__ float fexp(float x) { return __builtin_amdgcn_exp2f(x * 1.4426950408889634f); }
__device__ __forceinline__ float frcp(float x) { return __builtin_amdgcn_rcpf(x); }
__device__ __forceinline__ float frsq(float x) { return __builtin_amdgcn_rsqf(x); }
__device__ __forceinline__ float fsigmoid(float x) { return frcp(1.0f + fexp(-x)); }
__device__ __forceinline__ float ftanh(float x) { const float a = fminf(fmaxf(x, -15.f), 15.f); return 1.0f - 2.0f * frcp(1.0f + fexp(2.0f * a)); }
__device__ __forceinline__ float fsoftplus(float x) { return x > 20.f ? x : __builtin_amdgcn_logf(1.0f + fexp(x)) * 0.6931471805599453f; }
__device__ __forceinline__ float softplusf_(float x) { return x > 20.f ? x : log1pf(expf(x)); }
__device__ __forceinline__ float gelu_tanh(float y) { return 0.5f * y * (1.0f + ftanh(0.7978845608028654f * (y + 0.044715f * y * y * y))); }

namespace pg8 {
#define PG8_LAS __attribute__((address_space(3)))
typedef unsigned short bf16_t;
typedef short bf16x8 __attribute__((ext_vector_type(8)));
typedef float f32x4 __attribute__((ext_vector_type(4)));
typedef unsigned u32x4 __attribute__((ext_vector_type(4)));
constexpr int BM = 256, BK = 64, HALF = 128, HTB = HALF * BK * 2  , STAGE_BYTES = 8 * HTB, NXCD = 8, WGM = 8;

__host__ __device__ __forceinline__ int lds_byte(int r, int c) { const int st = (r >> 4) * 2 + (c >> 5), rr = r & 15, cc = c & 31, ob = rr * 64 + cc * 2; return st * 1024 + (ob ^ (((ob >> 9) & 1) << 5)); }
__host__ __device__ __forceinline__ void stage_rc(int b, int& R, int& C) { const int st = b / 1024, sb = b % 1024, swz = sb ^ (((sb >> 9) & 1) << 5); R = (st >> 1) * 16 + swz / 64; C = (st & 1) * 32 + (swz % 64) / 2; }
__host__ __device__ __forceinline__ int perm32(int rho) { const int n = rho >> 4, i = rho & 15; return 8 * (i >> 2) + 4 * n + (i & 3); }

struct Unit { int pm, pn; };
struct Gemm { const bf16_t* A; const bf16_t* Bt; int M, N, K; int lda, ldb; };

struct StaticOrder {
    int nM, nN, nwg, G, c;
    __host__ __device__ void init(int M, int N, int G_, int c_) { nM = M / BM; nN = N / BM; nwg = nM * nN; G = G_; c = c_; }
    __host__ __device__ bool next(int i, Unit& u) const {
        const long L = (long)i * G + c; if (L >= nwg) return false;
        int wgid = (int)L; { const int q = nwg / NXCD, r = nwg % NXCD, xcd = wgid % NXCD, off = wgid / NXCD; wgid = (xcd < r ? xcd * (q + 1) : r * (q + 1) + (xcd - r) * q) + off; }
        const int nig = WGM * nN, gid = wgid / nig, fm = gid * WGM, gsz = (nM - fm) < WGM ? (nM - fm) : WGM;
        u.pm = fm + ((wgid % nig) % gsz); u.pn = (wgid % nig) / gsz; return true;
    }
    __device__ __forceinline__ void a_ready(const Unit&) const {}
    __device__ __forceinline__ void done(const Unit&) const {}
};
__device__ __forceinline__ void static_unit_of(int nM, int nN, int c, int& pm, int& pn) {
    const int nwg = nM * nN; const int q = nwg / NXCD, r = nwg % NXCD, xcd = c % NXCD, off = c / NXCD; const int wgid = (xcd < r ? xcd * (q + 1) : r * (q + 1) + (xcd - r) * q) + off;
    const int nig = WGM * nN, gid = wgid / nig, fm = gid * WGM, gsz = (nM - fm) < WGM ? (nM - fm) : WGM; pm = fm + ((wgid % nig) % gsz); pn = (wgid % nig) / gsz;
}
typedef float f32x2c __attribute__((ext_vector_type(2)));
typedef __bf16 bf16x2c __attribute__((ext_vector_type(2)));
__device__ __forceinline__ unsigned cvt_pk_bf16(float lo, float hi) { const f32x2c v = {lo, hi}; const bf16x2c r = __builtin_convertvector(v, bf16x2c); return __builtin_bit_cast(unsigned, r); }
typedef float f32x2 __attribute__((ext_vector_type(2)));
template <class Epi, class Sched, bool ALIGN_EPI = false, bool SP2 = false>
__device__ __forceinline__ void gemm_phase(PG8_LAS unsigned char* lds, const Gemm g, const Sched& S, const Epi& E) {
    const int tid = ::otid(), wid = __builtin_amdgcn_readfirstlane(tid >> 6), lane = tid & 63, wr = wid >> 2, wc = wid & 3, fr = lane & 15, fq = lane >> 4;
    const int K = g.K, nt = K / BK; const int lda = g.lda ? g.lda : K, ldb = g.ldb ? g.ldb : K;
    unsigned voffA[2], voffB[2];
#pragma unroll
    for (int i = 0; i < 2; ++i) { int R, C; stage_rc(tid * 16 + i * 8192, R, C); const int Rb = Epi::PERM ? ((R & ~31) + perm32(R & 31)) : R;
        voffA[i] = (unsigned)(R * lda + C) * 2u; voffB[i] = (unsigned)(Rb * ldb + C) * 2u; }
    const size_t kstep = (size_t)(BK * 2);
    const size_t hstepA = (size_t)HALF * lda * 2, hstepB = (size_t)HALF * ldb * 2;
    const size_t tstepA = 2 * hstepA, tstepB = 2 * hstepB;
    const unsigned ldsw = (unsigned)wid * 1024u; const unsigned ldsb32 = (unsigned)(size_t)lds;
    const int aoff = lds_byte(wr * 64 + fr, fq * 8), boff = lds_byte(wc * 32 + fr, fq * 8);
#define PG8_SA(b, h) (((b) * 2 + (h)) * HTB)
#define PG8_SB(b, h) ((4 + (b) * 2 + (h)) * HTB)
#define PG8_STAGE(bufoff, gbase, voff) do { _Pragma("unroll") for (int _i = 0; _i < 2; ++_i) \
        asm volatile("s_mov_b32 m0, %2\n\tglobal_load_lds_dwordx4 %0, %1" :: "v"((voff)[_i]), "s"((const char*)(gbase)), "s"((unsigned)(ldsb32 + (unsigned)(bufoff) + ldsw + (unsigned)(_i * 8192))) : "memory", "m0"); } while (0)
#define PG8_LDA(dst, b, h) do { _Pragma("unroll") for (int m = 0; m < 4; ++m) _Pragma("unroll") for (int k = 0; k < 2; ++k) dst[m][k] = *(const PG8_LAS bf16x8*)(lds + PG8_SA(b, h) + aoff + m * 2048 + k * 1024); } while (0)
#define PG8_LDB(dst, b, h) do { _Pragma("unroll") for (int n = 0; n < 2; ++n) _Pragma("unroll") for (int k = 0; k < 2; ++k) dst[n][k] = *(const PG8_LAS bf16x8*)(lds + PG8_SB(b, h) + boff + n * 2048 + k * 1024); } while (0)
#define PG8_MMA(ai, bj, At, Bt) do { __builtin_amdgcn_s_setprio(1); _Pragma("unroll") for (int m = 0; m < 4; ++m) _Pragma("unroll") for (int n = 0; n < 2; ++n) _Pragma("unroll") for (int k = 0; k < 2; ++k) \
        acc[ai][bj][m][n] = __builtin_amdgcn_mfma_f32_16x16x32_bf16(Bt[n][k], At[m][k], acc[ai][bj][m][n], 0, 0, 0); __builtin_amdgcn_s_setprio(0); } while (0)
#define PG8_WAIT_V(n) asm volatile("s_waitcnt vmcnt(" #n ")" ::: "memory")
#define PG8_WAIT_L(n) asm volatile("s_waitcnt lgkmcnt(" #n ")" ::: "memory")
#define PG8_BAR __builtin_amdgcn_s_barrier()
#define PG8_SCHED __builtin_amdgcn_sched_barrier(0)
    Unit cur, nxt; int ui = 0;
    if (!S.next(0, cur)) return;
    f32x4 acc[2][2][4][2];
#pragma unroll
    for (int a = 0; a < 2; ++a)
#pragma unroll
        for (int b = 0; b < 2; ++b)
#pragma unroll
            for (int m = 0; m < 4; ++m)
#pragma unroll
                for (int n = 0; n < 2; ++n) acc[a][b][m][n] = (f32x4){0.f, 0.f, 0.f, 0.f};
    bf16x8 At[4][2], B0[2][2], B1[2][2];
    const char* cA = (const char*)g.A + (size_t)cur.pm * tstepA; const char* cB = (const char*)g.Bt + (size_t)cur.pn * tstepB;
    S.a_ready(cur);
    if constexpr (SP2) {
        PG8_STAGE(PG8_SB(0, 0), cB, voffB); PG8_STAGE(PG8_SB(0, 1), cB + hstepB, voffB); PG8_STAGE(PG8_SA(0, 0), cA, voffA); PG8_STAGE(PG8_SA(0, 1), cA + hstepA, voffA);
        if (wr == 1) PG8_BAR;
        PG8_WAIT_V(2); PG8_BAR;
        PG8_STAGE(PG8_SB(1, 0), cB + kstep, voffB); PG8_STAGE(PG8_SA(1, 0), cA + kstep, voffA); PG8_STAGE(PG8_SB(1, 1), cB + hstepB + kstep, voffB);
        PG8_WAIT_V(6); PG8_BAR;
    } else {
        PG8_STAGE(PG8_SB(0, 0), cB, voffB); PG8_STAGE(PG8_SA(0, 0), cA, voffA); PG8_STAGE(PG8_SB(0, 1), cB + hstepB, voffB); PG8_STAGE(PG8_SA(0, 1), cA + hstepA, voffA);
        if (wr == 1) PG8_BAR;
        PG8_WAIT_V(4); PG8_BAR;
        PG8_STAGE(PG8_SB(1, 0), cB + kstep, voffB); PG8_STAGE(PG8_SA(1, 0), cA + kstep, voffA); PG8_STAGE(PG8_SB(1, 1), cB + hstepB + kstep, voffB);
        PG8_WAIT_V(6); PG8_BAR;
    }
    for (;;) {
        const bool has_next = S.next(ui + 1, nxt);
        const char* nA = has_next ? (const char*)g.A + (size_t)nxt.pm * tstepA : cA; const char* nB = has_next ? (const char*)g.Bt + (size_t)nxt.pn * tstepB : cB;
        for (int t = 0; t < nt; t += 2) {
            const bool last = (t == nt - 2);
            const char* a1 = cA + (size_t)(t + 1) * kstep;
            const char* a2 = last ? nA : cA + (size_t)(t + 2) * kstep; const char* b2 = last ? nB : cB + (size_t)(t + 2) * kstep;
            const char* a3 = a2 + kstep; const char* b3 = b2 + kstep;
            if (last && has_next) S.a_ready(nxt);
            if constexpr (SP2) {
            PG8_LDB(B0, 0, 0); PG8_LDB(B1, 0, 1); PG8_SCHED; PG8_LDA(At, 0, 0); PG8_STAGE(PG8_SA(1, 1), a1 + hstepA, voffA);
            PG8_WAIT_V(8); PG8_WAIT_L(0); PG8_BAR; PG8_MMA(0, 0, At, B0); PG8_MMA(0, 1, At, B1); PG8_BAR; PG8_SCHED;
            PG8_LDA(At, 0, 1); PG8_STAGE(PG8_SB(0, 0), b2, voffB); PG8_STAGE(PG8_SB(0, 1), b2 + hstepB, voffB); PG8_STAGE(PG8_SA(0, 0), a2, voffA);
            PG8_WAIT_V(8); PG8_WAIT_L(0); PG8_BAR; PG8_MMA(1, 0, At, B0); PG8_MMA(1, 1, At, B1); PG8_BAR; PG8_SCHED;
            PG8_LDB(B0, 1, 0); PG8_LDB(B1, 1, 1); PG8_SCHED; PG8_LDA(At, 1, 0); PG8_STAGE(PG8_SA(0, 1), a2 + hstepA, voffA);
            PG8_WAIT_V(8); PG8_WAIT_L(0); PG8_BAR; PG8_MMA(0, 0, At, B0); PG8_MMA(0, 1, At, B1); PG8_BAR; PG8_SCHED;
            PG8_LDA(At, 1, 1); PG8_STAGE(PG8_SB(1, 0), b3, voffB); PG8_STAGE(PG8_SB(1, 1), b3 + hstepB, voffB); PG8_STAGE(PG8_SA(1, 0), a3, voffA);
            PG8_WAIT_V(8); PG8_WAIT_L(0); PG8_BAR; PG8_MMA(1, 0, At, B0); PG8_MMA(1, 1, At, B1); PG8_BAR; PG8_SCHED;
            } else {
            PG8_LDB(B0, 0, 0); PG8_SCHED; PG8_LDA(At, 0, 0); PG8_STAGE(PG8_SA(1, 1), a1 + hstepA, voffA);
            PG8_WAIT_L(8); PG8_BAR; PG8_WAIT_L(0); PG8_MMA(0, 0, At, B0); PG8_BAR; PG8_SCHED;
            PG8_LDB(B1, 0, 1); PG8_STAGE(PG8_SB(0, 0), b2, voffB);
            PG8_BAR; PG8_WAIT_L(0); PG8_MMA(0, 1, At, B1); PG8_BAR;
            PG8_LDA(At, 0, 1); PG8_STAGE(PG8_SA(0, 0), a2, voffA);
            PG8_BAR; PG8_WAIT_L(0); PG8_MMA(1, 0, At, B0); PG8_BAR; PG8_SCHED;
            PG8_STAGE(PG8_SB(0, 1), b2 + hstepB, voffB);
            PG8_WAIT_V(6); PG8_BAR; PG8_MMA(1, 1, At, B1); PG8_BAR;
            PG8_LDB(B0, 1, 0); PG8_SCHED; PG8_LDA(At, 1, 0); PG8_STAGE(PG8_SA(0, 1), a2 + hstepA, voffA);
            PG8_WAIT_L(8); PG8_BAR; PG8_WAIT_L(0); PG8_MMA(0, 0, At, B0); PG8_BAR; PG8_SCHED;
            PG8_LDB(B1, 1, 1); PG8_STAGE(PG8_SB(1, 0), b3, voffB);
            PG8_BAR; PG8_WAIT_L(0); PG8_MMA(0, 1, At, B1); PG8_BAR;
            PG8_LDA(At, 1, 1); PG8_STAGE(PG8_SA(1, 0), a3, voffA);
            PG8_BAR; PG8_WAIT_L(0); PG8_MMA(1, 0, At, B0); PG8_BAR; PG8_SCHED;
            PG8_STAGE(PG8_SB(1, 1), b3 + hstepB, voffB);
            PG8_WAIT_V(6); PG8_BAR; PG8_MMA(1, 1, At, B1); PG8_BAR;
            }
        }
        if constexpr (ALIGN_EPI) { if (wr == 0) PG8_BAR; }
        if constexpr (!Epi::AFTER_DRAIN) { const int t2_ = ::otid(), l2_ = t2_ & 63, w2_ = __builtin_amdgcn_readfirstlane(t2_ >> 6);
            E(acc, cur, w2_ >> 2, w2_ & 3, l2_ & 15, l2_ >> 4); S.done(cur); }
        if (!has_next) break;
#pragma unroll
        for (int a = 0; a < 2; ++a)
#pragma unroll
            for (int b = 0; b < 2; ++b)
#pragma unroll
                for (int m = 0; m < 4; ++m)
#pragma unroll
                    for (int n = 0; n < 2; ++n) acc[a][b][m][n] = (f32x4){0.f, 0.f, 0.f, 0.f};
        cur = nxt; cA = nA; cB = nB; ++ui;
        if constexpr (ALIGN_EPI) { if (wr == 1) PG8_BAR; }
    }
    PG8_WAIT_V(0);
    if constexpr (!ALIGN_EPI) { if (wr == 0) PG8_BAR; }
    PG8_BAR;
    if constexpr (Epi::AFTER_DRAIN) { E.fused(acc, cur, wr, wc, fr, fq, lds, wid, lane); S.done(cur); }
#undef PG8_SA
#undef PG8_SB
#undef PG8_STAGE
#undef PG8_LDA
#undef PG8_LDB
#undef PG8_MMA
#undef PG8_WAIT_V
#undef PG8_WAIT_L
#undef PG8_BAR
#undef PG8_SCHED
}
typedef int v8i32 __attribute__((ext_vector_type(8)));
typedef int v4i32 __attribute__((ext_vector_type(4)));
template <class Epi, class Sched, bool ALIGN_EPI = false, bool SP2 = false>
__device__ __forceinline__ void gemm_phase_f8(PG8_LAS unsigned char* lds, const Gemm g, const Sched& S, const Epi& E) {
    const int tid = ::otid(), wid = __builtin_amdgcn_readfirstlane(tid >> 6), lane = tid & 63, wr = wid >> 2, wc = wid & 3, fr = lane & 15, fq = lane >> 4;
    const int K = g.K, nt = K / BK; const int lda = g.lda ? g.lda : K, ldb = g.ldb ? g.ldb : K;
    unsigned voffA[2], voffB[2];
#pragma unroll
    for (int i = 0; i < 2; ++i) { int R, C; stage_rc(tid * 16 + i * 8192, R, C); const int Rb = Epi::PERM ? ((R & ~31) + perm32(R & 31)) : R;
        voffA[i] = (unsigned)(R * lda + C) * 2u; voffB[i] = (unsigned)(Rb * ldb + C) * 2u; }
    const size_t kstep = (size_t)(BK * 2);
    const size_t hstepA = (size_t)HALF * lda * 2, hstepB = (size_t)HALF * ldb * 2;
    const size_t tstepA = 2 * hstepA, tstepB = 2 * hstepB;
    const unsigned ldsw = (unsigned)wid * 1024u; const unsigned ldsb32 = (unsigned)(size_t)lds;
    const int aoff = lds_byte(wr * 64 + fr, 16 * (fq & 1)) + (fq >> 1) * 1024, boff = lds_byte(wc * 32 + fr, 16 * (fq & 1)) + (fq >> 1) * 1024;
#define PG8_SA(b, h) (((b) * 2 + (h)) * HTB)
#define PG8_SB(b, h) ((4 + (b) * 2 + (h)) * HTB)
#define PG8_STAGE(bufoff, gbase, voff) do { _Pragma("unroll") for (int _i = 0; _i < 2; ++_i) \
        asm volatile("s_mov_b32 m0, %2\n\tglobal_load_lds_dwordx4 %0, %1" :: "v"((voff)[_i]), "s"((const char*)(gbase)), "s"((unsigned)(ldsb32 + (unsigned)(bufoff) + ldsw + (unsigned)(_i * 8192))) : "memory", "m0"); } while (0)
#define PG8_LDA(dst, b, h) do { _Pragma("unroll") for (int m = 0; m < 4; ++m) { const v4i32 lo_ = *(const PG8_LAS v4i32*)(lds + PG8_SA(b, h) + aoff + m * 2048), hi_ = *(const PG8_LAS v4i32*)(lds + PG8_SA(b, h) + aoff + m * 2048 + 16); dst[m] = __builtin_shufflevector(lo_, hi_, 0, 1, 2, 3, 4, 5, 6, 7); } } while (0)
#define PG8_LDB(dst, b, h) do { _Pragma("unroll") for (int n = 0; n < 2; ++n) { const v4i32 lo_ = *(const PG8_LAS v4i32*)(lds + PG8_SB(b, h) + boff + n * 2048), hi_ = *(const PG8_LAS v4i32*)(lds + PG8_SB(b, h) + boff + n * 2048 + 16); dst[n] = __builtin_shufflevector(lo_, hi_, 0, 1, 2, 3, 4, 5, 6, 7); } } while (0)
#define PG8_MMA(ai, bj, At, Bt) do { __builtin_amdgcn_s_setprio(1); _Pragma("unroll") for (int m = 0; m < 4; ++m) _Pragma("unroll") for (int n = 0; n < 2; ++n) \
        acc[ai][bj][m][n] = __builtin_amdgcn_mfma_scale_f32_16x16x128_f8f6f4(Bt[n], At[m], acc[ai][bj][m][n], 0, 0, 0, 0x7F7F7F7F, 0, 0x7F7F7F7F); \
          \
        asm volatile("" : "+v"(acc[ai][bj][0][0]), "+v"(acc[ai][bj][0][1]), "+v"(acc[ai][bj][1][0]), "+v"(acc[ai][bj][1][1]), "+v"(acc[ai][bj][2][0]), "+v"(acc[ai][bj][2][1]), "+v"(acc[ai][bj][3][0]), "+v"(acc[ai][bj][3][1])); \
        __builtin_amdgcn_s_setprio(0); } while (0)
#define PG8_WAIT_V(n) asm volatile("s_waitcnt vmcnt(" #n ")" ::: "memory")
#define PG8_WAIT_L(n) asm volatile("s_waitcnt lgkmcnt(" #n ")" ::: "memory")
#define PG8_BAR __builtin_amdgcn_s_barrier()
#define PG8_SCHED __builtin_amdgcn_sched_barrier(0)
    Unit cur, nxt; int ui = 0;
    if (!S.next(0, cur)) return;
    f32x4 acc[2][2][4][2];
#pragma unroll
    for (int a = 0; a < 2; ++a)
#pragma unroll
        for (int b = 0; b < 2; ++b)
#pragma unroll
            for (int m = 0; m < 4; ++m)
#pragma unroll
                for (int n = 0; n < 2; ++n) acc[a][b][m][n] = (f32x4){0.f, 0.f, 0.f, 0.f};
    v8i32 At[4], B0[2], B1[2];
    const char* cA = (const char*)g.A + (size_t)cur.pm * tstepA; const char* cB = (const char*)g.Bt + (size_t)cur.pn * tstepB;
    S.a_ready(cur);
    if constexpr (SP2) {
        PG8_STAGE(PG8_SB(0, 0), cB, voffB); PG8_STAGE(PG8_SB(0, 1), cB + hstepB, voffB); PG8_STAGE(PG8_SA(0, 0), cA, voffA); PG8_STAGE(PG8_SA(0, 1), cA + hstepA, voffA);
        if (wr == 1) PG8_BAR;
        PG8_WAIT_V(2); PG8_BAR;
        PG8_STAGE(PG8_SB(1, 0), cB + kstep, voffB); PG8_STAGE(PG8_SA(1, 0), cA + kstep, voffA); PG8_STAGE(PG8_SB(1, 1), cB + hstepB + kstep, voffB);
        PG8_WAIT_V(6); PG8_BAR;
    } else {
        PG8_STAGE(PG8_SB(0, 0), cB, voffB); PG8_STAGE(PG8_SA(0, 0), cA, voffA); PG8_STAGE(PG8_SB(0, 1), cB + hstepB, voffB); PG8_STAGE(PG8_SA(0, 1), cA + hstepA, voffA);
        if (wr == 1) PG8_BAR;
        PG8_WAIT_V(4); PG8_BAR;
        PG8_STAGE(PG8_SB(1, 0), cB + kstep, voffB); PG8_STAGE(PG8_SA(1, 0), cA + kstep, voffA); PG8_STAGE(PG8_SB(1, 1), cB + hstepB + kstep, voffB);
        PG8_WAIT_V(6); PG8_BAR;
    }
    for (;;) {
        const bool has_next = S.next(ui + 1, nxt);
        const char* nA = has_next ? (const char*)g.A + (size_t)nxt.pm * tstepA : cA; const char* nB = has_next ? (const char*)g.Bt + (size_t)nxt.pn * tstepB : cB;
#pragma unroll 1
        for (int t = 0; t < nt; t += 2) {
            const bool last = (t == nt - 2);
            const char* a1 = cA + (size_t)(t + 1) * kstep;
            const char* a2 = last ? nA : cA + (size_t)(t + 2) * kstep; const char* b2 = last ? nB : cB + (size_t)(t + 2) * kstep;
            const char* a3 = a2 + kstep; const char* b3 = b2 + kstep;
            if (last && has_next) S.a_ready(nxt);
            if constexpr (SP2) {
            PG8_LDB(B0, 0, 0); PG8_LDB(B1, 0, 1); PG8_SCHED; PG8_LDA(At, 0, 0); PG8_STAGE(PG8_SA(1, 1), a1 + hstepA, voffA);
            PG8_WAIT_V(8); PG8_WAIT_L(0); PG8_BAR; PG8_MMA(0, 0, At, B0); PG8_MMA(0, 1, At, B1); PG8_BAR; PG8_SCHED;
            PG8_LDA(At, 0, 1); PG8_STAGE(PG8_SB(0, 0), b2, voffB); PG8_STAGE(PG8_SB(0, 1), b2 + hstepB, voffB); PG8_STAGE(PG8_SA(0, 0), a2, voffA);
            PG8_WAIT_V(8); PG8_WAIT_L(0); PG8_BAR; PG8_MMA(1, 0, At, B0); PG8_MMA(1, 1, At, B1); PG8_BAR; PG8_SCHED;
            PG8_LDB(B0, 1, 0); PG8_LDB(B1, 1, 1); PG8_SCHED; PG8_LDA(At, 1, 0); PG8_STAGE(PG8_SA(0, 1), a2 + hstepA, voffA);
            PG8_WAIT_V(8); PG8_WAIT_L(0); PG8_BAR; PG8_MMA(0, 0, At, B0); PG8_MMA(0, 1, At, B1); PG8_BAR; PG8_SCHED;
            PG8_LDA(At, 1, 1); PG8_STAGE(PG8_SB(1, 0), b3, voffB); PG8_STAGE(PG8_SB(1, 1), b3 + hstepB, voffB); PG8_STAGE(PG8_SA(1, 0), a3, voffA);
            PG8_WAIT_V(8); PG8_WAIT_L(0); PG8_BAR; PG8_MMA(1, 0, At, B0); PG8_MMA(1, 1, At, B1); PG8_BAR; PG8_SCHED;
            } else {
            PG8_LDB(B0, 0, 0); PG8_SCHED; PG8_LDA(At, 0, 0); PG8_STAGE(PG8_SA(1, 1), a1 + hstepA, voffA);
            PG8_WAIT_L(8); PG8_BAR; PG8_WAIT_L(0); PG8_MMA(0, 0, At, B0); PG8_BAR; PG8_SCHED;
            PG8_LDB(B1, 0, 1); PG8_STAGE(PG8_SB(0, 0), b2, voffB);
            PG8_BAR; PG8_WAIT_L(0); PG8_MMA(0, 1, At, B1); PG8_BAR;
            PG8_LDA(At, 0, 1); PG8_STAGE(PG8_SA(0, 0), a2, voffA);
            PG8_BAR; PG8_WAIT_L(0); PG8_MMA(1, 0, At, B0); PG8_BAR; PG8_SCHED;
            PG8_STAGE(PG8_SB(0, 1), b2 + hstepB, voffB);
            PG8_WAIT_V(6); PG8_BAR; PG8_MMA(1, 1, At, B1); PG8_BAR;
            PG8_LDB(B0, 1, 0); PG8_SCHED; PG8_LDA(At, 1, 0); PG8_STAGE(PG8_SA(0, 1), a2 + hstepA, voffA);
            PG8_WAIT_L(8); PG8_BAR; PG8_WAIT_L(0); PG8_MMA(0, 0, At, B0); PG8_BAR; PG8_SCHED;
            PG8_LDB(B1, 1, 1); PG8_STAGE(PG8_SB(1, 0), b3, voffB);
            PG8_BAR; PG8_WAIT_L(0); PG8_MMA(0, 1, At, B1); PG8_BAR;
            PG8_LDA(At, 1, 1); PG8_STAGE(PG8_SA(1, 0), a3, voffA);
            PG8_BAR; PG8_WAIT_L(0); PG8_MMA(1, 0, At, B0); PG8_BAR; PG8_SCHED;
            PG8_STAGE(PG8_SB(1, 1), b3 + hstepB, voffB);
            PG8_WAIT_V(6); PG8_BAR; PG8_MMA(1, 1, At, B1); PG8_BAR;
            }
        }
        if constexpr (ALIGN_EPI) { if (wr == 0) PG8_BAR; }
        if constexpr (!Epi::AFTER_DRAIN) { const int t2_ = ::otid(), l2_ = t2_ & 63, w2_ = __builtin_amdgcn_readfirstlane(t2_ >> 6);
            E(acc, cur, w2_ >> 2, w2_ & 3, l2_ & 15, l2_ >> 4); S.done(cur); }
        if (!has_next) break;
#pragma unroll
        for (int a = 0; a < 2; ++a)
#pragma unroll
            for (int b = 0; b < 2; ++b)
#pragma unroll
                for (int m = 0; m < 4; ++m)
#pragma unroll
                    for (int n = 0; n < 2; ++n) acc[a][b][m][n] = (f32x4){0.f, 0.f, 0.f, 0.f};
        cur = nxt; cA = nA; cB = nB; ++ui;
        if constexpr (ALIGN_EPI) { if (wr == 1) PG8_BAR; }
    }
    PG8_WAIT_V(0);
    if constexpr (!ALIGN_EPI) { if (wr == 0) PG8_BAR; }
    PG8_BAR;
    if constexpr (Epi::AFTER_DRAIN) { E.fused(acc, cur, wr, wc, fr, fq, lds, wid, lane); S.done(cur); }
#undef PG8_SA
#undef PG8_SB
#undef PG8_STAGE
#undef PG8_LDA
#undef PG8_LDB
#undef PG8_MMA
#undef PG8_WAIT_V
#undef PG8_WAIT_L
#undef PG8_BAR
#undef PG8_SCHED
}
}

#ifndef PG8_SP2
#define PG8_SP2 true
#endif
#ifndef PG8_ALIGN
#define PG8_ALIGN true
#endif
typedef pg8::bf16_t bf16_t;
__device__ __forceinline__ unsigned f2bf(float f) { return pg8::cvt_pk_bf16(f, f) & 0xffffu; }
__device__ __forceinline__ unsigned pk2(float lo, float hi) { return pg8::cvt_pk_bf16(lo, hi); }
__device__ __forceinline__ float bf2f(unsigned short b) { return __builtin_bit_cast(float, ((unsigned)b) << 16); }
__device__ __forceinline__ unsigned pk4_fp8(float a, float b, float c, float d) { unsigned r = 0; r = __builtin_amdgcn_cvt_pk_fp8_f32(a, b, r, false); r = __builtin_amdgcn_cvt_pk_fp8_f32(c, d, r, true); return r; }

struct EpiF32R {
    static constexpr bool PERM = false, AFTER_DRAIN = false;
    float* C; int ldc; const float* R; int ncols; float* C2; int ldc2; int split; int nN;
    __device__ __forceinline__ void operator()(const pg8::f32x4 (&acc)[2][2][4][2], const pg8::Unit& u, int wr, int wc, int fr, int fq) const {
        const int row0 = u.pm * 256 + wr * 64 + fr, col0 = (nN ? (u.pn % nN) : u.pn) * 256 + wc * 32 + 4 * fq;
#pragma unroll
        for (int ai = 0; ai < 2; ++ai)
#pragma unroll
            for (int m = 0; m < 4; ++m) { const size_t row = (size_t)(row0 + ai * 128 + m * 16);
#pragma unroll
                for (int bj = 0; bj < 2; ++bj)
#pragma unroll
                    for (int n = 0; n < 2; ++n) { const int col = col0 + bj * 128 + n * 16;
                        if (col < ncols) {
                            pg8::f32x4 v = acc[ai][bj][m][n];
                            if (col < split) { if (R) v += *(const pg8::f32x4*)(R + row * ldc + col); *(pg8::f32x4*)(C + row * ldc + col) = v; }
                            else *(pg8::f32x4*)(C2 + row * ldc2 + (col - split)) = v;
                        } } }
    }
};
__device__ __forceinline__ float row_rstd(const float* ssq, int row) {
    const pg8::f32x4* p4 = (const pg8::f32x4*)(ssq + (size_t)row * 16); const pg8::f32x4 a = p4[0], b = p4[1], c = p4[2], d = p4[3];
    const float t = ((a[0] + a[1]) + (a[2] + a[3])) + ((b[0] + b[1]) + (b[2] + b[3])) + ((c[0] + c[1]) + (c[2] + c[3])) + ((d[0] + d[1]) + (d[2] + d[3]));
    return 1.0f / sqrtf(t * (1.0f / 1024.0f) + NORM_EPS);
}
struct EpiSwiGLU {
    static constexpr bool PERM = true, AFTER_DRAIN = false;
    bf16_t* H; int ldh; int nN; int row_shift; const float* ssq;
    __device__ __forceinline__ void operator()(const pg8::f32x4 (&acc)[2][2][4][2], const pg8::Unit& u, int wr, int wc, int fr, int fq) const {
        const int row0 = u.pm * 256 + wr * 64 + fr + row_shift; const int pnl = nN ? (u.pn % nN) : u.pn;
        const int hc0 = (pnl * 256 + wc * 32 + 8 * fq) >> 1;
#pragma unroll
        for (int ai = 0; ai < 2; ++ai)
#pragma unroll
            for (int m = 0; m < 4; ++m) { bf16_t* rowp = H + (size_t)(row0 + ai * 128 + m * 16) * ldh + hc0; const float rs = ssq ? row_rstd(ssq, row0 + ai * 128 + m * 16) : 1.0f;
#pragma unroll
                for (int bj = 0; bj < 2; ++bj) { const pg8::f32x4 g = acc[ai][bj][m][0] * rs, up = acc[ai][bj][m][1] * rs; float o[4];
#pragma unroll
                    for (int j = 0; j < 4; ++j) o[j] = g[j] * __builtin_amdgcn_rcpf(1.0f + __expf(-g[j])) * up[j];
                    uint2 w; w.x = pg8::cvt_pk_bf16(o[0], o[1]); w.y = pg8::cvt_pk_bf16(o[2], o[3]);
                    *(uint2*)(rowp + bj * 64) = w; } }
    }
};
struct EpiBf16P {
    static constexpr bool PERM = true, AFTER_DRAIN = false;
    bf16_t* O; int ldc; int nN; int row_shift; const float* ssq;
    __device__ __forceinline__ void operator()(const pg8::f32x4 (&acc)[2][2][4][2], const pg8::Unit& u, int wr, int wc, int fr, int fq) const {
        const int row0 = u.pm * 256 + wr * 64 + fr + row_shift; const int pnl = nN ? (u.pn % nN) : u.pn;
        const int col0 = pnl * 256 + wc * 32 + 8 * fq;
#pragma unroll
        for (int ai = 0; ai < 2; ++ai)
#pragma unroll
            for (int m = 0; m < 4; ++m) { bf16_t* rowp = O + (size_t)(row0 + ai * 128 + m * 16) * ldc + col0; const float rs = ssq ? row_rstd(ssq, row0 + ai * 128 + m * 16) : 1.0f;
#pragma unroll
                for (int bj = 0; bj < 2; ++bj) { const pg8::f32x4 v0 = acc[ai][bj][m][0] * rs, v1 = acc[ai][bj][m][1] * rs;
                    pg8::u32x4 w; w.x = pg8::cvt_pk_bf16(v0[0], v0[1]); w.y = pg8::cvt_pk_bf16(v0[2], v0[3]); w.z = pg8::cvt_pk_bf16(v1[0], v1[1]); w.w = pg8::cvt_pk_bf16(v1[2], v1[3]);
                    *(pg8::u32x4*)(rowp + bj * 128) = w; } }
    }
};


template <bool HALFN> struct EpiF32S {
    static constexpr bool PERM = false, AFTER_DRAIN = false;
    float* C; int ldc; int nN;
    __device__ __forceinline__ void operator()(const pg8::f32x4 (&acc)[2][2][4][2], const pg8::Unit& u, int wr, int wc, int fr, int fq) const {
        const int row0 = u.pm * 256 + wr * 64 + fr, col0 = (nN ? (u.pn % nN) : u.pn) * 256 + wc * 32 + 4 * fq;
#pragma unroll
        for (int ai = 0; ai < 2; ++ai)
#pragma unroll
            for (int m = 0; m < 4; ++m) { float* rowp = C + (size_t)(row0 + ai * 128 + m * 16) * ldc + col0;
#pragma unroll
                for (int bj = 0; bj < (HALFN ? 1 : 2); ++bj)
#pragma unroll
                    for (int n = 0; n < 2; ++n) *(pg8::f32x4*)(rowp + bj * 128 + n * 16) = acc[ai][bj][m][n]; }
    }
};
struct EpiRes {
    static constexpr bool PERM = false, AFTER_DRAIN = false;
    const float* R32; bf16_t* Hb; float* ssq;
    __device__ __forceinline__ void operator()(const pg8::f32x4 (&acc)[2][2][4][2], const pg8::Unit& u, int wr, int wc, int fr, int fq) const {
        const int row0 = u.pm * 256 + wr * 64 + fr, col0 = u.pn * 256 + wc * 32 + 4 * fq;
#pragma unroll
        for (int ai = 0; ai < 2; ++ai)
#pragma unroll
            for (int m = 0; m < 4; ++m) { const size_t row = (size_t)(row0 + ai * 128 + m * 16); float sq = 0.f;
#pragma unroll
                for (int bj = 0; bj < 2; ++bj)
#pragma unroll
                    for (int n = 0; n < 2; ++n) { const int col = col0 + bj * 128 + n * 16;
                        pg8::f32x4 v = acc[ai][bj][m][n];
                        if (R32) v += *(const pg8::f32x4*)(R32 + row * D + col);
                        else { const uint2 rw = *(const uint2*)(Hb + row * D + col);
                            v[0] += bf2f((unsigned short)(rw.x & 0xffff)); v[1] += bf2f((unsigned short)(rw.x >> 16)); v[2] += bf2f((unsigned short)(rw.y & 0xffff)); v[3] += bf2f((unsigned short)(rw.y >> 16)); }
                        uint2 w; w.x = pg8::cvt_pk_bf16(v[0], v[1]); w.y = pg8::cvt_pk_bf16(v[2], v[3]); *(uint2*)(Hb + row * D + col) = w;
                        sq += (v[0] * v[0] + v[1] * v[1]) + (v[2] * v[2] + v[3] * v[3]); }
                sq += __shfl_xor(sq, 16); sq += __shfl_xor(sq, 32); if (fq == 0) ssq[row * 16 + u.pn * 4 + wc] = sq; }
    }
};
struct EpiGLU {
    static constexpr bool PERM = true, AFTER_DRAIN = false;
    const float* YS; const float* bglu; bf16_t* YMIX;
    __device__ __forceinline__ void operator()(const pg8::f32x4 (&acc)[2][2][4][2], const pg8::Unit& u, int wr, int wc, int fr, int fq) const {
        const int row0 = u.pm * 256 + wr * 64 + fr, col0 = u.pn * 256 + wc * 32 + 8 * fq;
#pragma unroll
        for (int ai = 0; ai < 2; ++ai)
#pragma unroll
            for (int m = 0; m < 4; ++m) { const size_t row = (size_t)(row0 + ai * 128 + m * 16);
#pragma unroll
                for (int bj = 0; bj < 2; ++bj) { const int col = col0 + bj * 128;
                    const pg8::f32x4 y0 = *(const pg8::f32x4*)(YS + row * 512 + col), y1 = *(const pg8::f32x4*)(YS + row * 512 + col + 4);
                    const pg8::f32x4 b0 = *(const pg8::f32x4*)(bglu + col), b1 = *(const pg8::f32x4*)(bglu + col + 4);
                    const pg8::f32x4 a0 = acc[ai][bj][m][0] + b0, a1 = acc[ai][bj][m][1] + b1; float o[8];
#pragma unroll
                    for (int j = 0; j < 4; ++j) { o[j] = y0[j] * __builtin_amdgcn_rcpf(1.0f + __expf(-a0[j])); o[4 + j] = y1[j] * __builtin_amdgcn_rcpf(1.0f + __expf(-a1[j])); }
                    pg8::u32x4 w; w.x = pg8::cvt_pk_bf16(o[0], o[1]); w.y = pg8::cvt_pk_bf16(o[2], o[3]); w.z = pg8::cvt_pk_bf16(o[4], o[5]); w.w = pg8::cvt_pk_bf16(o[6], o[7]);
                    *(pg8::u32x4*)(YMIX + row * 1024 + 512 + col) = w; } }
    }
};

struct EpiQKV {
    static constexpr bool PERM = true, AFTER_DRAIN = false;
    bf16_t* O; const float* ssq; const float* qg; const float* kg;
    __device__ __forceinline__ void operator()(const pg8::f32x4 (&acc)[2][2][4][2], const pg8::Unit& u, int wr, int wc, int fr, int fq) const {
        const int row0 = u.pm * 256 + wr * 64 + fr; const int G = 4 * u.pn + wc;
        const float* gp = G < 16 ? qg : kg; const float post = G < 16 ? 0.125f * 1.4426950408889634f : 1.0f;
        pg8::f32x4 gv[2][2];
#pragma unroll
        for (int bj = 0; bj < 2; ++bj)
#pragma unroll
            for (int n = 0; n < 2; ++n) gv[bj][n] = (G < 32) ? *(const pg8::f32x4*)(gp + 32 * bj + 8 * fq + 4 * n) * post : (pg8::f32x4){1.f, 1.f, 1.f, 1.f};
#pragma unroll
        for (int ai = 0; ai < 2; ++ai)
#pragma unroll
            for (int m = 0; m < 4; ++m) { const int row = row0 + ai * 128 + m * 16; const float rs = row_rstd(ssq, row);
                pg8::f32x4 v[2][2]; float sq = 0.f;
#pragma unroll
                for (int bj = 0; bj < 2; ++bj)
#pragma unroll
                    for (int n = 0; n < 2; ++n) { v[bj][n] = acc[ai][bj][m][n] * rs; sq += (v[bj][n][0] * v[bj][n][0] + v[bj][n][1] * v[bj][n][1]) + (v[bj][n][2] * v[bj][n][2] + v[bj][n][3] * v[bj][n][3]); }
                sq += __shfl_xor(sq, 16); sq += __shfl_xor(sq, 32);
                const float rn = (G < 32) ? frsq(sq * (1.0f / 64.0f) + NORM_EPS) : 1.0f;
                bf16_t* rowp = O + (size_t)row * 3072 + 64 * G + 8 * fq;
#pragma unroll
                for (int bj = 0; bj < 2; ++bj) { const pg8::f32x4 a = v[bj][0] * rn * gv[bj][0], b = v[bj][1] * rn * gv[bj][1];
                    pg8::u32x4 w; w.x = pg8::cvt_pk_bf16(a[0], a[1]); w.y = pg8::cvt_pk_bf16(a[2], a[3]); w.z = pg8::cvt_pk_bf16(b[0], b[1]); w.w = pg8::cvt_pk_bf16(b[2], b[3]);
                    *(pg8::u32x4*)(rowp + 32 * bj) = w; } }
    }
};
struct MoeOrder {
    const int* cnt; int nN, G, c, t_lo, t_hi, pm_base;
    __device__ __forceinline__ bool next(int i, pg8::Unit& u) const {
        int ts[9]; ts[0] = 0;
#pragma unroll
        for (int e = 0; e < 8; ++e) ts[e + 1] = ts[e] + ((__builtin_amdgcn_readfirstlane(cnt[e]) + 255) >> 8);
        const int tend = t_hi < ts[8] ? t_hi : ts[8]; const int nt = tend - t_lo; if (nt <= 0) return false;
        const long L = (long)i * G + c; if (L >= (long)nt * nN) return false;
        const int per = 8 * nN; const int grp = (int)(L / per), r = (int)(L % per);
        const int gt0 = grp * 8; const int gsz = (nt - gt0) < 8 ? (nt - gt0) : 8;
        const int tile = t_lo + gt0 + (r % gsz), pn = r / gsz;
        int e = 0;
#pragma unroll
        for (int j = 1; j < 8; ++j) e += (tile >= ts[j]) ? 1 : 0;
        u.pm = __builtin_amdgcn_readfirstlane(tile - pm_base); u.pn = __builtin_amdgcn_readfirstlane(e * nN + pn); return true;
    }
    __device__ __forceinline__ void a_ready(const pg8::Unit&) const {}
    __device__ __forceinline__ void done(const pg8::Unit&) const {}
};

struct WC { const float* W; int ldw; int K; int ncols; int npad; bf16_t* WT; int rbase; int rs4; int ldt; int koff; int nkt_out; const float* kscale; int qkvmap; };
__device__ __forceinline__ int wc_nblk(const WC& w) { const int nkt = w.ldt ? w.nkt_out : w.K / 64, nnt = (w.npad + 63) / 64; return (nkt >> 1) * (nnt >> 2); }
__device__ __forceinline__ void ph_wconv(const WC w, float* lds, int vb = -1, int vg = 0, int rot = 0) {
    const int TIDX = otid();
    const int lane = TIDX & 63, wave = TIDX >> 6;
    unsigned char* scr = (unsigned char*)lds + wave * 9216;
    const int nwg = vb >= 0 ? vg : (int)gridDim.x; int wgid = (vb >= 0 ? vb : (int)blockIdx.x) - rot; if (wgid < 0) wgid += nwg;
    const int nkt = w.ldt ? w.nkt_out : w.K / 64, nnt = (w.npad + 63) / 64; const int ldt = w.ldt ? w.ldt : w.K;
    const int bk = nkt >> 1, bn = nnt >> 2;
    const int g = lane >> 4, l15 = lane & 15;
    float4 va[8], vb4[8];
#define WCONV_LOAD(bt) do { const int kt_ = 2 * ((bt) % bk) + (wave & 1), nt_ = 4 * ((bt) / bk) + (wave >> 1); const int k0_ = kt_ * 64, ncol_ = nt_ * 64 + 4 * l15; const bool cv_ = ncol_ < w.ncols; \
        const float* wp_ = w.W + (size_t)(k0_ + 2 * g) * w.ldw + ncol_; \
        _Pragma("unroll") for (int j = 0; j < 8; ++j) { va[j] = make_float4(0.f, 0.f, 0.f, 0.f); vb4[j] = va[j]; \
            if (cv_ && k0_ + 8 * j + 2 * g < w.K) va[j] = *(const float4*)(wp_ + (size_t)(8 * j) * w.ldw); \
            if (cv_ && k0_ + 8 * j + 2 * g + 1 < w.K) vb4[j] = *(const float4*)(wp_ + (size_t)(8 * j + 1) * w.ldw); } } while (0)
    int bt = wgid;
    if (bt < bk * bn) WCONV_LOAD(bt);
#pragma unroll 1
    for (; bt < bk * bn; bt += nwg) {
        const int kt = 2 * (bt % bk) + (wave & 1), nt = 4 * (bt / bk) + (wave >> 1); const int k0 = kt * 64, n0 = nt * 64;
#pragma unroll
        for (int j = 0; j < 8; ++j) {
            float4 a = va[j], b = vb4[j];
            if (w.kscale) { const float sa = w.kscale[k0 + 8 * j + 2 * g], sb = w.kscale[k0 + 8 * j + 2 * g + 1]; a.x *= sa; a.y *= sa; a.z *= sa; a.w *= sa; b.x *= sb; b.y *= sb; b.z *= sb; b.w *= sb; }
            const int kb = (8 * j + 2 * g) * 2;
            *(unsigned*)(scr + (4 * l15 + 0) * 144 + kb) = pk2(a.x, b.x);
            *(unsigned*)(scr + (4 * l15 + 1) * 144 + kb) = pk2(a.y, b.y);
            *(unsigned*)(scr + (4 * l15 + 2) * 144 + kb) = pk2(a.z, b.z);
            *(unsigned*)(scr + (4 * l15 + 3) * 144 + kb) = pk2(a.w, b.w);
        }
        if (bt + nwg < bk * bn) WCONV_LOAD(bt + nwg);
        asm volatile("s_waitcnt lgkmcnt(0)" ::: "memory");
#pragma unroll
        for (int i = 0; i < 8; ++i) {
            const int nl = 8 * i + (lane >> 3), ch = lane & 7; const int n = n0 + nl;
            const uint4 v = *(const uint4*)(scr + nl * 144 + ch * 16);
            if (n < w.npad) { int drow = w.rbase + (n >> 2) * w.rs4 + (n & 3); if (w.qkvmap) { const int G_ = n >> 6, d_ = n & 63; drow = 256 * (G_ >> 2) + 128 * (d_ >> 5) + 32 * (G_ & 3) + (d_ & 31); }
                int dk = w.koff + k0; if (dk >= ldt) dk -= ldt; *(uint4*)(w.WT + (size_t)drow * ldt + dk + 8 * ch) = v; }
        }
        asm volatile("s_waitcnt lgkmcnt(0)" ::: "memory");
    }
#undef WCONV_LOAD
}

__device__ __forceinline__ void ph_rmsnorm(const float* __restrict__ x, const float* __restrict__ gain, bf16_t* __restrict__ out, int rows) {
    const int TIDX = otid();
    const int lane = TIDX & 63, wave = TIDX >> 6;
    const int gw = blockIdx.x * 8 + wave, NGW = gridDim.x * 8;
#pragma unroll 2
    for (int r = gw; r < rows; r += NGW) {
        const float4* xr = (const float4*)(x + (size_t)r * D) + lane;
        float4 v[4]; float s = 0.f;
#pragma unroll
        for (int j = 0; j < 4; ++j) { v[j] = xr[64 * j]; s += v[j].x * v[j].x + v[j].y * v[j].y + v[j].z * v[j].z + v[j].w * v[j].w; }
        s = wave_sum(s);
        const float rs = 1.0f / sqrtf(s * (1.0f / D) + NORM_EPS);
        uint2* o = (uint2*)(out + (size_t)r * D) + lane;
#pragma unroll
        for (int j = 0; j < 4; ++j) { const float4 g = ((const float4*)gain)[lane + 64 * j]; uint2 w; w.x = pk2(v[j].x * rs * g.x, v[j].y * rs * g.y); w.y = pk2(v[j].z * rs * g.z, v[j].w * rs * g.w); o[64 * j] = w; }
    }
}

struct GD { const float* A; int lda; const int* arow; const int* mcnt; int M; const float* B; const float* B2; int ldb; int K; int N;
            float* C; int ldc; int mode; const float* R; const float* gw; const int* crow; };
struct RwkvP { const float *mu, *w0, *w_up, *a0, *a_up, *g_up, *k_k, *k_a, *r_k, *ln_w, *ln_b; };
struct S5P { const float *lre, *lim, *ldt, *bre, *bim, *cre, *cim, *dsk; };
struct DAP { const float *lq1, *lk1, *lq2, *lk2, *subg; };
typedef short bf16x8_t __attribute__((ext_vector_type(8)));
typedef short s16x4_t __attribute__((ext_vector_type(4)));
typedef float f32x16_t __attribute__((ext_vector_type(16)));
#define MFMA32(a, b, c) __builtin_amdgcn_mfma_f32_32x32x16_bf16((a), (b), (c), 0, 0, 0)
__device__ __forceinline__ bf16x8_t pack8(float a0, float a1, float a2, float a3, float a4, float a5, float a6, float a7) {
    pg8::u32x4 p; p.x = pg8::cvt_pk_bf16(a0, a1); p.y = pg8::cvt_pk_bf16(a2, a3); p.z = pg8::cvt_pk_bf16(a4, a5); p.w = pg8::cvt_pk_bf16(a6, a7);
    return __builtin_bit_cast(bf16x8_t, p);
}
constexpr int DA_KROW = 144, DA_VROW = 288, DA_KT = 64 * DA_KROW, DA_VT = 64 * DA_VROW, DA_BUF = 2 * DA_KT + DA_VT;
__device__ __forceinline__ void ph_diff_attn_mfma(const bf16_t* __restrict__ QKVb, const DAP p, bf16_t* __restrict__ AO, float* ldsf, unsigned* qctr, const float* __restrict__ qgain, const float* __restrict__ kgain) {
    const int TIDX = otid();
    const int tid = TIDX, lane = tid & 63, wave = __builtin_amdgcn_readfirstlane(tid >> 6);
    const int sub = wave & 3, map = wave >> 2;
    const int r = lane & 31, hh = lane >> 5, blk = (lane >> 4) & 1, i16 = lane & 15, tq = i16 >> 2, tp = i16 & 3;
    unsigned char* lds = (unsigned char*)ldsf;
    float d1 = 0.f, d2 = 0.f;
    for (int i = 0; i < 64; ++i) { d1 += p.lq1[i] * p.lk1[i]; d2 += p.lq2[i] * p.lk2[i]; }
    const float lam = expf(d1) - expf(d2) + LAMBDA_INIT;
    float gqm = 0.f, gkm = 0.f;
    for (int i = 0; i < 64; ++i) { gqm = fmaxf(gqm, fabsf(qgain[i])); gkm = fmaxf(gkm, fabsf(kgain[i])); }
    const float wnum = 2.0f * (8.0f * gqm * gkm * 1.02f) + 8.3178f + 18.0219f;
    const int kr = tid >> 3, c8 = tid & 7;
    volatile int* unit_word = (volatile int*)(lds + 2 * DA_BUF);
#pragma unroll 1
    for (;;) {
        __syncthreads();
        if (tid == 0) *unit_word = (int)atomicAdd(qctr, 1u);
        __syncthreads();
        const int rank = *unit_word;
        if (rank >= NB * 8 * 32) break;
        {
            const int qb = 31 - (rank >> 5); const int bh = rank & 31; const int b = bh >> 3, h = 7 - (bh & 7);
            const float slope = fexp2(-(float)(h + 1));
            const float slope2 = slope * 1.4426950408889634f;
            const float wf = ceilf(wnum / (64.0f * slope)); const int Wh = wf > 64.f ? 64 : (int)wf;
            const int row0 = qb * 128 + sub * 32; const int cq = qb * 2 + (sub >> 1); const int nt = qb * 2 + 2;
            const int t_first = (qb * 2 - Wh) > 0 ? (qb * 2 - Wh) : 0;
            const size_t tokb = (size_t)b * T;
            bf16x8_t qf[4];
            { const bf16_t* qp = QKVb + (tokb + row0 + r) * 3072 + h * 128 + map * 64 + 8 * hh;
#pragma unroll
              for (int s = 0; s < 4; ++s) qf[s] = *(const bf16x8_t*)(qp + 16 * s); }
            const float qpos = (float)(row0 + r);
            f32x16_t O[4];
#pragma unroll
            for (int dt = 0; dt < 4; ++dt)
#pragma unroll
                for (int i = 0; i < 16; ++i) O[dt][i] = 0.f;
            float m = -1e30f, l = 0.f;
            typedef unsigned u32x4b __attribute__((ext_vector_type(4)));
            const __amdgpu_buffer_rsrc_t rsrc = __builtin_amdgcn_make_buffer_rsrc((void*)QKVb, 0, (int)((size_t)M * 3072 * 2), 0x00020000);
            const int voK = (kr * 3072 + h * 128 + c8 * 8 + 1024) * 2, voV0 = ((tid >> 4) * 3072 + 2048 + h * 128 + (tid & 15) * 8) * 2, voV1 = voV0 + 32 * 3072 * 2;
            u32x4b g0, g1, g2, g3;
            { const int so = (int)((tokb + (size_t)t_first * 64) * 3072 * 2);
              g0 = __builtin_amdgcn_raw_buffer_load_b128(rsrc, voK, so, 0); g1 = __builtin_amdgcn_raw_buffer_load_b128(rsrc, voK + 128, so, 0);
              g2 = __builtin_amdgcn_raw_buffer_load_b128(rsrc, voV0, so, 0); g3 = __builtin_amdgcn_raw_buffer_load_b128(rsrc, voV1, so, 0); }
            __syncthreads();
            { unsigned char* bufp = lds + (t_first & 1) * DA_BUF;
              *(u32x4b*)(bufp + kr * DA_KROW + c8 * 16) = g0; *(u32x4b*)(bufp + DA_KT + kr * DA_KROW + c8 * 16) = g1;
              *(u32x4b*)(bufp + 2 * DA_KT + (tid >> 4) * DA_VROW + (tid & 15) * 16) = g2; *(u32x4b*)(bufp + 2 * DA_KT + ((tid + 512) >> 4) * DA_VROW + (tid & 15) * 16) = g3; }
            __syncthreads();
#pragma unroll 1
            for (int t = t_first; t < nt; ++t) {
                const bool more = (t + 1 < nt);
                if (more) { const int so = (int)((tokb + (size_t)(t + 1) * 64) * 3072 * 2);
                    g0 = __builtin_amdgcn_raw_buffer_load_b128(rsrc, voK, so, 0); g1 = __builtin_amdgcn_raw_buffer_load_b128(rsrc, voK + 128, so, 0);
                    g2 = __builtin_amdgcn_raw_buffer_load_b128(rsrc, voV0, so, 0); g3 = __builtin_amdgcn_raw_buffer_load_b128(rsrc, voV1, so, 0); }
                if (t <= cq && t >= cq - Wh) {
                    const unsigned char* bufp = lds + (t & 1) * DA_BUF;
                    const unsigned char* kp = bufp + map * DA_KT + r * DA_KROW + 16 * hh;
                    f32x16_t x0, x1;
#pragma unroll
                    for (int i = 0; i < 16; ++i) { x0[i] = 0.f; x1[i] = 0.f; }
#pragma unroll
                    for (int s = 0; s < 4; ++s) {
                        const bf16x8_t a0 = *(const bf16x8_t*)(kp + 32 * s), a1 = *(const bf16x8_t*)(kp + 32 * DA_KROW + 32 * s);
                        x0 = MFMA32(a0, qf[s], x0); x1 = MFMA32(a1, qf[s], x1);
                    }
                    const float kb0 = (float)(t * 64 + 4 * hh) - qpos;
                    float mx = -1e30f;
#pragma unroll
                    for (int i = 0; i < 16; ++i) {
                        const float dk = kb0 + (float)((i & 3) + 8 * (i >> 2));
                        x0[i] = __builtin_fmaf(-slope2, fabsf(dk), x0[i]);
                        x1[i] = __builtin_fmaf(-slope2, fabsf(dk + 32.f), x1[i]);
                        mx = fmaxf(mx, fmaxf(x0[i], x1[i]));
                    }
                    mx = fmaxf(mx, __shfl_xor(mx, 32));
                    const float mn = fmaxf(m, mx);
                    const float alpha = fexp2(m - mn);
                    m = mn;
                    float rsum = 0.f;
#pragma unroll
                    for (int i = 0; i < 16; ++i) { x0[i] = fexp2(x0[i] - mn); x1[i] = fexp2(x1[i] - mn); rsum += x0[i] + x1[i]; }
                    l = l * alpha + rsum;
                    if (__any(alpha != 1.0f)) {
#pragma unroll
                        for (int dt = 0; dt < 4; ++dt)
#pragma unroll
                            for (int i = 0; i < 16; ++i) O[dt][i] *= alpha;
                    }
                    const bf16x8_t p00 = pack8(x0[0], x0[1], x0[2], x0[3], x0[4], x0[5], x0[6], x0[7]);
                    const bf16x8_t p01 = pack8(x0[8], x0[9], x0[10], x0[11], x0[12], x0[13], x0[14], x0[15]);
                    const bf16x8_t p10 = pack8(x1[0], x1[1], x1[2], x1[3], x1[4], x1[5], x1[6], x1[7]);
                    const bf16x8_t p11 = pack8(x1[8], x1[9], x1[10], x1[11], x1[12], x1[13], x1[14], x1[15]);
                    const unsigned vbase = (unsigned)(size_t)(bufp + 2 * DA_KT) + (unsigned)((4 * hh + tq) * DA_VROW + 32 * blk + 8 * tp);
#define DA_VREAD(va_, A0, A1, A2, A3, A4, A5, A6, A7) asm volatile("ds_read_b64_tr_b16 %0, %8\n\tds_read_b64_tr_b16 %1, %8 offset:%9\n\tds_read_b64_tr_b16 %2, %8 offset:%10\n\tds_read_b64_tr_b16 %3, %8 offset:%11\n\t" \
                                     "ds_read_b64_tr_b16 %4, %8 offset:%12\n\tds_read_b64_tr_b16 %5, %8 offset:%13\n\tds_read_b64_tr_b16 %6, %8 offset:%14\n\tds_read_b64_tr_b16 %7, %8 offset:%15" \
                                     : "=&v"(A0), "=&v"(A1), "=&v"(A2), "=&v"(A3), "=&v"(A4), "=&v"(A5), "=&v"(A6), "=&v"(A7) \
                                     : "v"(va_), "n"(8 * DA_VROW), "n"(16 * DA_VROW), "n"(24 * DA_VROW), "n"(32 * DA_VROW), "n"(40 * DA_VROW), "n"(48 * DA_VROW), "n"(56 * DA_VROW) : "memory")
#define DA_VWAIT(N, A0, A1, A2, A3, A4, A5, A6, A7) asm volatile("s_waitcnt lgkmcnt(" #N ")" : "+v"(A0), "+v"(A1), "+v"(A2), "+v"(A3), "+v"(A4), "+v"(A5), "+v"(A6), "+v"(A7) :: "memory")
#define DA_PV(dt_, A0, A1, A2, A3, A4, A5, A6, A7) do { \
                        const bf16x8_t a00 = __builtin_shufflevector(A0, A1, 0, 1, 2, 3, 4, 5, 6, 7), a01 = __builtin_shufflevector(A2, A3, 0, 1, 2, 3, 4, 5, 6, 7); \
                        const bf16x8_t a10 = __builtin_shufflevector(A4, A5, 0, 1, 2, 3, 4, 5, 6, 7), a11 = __builtin_shufflevector(A6, A7, 0, 1, 2, 3, 4, 5, 6, 7); \
                        O[dt_] = MFMA32(a00, p00, O[dt_]); O[dt_] = MFMA32(a01, p01, O[dt_]); O[dt_] = MFMA32(a10, p10, O[dt_]); O[dt_] = MFMA32(a11, p11, O[dt_]); } while (0)
                    {
                        s16x4_t e0, e1, e2, e3, e4, e5, e6, e7, f0, f1, f2, f3, f4, f5, f6, f7;
                        DA_VREAD(vbase, e0, e1, e2, e3, e4, e5, e6, e7);
                        DA_VREAD(vbase + 64, f0, f1, f2, f3, f4, f5, f6, f7);
                        DA_VWAIT(8, e0, e1, e2, e3, e4, e5, e6, e7);
                        DA_PV(0, e0, e1, e2, e3, e4, e5, e6, e7);
                        DA_VREAD(vbase + 128, e0, e1, e2, e3, e4, e5, e6, e7);
                        DA_VWAIT(8, f0, f1, f2, f3, f4, f5, f6, f7);
                        DA_PV(1, f0, f1, f2, f3, f4, f5, f6, f7);
                        DA_VREAD(vbase + 192, f0, f1, f2, f3, f4, f5, f6, f7);
                        DA_VWAIT(8, e0, e1, e2, e3, e4, e5, e6, e7);
                        DA_PV(2, e0, e1, e2, e3, e4, e5, e6, e7);
                        DA_VWAIT(0, f0, f1, f2, f3, f4, f5, f6, f7);
                        DA_PV(3, f0, f1, f2, f3, f4, f5, f6, f7);
                    }
                }
                if (more) { unsigned char* bufp = lds + ((t + 1) & 1) * DA_BUF;
                    *(u32x4b*)(bufp + kr * DA_KROW + c8 * 16) = g0; *(u32x4b*)(bufp + DA_KT + kr * DA_KROW + c8 * 16) = g1;
                    *(u32x4b*)(bufp + 2 * DA_KT + (tid >> 4) * DA_VROW + (tid & 15) * 16) = g2; *(u32x4b*)(bufp + 2 * DA_KT + ((tid + 512) >> 4) * DA_VROW + (tid & 15) * 16) = g3; }
                __syncthreads();
            }
            const float lt = l + __shfl_xor(l, 32); const float inv = 1.0f / lt;
            float* xch = ldsf + (size_t)sub * 4096;
            if (map == 1) {
#pragma unroll
                for (int dt = 0; dt < 4; ++dt)
#pragma unroll
                    for (int i = 0; i < 16; ++i) xch[(dt * 16 + i) * 64 + lane] = O[dt][i] * inv;
            }
            __syncthreads();
            if (map == 0) {
                float ss = 0.f;
#pragma unroll
                for (int dt = 0; dt < 4; ++dt)
#pragma unroll
                    for (int i = 0; i < 16; ++i) { const float o = O[dt][i] * inv - lam * xch[(dt * 16 + i) * 64 + lane]; O[dt][i] = o; ss += o * o; }
                ss += __shfl_xor(ss, 32);
                const float rs = (1.0f / sqrtf(ss * (1.0f / 128.0f) + NORM_EPS)) * (1.0f - LAMBDA_INIT);
                bf16_t* op = AO + (tokb + row0 + r) * 1024 + h * 128;
#pragma unroll
                for (int dt = 0; dt < 4; ++dt)
#pragma unroll
                    for (int gq = 0; gq < 4; ++gq) { const int dim = dt * 32 + 8 * gq + 4 * hh; const float4 sg = *(const float4*)(p.subg + dim);
                        uint2 w; w.x = pk2(O[dt][4 * gq] * rs * sg.x, O[dt][4 * gq + 1] * rs * sg.y); w.y = pk2(O[dt][4 * gq + 2] * rs * sg.z, O[dt][4 * gq + 3] * rs * sg.w);
                        *(uint2*)(op + dim) = w; }
            }
        }
    }
    __syncthreads();
}


struct RwkvChunkBufs { bf16_t* AR; bf16_t* BKh; bf16_t* VT; bf16_t* MK; bf16_t* MB; bf16_t* IT; float* bL; };
struct RwkvOps { bf16x8_t ar0, ar1, ar2, ar3, mk, it, mb, bb0, bk0, bb1, bk1, vt; };
__device__ __forceinline__ void ph_knorm_bf16(bf16_t* __restrict__ KVb, const float* __restrict__ kg, const float* __restrict__ qg, int vb, int vg) {
    const int TIDX = otid();
    const int lane = TIDX & 63, wave = TIDX >> 6;
    if (vb < 0) return;
    const int gw = vb * 8 + wave, NGW = vg * 8;
    for (int row = gw; row < NB * MEML; row += NGW) {
        uint4* rowp = (uint4*)(KVb + (size_t)row * 2048);
#pragma unroll
        for (int j = 0; j < 2; ++j) {
            const int ch = lane + 64 * j;
            const uint4 v = rowp[ch];
            const unsigned w[4] = {v.x, v.y, v.z, v.w}; float f[8]; float ss = 0.f;
#pragma unroll
            for (int q = 0; q < 4; ++q) { f[2 * q] = bf2f((unsigned short)(w[q] & 0xffff)); f[2 * q + 1] = bf2f((unsigned short)(w[q] >> 16)); ss += f[2 * q] * f[2 * q] + f[2 * q + 1] * f[2 * q + 1]; }
            ss += __shfl_xor(ss, 1); ss += __shfl_xor(ss, 2); ss += __shfl_xor(ss, 4); ss += __shfl_xor(ss, 8); ss += __shfl_xor(ss, 16);
            const float rs = 1.0f / sqrtf(ss * (1.0f / 256.0f) + NORM_EPS);
            const int d0 = (ch & 31) * 8;
            const float4 k0 = *(const float4*)(kg + d0), k1 = *(const float4*)(kg + d0 + 4), q0 = *(const float4*)(qg + d0), q1 = *(const float4*)(qg + d0 + 4);
            uint4 o; o.x = pk2(f[0] * rs * k0.x * q0.x, f[1] * rs * k0.y * q0.y); o.y = pk2(f[2] * rs * k0.z * q0.z, f[3] * rs * k0.w * q0.w);
            o.z = pk2(f[4] * rs * k1.x * q1.x, f[5] * rs * k1.y * q1.y); o.w = pk2(f[6] * rs * k1.z * q1.z, f[7] * rs * k1.w * q1.w);
            rowp[ch] = o;
        }
    }
}
constexpr int MA_KROW = 528, MA_VROW = 544, MA_KT = 64 * MA_KROW, MA_VT = 64 * MA_VROW;
__device__ __forceinline__ void ph_mem_attn_mfma(const bf16_t* __restrict__ Qb, const bf16_t* __restrict__ KVb, bf16_t* __restrict__ AO, float* ldsf, int u0) {
    const int TIDX = otid();
    const int tid = TIDX, lane = tid & 63, wave = __builtin_amdgcn_readfirstlane(tid >> 6);
    const int sub = wave & 3, dh = wave >> 2;
    const int r = lane & 31, hh = lane >> 5, blk = (lane >> 4) & 1, i16 = lane & 15, tq = i16 >> 2, tp = i16 & 3;
    unsigned char* lds = (unsigned char*)ldsf;
    typedef unsigned u32x4b __attribute__((ext_vector_type(4)));
    const __amdgpu_buffer_rsrc_t rsrc = __builtin_amdgcn_make_buffer_rsrc((void*)KVb, 0, NB * MEML * 2048 * 2, 0x00020000);
#pragma unroll 1
    for (int unit = u0; unit < u0 + 2; ++unit) {
        const int b = unit >> 7, head = (unit >> 5) & 3, qb = unit & 31;
        const int row0 = qb * 128 + sub * 32; const size_t tok = (size_t)b * T + row0 + r;
        bf16x8_t qf[16]; float ss = 0.f;
        { const bf16_t* qp = Qb + tok * 1024 + head * 256 + 8 * hh;
#pragma unroll
          for (int s = 0; s < 16; ++s) { qf[s] = *(const bf16x8_t*)(qp + 16 * s);
#pragma unroll
              for (int j = 0; j < 8; ++j) { const float f = bf2f((unsigned short)qf[s][j]); ss += f * f; } } }
        ss += __shfl_xor(ss, 32);
        const float rq = (1.0f / sqrtf(ss * (1.0f / 256.0f) + NORM_EPS)) * 0.0625f * 1.4426950408889634f;
        f32x16_t O[4];
#pragma unroll
        for (int dt = 0; dt < 4; ++dt)
#pragma unroll
            for (int i = 0; i < 16; ++i) O[dt][i] = 0.f;
        float m = -1e30f, l = 0.f;
        u32x4b g[8];
        const int vo = ((tid >> 5) * 2048 + head * 256 + (tid & 31) * 8) * 2;
#pragma unroll 1
        for (int kt = 0; kt < 4; ++kt) {
            { const int so = (b * MEML + kt * 64) * 2048 * 2;
#pragma unroll
              for (int j = 0; j < 4; ++j) { g[j] = __builtin_amdgcn_raw_buffer_load_b128(rsrc, vo + j * 16 * 4096, so, 0); g[4 + j] = __builtin_amdgcn_raw_buffer_load_b128(rsrc, vo + j * 16 * 4096 + 2048, so, 0); } }
            __syncthreads();
#pragma unroll
            for (int j = 0; j < 4; ++j) { *(u32x4b*)(lds + ((tid >> 5) + 16 * j) * MA_KROW + (tid & 31) * 16) = g[j]; *(u32x4b*)(lds + MA_KT + ((tid >> 5) + 16 * j) * MA_VROW + (tid & 31) * 16) = g[4 + j]; }
            __syncthreads();
            const unsigned char* kp = lds + r * MA_KROW + 16 * hh;
            f32x16_t x0, x1;
#pragma unroll
            for (int i = 0; i < 16; ++i) { x0[i] = 0.f; x1[i] = 0.f; }
#pragma unroll
            for (int s = 0; s < 16; ++s) {
                const bf16x8_t a0 = *(const bf16x8_t*)(kp + 32 * s), a1 = *(const bf16x8_t*)(kp + 32 * MA_KROW + 32 * s);
                x0 = MFMA32(a0, qf[s], x0); x1 = MFMA32(a1, qf[s], x1);
            }
            float mx = -1e30f;
#pragma unroll
            for (int i = 0; i < 16; ++i) { x0[i] *= rq; x1[i] *= rq; mx = fmaxf(mx, fmaxf(x0[i], x1[i])); }
            mx = fmaxf(mx, __shfl_xor(mx, 32));
            const float mn = fmaxf(m, mx); const float alpha = fexp2(m - mn); m = mn;
            float rsum = 0.f;
#pragma unroll
            for (int i = 0; i < 16; ++i) { x0[i] = fexp2(x0[i] - mn); x1[i] = fexp2(x1[i] - mn); rsum += x0[i] + x1[i]; }
            l = l * alpha + rsum;
            if (__any(alpha != 1.0f)) {
#pragma unroll
                for (int dt = 0; dt < 4; ++dt)
#pragma unroll
                    for (int i = 0; i < 16; ++i) O[dt][i] *= alpha;
            }
            const bf16x8_t p00 = pack8(x0[0], x0[1], x0[2], x0[3], x0[4], x0[5], x0[6], x0[7]);
            const bf16x8_t p01 = pack8(x0[8], x0[9], x0[10], x0[11], x0[12], x0[13], x0[14], x0[15]);
            const bf16x8_t p10 = pack8(x1[0], x1[1], x1[2], x1[3], x1[4], x1[5], x1[6], x1[7]);
            const bf16x8_t p11 = pack8(x1[8], x1[9], x1[10], x1[11], x1[12], x1[13], x1[14], x1[15]);
            const unsigned vbase = (unsigned)(size_t)(lds + MA_KT) + (unsigned)((4 * hh + tq) * MA_VROW + dh * 256 + 32 * blk + 8 * tp);
#pragma unroll
            for (int dt = 0; dt < 4; ++dt) {
                s16x4_t v0, v1, v2, v3, v4, v5, v6, v7;
                const unsigned va = vbase + dt * 64;
                asm volatile("ds_read_b64_tr_b16 %0, %8\n\tds_read_b64_tr_b16 %1, %8 offset:%9\n\tds_read_b64_tr_b16 %2, %8 offset:%10\n\tds_read_b64_tr_b16 %3, %8 offset:%11\n\t"
                             "ds_read_b64_tr_b16 %4, %8 offset:%12\n\tds_read_b64_tr_b16 %5, %8 offset:%13\n\tds_read_b64_tr_b16 %6, %8 offset:%14\n\tds_read_b64_tr_b16 %7, %8 offset:%15\n\ts_waitcnt lgkmcnt(0)"
                             : "=&v"(v0), "=&v"(v1), "=&v"(v2), "=&v"(v3), "=&v"(v4), "=&v"(v5), "=&v"(v6), "=&v"(v7)
                             : "v"(va), "n"(8 * MA_VROW), "n"(16 * MA_VROW), "n"(24 * MA_VROW), "n"(32 * MA_VROW), "n"(40 * MA_VROW), "n"(48 * MA_VROW), "n"(56 * MA_VROW) : "memory");
                const bf16x8_t a00 = __builtin_shufflevector(v0, v1, 0, 1, 2, 3, 4, 5, 6, 7), a01 = __builtin_shufflevector(v2, v3, 0, 1, 2, 3, 4, 5, 6, 7);
                const bf16x8_t a10 = __builtin_shufflevector(v4, v5, 0, 1, 2, 3, 4, 5, 6, 7), a11 = __builtin_shufflevector(v6, v7, 0, 1, 2, 3, 4, 5, 6, 7);
                O[dt] = MFMA32(a00, p00, O[dt]); O[dt] = MFMA32(a01, p01, O[dt]); O[dt] = MFMA32(a10, p10, O[dt]); O[dt] = MFMA32(a11, p11, O[dt]);
            }
        }
        const float lt = l + __shfl_xor(l, 32); const float inv = 1.0f / lt;
        bf16_t* op = AO + tok * 1024 + head * 256 + dh * 128;
#pragma unroll
        for (int dt = 0; dt < 4; ++dt)
#pragma unroll
            for (int gq = 0; gq < 4; ++gq) { const int dim = dt * 32 + 8 * gq + 4 * hh;
                uint2 w; w.x = pk2(O[dt][4 * gq] * inv, O[dt][4 * gq + 1] * inv); w.y = pk2(O[dt][4 * gq + 2] * inv, O[dt][4 * gq + 3] * inv);
                *(uint2*)(op + dim) = w; }
    }
    __syncthreads();
}


__device__ __forceinline__ void ph_lora_in(const bf16_t* __restrict__ ZA, const float* __restrict__ mu, bf16_t* __restrict__ LA, int vb, int vg) {
    const int TIDX = otid();
    const size_t n = (size_t)M * 384;
    if (vb < 0) return;
    for (size_t i = (size_t)vb * NTHR + TIDX; i < n; i += (size_t)vg * NTHR) {
        const int tok = (int)(i / 384), c = (int)(i % 384);
        float val = 0.f;
        if (c < 288) {
            const float cur = bf2f(ZA[(size_t)tok * RCOLS + 1536 + c]); const float prev = (tok % T) ? bf2f(ZA[(size_t)(tok - 1) * RCOLS + 1536 + c]) : 0.f;
            const float m = cur + (prev - cur) * mu[1536 + c];
            val = c < 64 ? ftanh(m) : (c < 128 ? m : fsigmoid(m));
        }
        LA[i] = (bf16_t)f2bf(val);
    }
}
__device__ __forceinline__ void ph_rwkv_chunk_prep2(const bf16_t* __restrict__ ZA, const bf16_t* __restrict__ LORA, const RwkvP p, const RwkvChunkBufs cb, bf16_t* __restrict__ BON, float* ldsf) {
    const int TIDX = otid();
    const int lane = TIDX & 63, wave = __builtin_amdgcn_readfirstlane(TIDX >> 6);
    const int r = lane & 31, hh = lane >> 5;
    unsigned char* scr = (unsigned char*)ldsf + wave * 10240;
    unsigned char* ARs = scr; unsigned char* BKs = scr + 4608; float* Mf = (float*)(scr + 9216);
    const int gw = blockIdx.x * 8 + wave, NGW = gridDim.x * 8;
    const int pos = (lane & ~15) + 8 * ((lane >> 2) & 1) + (lane & 3) + 4 * ((lane >> 3) & 1);
    unsigned short zr[17], zk[17], zv[17], lw[16], la[16];
#define R1_LOAD(chx) do { const int bh_ = (chx) >> 8, c_ = (chx) & 255; const int col_ = (bh_ & 7) * 64 + lane; const size_t tok0_ = (size_t)(bh_ >> 3) * T + c_ * 16; \
        zr[0] = 0; zk[0] = 0; zv[0] = 0; \
        if (c_ > 0) { const bf16_t* zp_ = ZA + (tok0_ - 1) * RCOLS + col_; zr[0] = zp_[0]; zk[0] = zp_[512]; zv[0] = zp_[1024]; } \
        _Pragma("unroll") for (int t = 0; t < 16; ++t) { const bf16_t* z_ = ZA + (tok0_ + t) * RCOLS + col_; const bf16_t* lo_ = LORA + (tok0_ + t) * 1536 + col_; \
            zr[t + 1] = z_[0]; zk[t + 1] = z_[512]; zv[t + 1] = z_[1024]; lw[t] = lo_[0]; la[t] = lo_[512]; } } while (0)
    if (gw < NB * 8 * 256) R1_LOAD(gw);
#pragma unroll 1
    for (int ch = gw; ch < NB * 8 * 256; ch += NGW) {
        const int bh = ch >> 8, c = ch & 255; const int b = bh >> 3, h = bh & 7; const int col = h * 64 + lane;
        const float mu_r = p.mu[col], mu_k = p.mu[512 + col], mu_v = p.mu[1024 + col], w0 = p.w0[col], a0 = p.a0[col], k_k = p.k_k[col], k_a = p.k_a[col], r_k = p.r_k[col];
        const size_t tok0 = (size_t)b * T + c * 16;
        float at[16], rt[16], bt[16], kt[16], vv[16]; float bcum = 1.0f;
        float pr = bf2f(zr[0]), pk = bf2f(zk[0]), pv = bf2f(zv[0]);
        float rr[16], kk2[16], vraw[16], wp[16], ap[16];
#pragma unroll
        for (int t = 0; t < 16; ++t) { const float cr = bf2f(zr[t + 1]), ck = bf2f(zk[t + 1]), cv = bf2f(zv[t + 1]);
            rr[t] = cr + (pr - cr) * mu_r; kk2[t] = ck + (pk - ck) * mu_k; vraw[t] = cv + (pv - cv) * mu_v; pr = cr; pk = ck; pv = cv; wp[t] = w0 + bf2f(lw[t]); ap[t] = a0 + bf2f(la[t]); }
        if (ch + NGW < NB * 8 * 256) R1_LOAD(ch + NGW);
#pragma unroll
        for (int t = 0; t < 16; ++t) {
            const float r_ = rr[t], k_ = kk2[t], v_ = vraw[t];
            const float wpre = wp[t], apre = ap[t];
            const float kkr = k_ * k_k; const float ss = wave_sum_dpp(kkr * kkr);
            const float kkv = kkr * frsq(fmaxf(ss, 1e-24f));
            const float a = fsigmoid(apre); const float kmod = k_ * (1.0f + (a - 1.0f) * k_a);
            const float w = fexp(-fexp(-fsoftplus(-wpre) - 0.5f));
            const float bon = wave_sum_dpp(r_ * kmod * r_k) * v_;
            BON[(tok0 + t) * 512 + col] = (bf16_t)f2bf(bon);
            const float ka = kkv * a;
            vv[t] = v_; at[t] = -bcum * kkv; bcum *= w; rt[t] = bcum * r_; const float ib = frcp(bcum); bt[t] = ka * ib; kt[t] = kmod * ib;
        }
        const float bL = bcum;
#pragma unroll
        for (int t = 0; t < 16; ++t) {
            *(bf16_t*)(ARs + t * 144 + pos * 2) = (bf16_t)f2bf(at[t]); *(bf16_t*)(ARs + (16 + t) * 144 + pos * 2) = (bf16_t)f2bf(rt[t]);
            *(bf16_t*)(BKs + t * 144 + pos * 2) = (bf16_t)f2bf(bt[t]); *(bf16_t*)(BKs + (16 + t) * 144 + pos * 2) = (bf16_t)f2bf(kt[t]);
        }
        asm volatile("s_waitcnt lgkmcnt(0)" ::: "memory");
        f32x16_t x;
#pragma unroll
        for (int i = 0; i < 16; ++i) x[i] = 0.f;
#pragma unroll
        for (int ks = 0; ks < 4; ++ks) {
            const bf16x8_t a = *(const bf16x8_t*)(BKs + r * 144 + ks * 32 + hh * 16), bq = *(const bf16x8_t*)(ARs + r * 144 + ks * 32 + hh * 16);
            x = MFMA32(a, bq, x);
        }
#pragma unroll
        for (int j = 0; j < 8; ++j) { const int sidx = (j & 3) + 8 * (j >> 2) + 4 * hh; const bool keep = (r < 16) ? (sidx < r) : (sidx <= r - 16);
            x[j] = keep ? x[j] : 0.f; x[8 + j] = keep ? x[8 + j] : 0.f; }
        *(bf16x8_t*)(cb.MK + (size_t)ch * 512 + r * 16 + hh * 8) = pack8(x[8], x[9], x[10], x[11], x[12], x[13], x[14], x[15]);
        if (r >= 16) *(bf16x8_t*)(cb.MB + (size_t)ch * 256 + (r - 16) * 16 + hh * 8) = pack8(x[0], x[1], x[2], x[3], x[4], x[5], x[6], x[7]);
        else {
#pragma unroll
            for (int j = 0; j < 8; ++j) Mf[((j & 3) + 8 * (j >> 2) + 4 * hh) * 16 + r] = x[j];
        }
#pragma unroll
        for (int i = 0; i < 4; ++i) { const int q = lane + 64 * i; *(uint4*)((unsigned char*)cb.AR + (size_t)ch * 4096 + q * 16) = *(const uint4*)(ARs + (q >> 3) * 144 + (q & 7) * 16); }
        { bf16_t* bk = cb.BKh + (size_t)ch * 2048 + lane * 32;
#pragma unroll
          for (int hp = 0; hp < 2; ++hp) {
              *(bf16x8_t*)(bk + hp * 8) = pack8(bL * bt[4 * hp], bL * bt[4 * hp + 1], bL * bt[4 * hp + 2], bL * bt[4 * hp + 3], bL * bt[8 + 4 * hp], bL * bt[9 + 4 * hp], bL * bt[10 + 4 * hp], bL * bt[11 + 4 * hp]);
              *(bf16x8_t*)(bk + 16 + hp * 8) = pack8(bL * kt[4 * hp], bL * kt[4 * hp + 1], bL * kt[4 * hp + 2], bL * kt[4 * hp + 3], bL * kt[8 + 4 * hp], bL * kt[9 + 4 * hp], bL * kt[10 + 4 * hp], bL * kt[11 + 4 * hp]);
              *(bf16x8_t*)(cb.VT + (size_t)ch * 1024 + lane * 16 + hp * 8) = pack8(vv[4 * hp], vv[4 * hp + 1], vv[4 * hp + 2], vv[4 * hp + 3], vv[8 + 4 * hp], vv[9 + 4 * hp], vv[10 + 4 * hp], vv[11 + 4 * hp]);
          } }
        cb.bL[(size_t)ch * 64 + lane] = bL;
        asm volatile("s_waitcnt lgkmcnt(0)" ::: "memory");
        if (lane < 16) {
            float inv[16];
#pragma unroll
            for (int q = 0; q < 16; ++q) inv[q] = (q == lane) ? 1.0f : 0.0f;
#pragma unroll
            for (int q = 14; q >= 0; --q) { float acc = 0.f;
#pragma unroll
                for (int j = q + 1; j < 16; ++j) acc += Mf[q * 16 + j] * inv[j];
                inv[q] += acc; }
            bf16_t* ip = cb.IT + (size_t)ch * 256 + lane * 16;
            *(bf16x8_t*)(ip) = pack8(inv[0], inv[1], inv[2], inv[3], inv[8], inv[9], inv[10], inv[11]);
            *(bf16x8_t*)(ip + 8) = pack8(inv[4], inv[5], inv[6], inv[7], inv[12], inv[13], inv[14], inv[15]);
        }
        asm volatile("s_waitcnt lgkmcnt(0)" ::: "memory");
    }
}
#undef R1_LOAD
__device__ __forceinline__ void ph_rwkv_fin2(const float* __restrict__ O, const bf16_t* __restrict__ LORA, const bf16_t* __restrict__ BON, const float* __restrict__ ln_w, const float* __restrict__ ln_b, bf16_t* __restrict__ YMIX) {
    const int TIDX = otid();
    const int c = TIDX;
#pragma unroll 4
    for (int tok = blockIdx.x; tok < M; tok += gridDim.x) {
        const size_t o = (size_t)tok * 512 + c;
        const float v = O[o];
        const float mean = wave_sum_dpp(v) * (1.0f / 64.0f);
        const float d = v - mean;
        const float var = wave_sum_dpp(d * d) * (1.0f / 64.0f);
        const float on = d * frsq(var + 64e-5f);
        YMIX[(size_t)tok * 1024 + c] = (bf16_t)f2bf((on * ln_w[c] + ln_b[c] + bf2f(BON[o])) * bf2f(LORA[(size_t)tok * 1536 + 1024 + c]));
    }
}
constexpr int S5L = 32, S5NC = M / S5L;
struct EpiZ {
    static constexpr bool PERM = false, AFTER_DRAIN = false;
    bf16_t* ZA; bf16_t* UGX;
    __device__ __forceinline__ void operator()(const pg8::f32x4 (&acc)[2][2][4][2], const pg8::Unit& u, int wr, int wc, int fr, int fq) const {
        const int row0 = u.pm * 256 + wr * 64 + fr, col0 = u.pn * 256 + wc * 32 + 4 * fq;
#pragma unroll
        for (int ai = 0; ai < 2; ++ai)
#pragma unroll
            for (int m = 0; m < 4; ++m) { const int row = row0 + ai * 128 + m * 16;
#pragma unroll
                for (int bj = 0; bj < 2; ++bj)
#pragma unroll
                    for (int n = 0; n < 2; ++n) { const int col = col0 + bj * 128 + n * 16; const pg8::f32x4 v = acc[ai][bj][m][n];
                        if (col < RCOLS) { uint2 w; w.x = pg8::cvt_pk_bf16(v[0], v[1]); w.y = pg8::cvt_pk_bf16(v[2], v[3]); *(uint2*)(ZA + (size_t)row * RCOLS + col) = w; }
                        else if (col < INCOLS) { const int cc = col - RCOLS; const int g = cc >> 4, i = cc & 15;
                            uint2 w; w.x = pg8::cvt_pk_bf16(v[0], v[1]); w.y = pg8::cvt_pk_bf16(v[2], v[3]);
                            *(uint2*)(UGX + ((size_t)(g * S5NC + (row >> 5)) * 640 + (row & 31) * 16 + i)) = w; } } }
    }
};
struct EpiS5Y {
    static constexpr bool PERM = false, AFTER_DRAIN = false;
    const bf16_t* UGX; const float* dsk; float* YS; bf16_t* YSb;
    __device__ __forceinline__ void operator()(const pg8::f32x4 (&acc)[2][2][4][2], const pg8::Unit& u, int wr, int wc, int fr, int fq) const {
        const int g = u.pn >> 1; const int row0 = u.pm * 256 + wr * 64 + fr, col0 = (u.pn & 1) * 256 + wc * 32 + 4 * fq;
#pragma unroll
        for (int ai = 0; ai < 2; ++ai)
#pragma unroll
            for (int m = 0; m < 4; ++m) { const int R = row0 + ai * 128 + m * 16; const int chunk = R & (S5NC - 1);
#pragma unroll
                for (int bj = 0; bj < 2; ++bj)
#pragma unroll
                    for (int n = 0; n < 2; ++n) { const int col = col0 + bj * 128 + n * 16; const int t = col >> 4, j = col & 15; const pg8::f32x4 v = acc[ai][bj][m][n];
                        const uint2 uw = *(const uint2*)(UGX + (size_t)R * 640 + col);
                        const pg8::f32x4 dv = *(const pg8::f32x4*)(dsk + g * 16 + j);
                        pg8::f32x4 y;
                        y[0] = gelu_tanh(v[0] + dv[0] * bf2f((unsigned short)(uw.x & 0xffff))); y[1] = gelu_tanh(v[1] + dv[1] * bf2f((unsigned short)(uw.x >> 16)));
                        y[2] = gelu_tanh(v[2] + dv[2] * bf2f((unsigned short)(uw.y & 0xffff))); y[3] = gelu_tanh(v[3] + dv[3] * bf2f((unsigned short)(uw.y >> 16)));
                        const size_t o = (size_t)(chunk * S5L + t) * 512 + g * 16 + j;
                        *(pg8::f32x4*)(YS + o) = y;
                        uint2 w; w.x = pg8::cvt_pk_bf16(y[0], y[1]); w.y = pg8::cvt_pk_bf16(y[2], y[3]); *(uint2*)(YSb + o) = w; } }
    }
};
struct GroupOrder {
    int nm, nn, ng, G, c;
    __device__ __forceinline__ bool next(int i, pg8::Unit& u) const {
        if (c < 0) return false;
        const long L = (long)i * G + c; if (L >= (long)ng * nm * nn) return false;
        const int per = nm * nn; const int g = (int)(L / per), rem = (int)(L % per);
        u.pm = g * nm + rem / nn; u.pn = g * nn + rem % nn; return true;
    }
    __device__ __forceinline__ void a_ready(const pg8::Unit&) const {}
    __device__ __forceinline__ void done(const pg8::Unit&) const {}
};
__device__ __forceinline__ void ph_s5_mats(const S5P p, bf16_t* __restrict__ TE, bf16_t* __restrict__ TF, float* ldsf) {
    const int TIDX = otid();
    const int tid = TIDX;
    float* pwr = ldsf;
    float* pwi = pwr + 33 * 64;
    float* bbr = pwi + 33 * 64;
    float* bbi = bbr + 1024;
    float* crs = bbi + 1024;
    float* cis = crs + 1024;
    float* kt = cis + 1024;
#pragma unroll 1
    for (int item = blockIdx.x; item < 256; item += gridDim.x) {
        const int g = item >> 3, part = item & 7;
        __syncthreads();
        const float dt = expf(p.ldt[g]);
        for (int idx = tid; idx < 33 * 64; idx += NTHR) { const int n = idx >> 6, pp = idx & 63;
            const float are = p.lre[g * 64 + pp], aim = p.lim[g * 64 + pp];
            const float mag = expf((float)n * are * dt); float sn, cs; sincosf((float)n * aim * dt, &sn, &cs);
            pwr[idx] = mag * cs; pwi[idx] = mag * sn; }
        for (int idx = tid; idx < 1024; idx += NTHR) { const int pp = idx >> 4, i = idx & 15;
            const float are = p.lre[g * 64 + pp], aim = p.lim[g * 64 + pp];
            const float mag = expf(are * dt); float sn, cs; sincosf(aim * dt, &sn, &cs);
            const float nr_ = mag * cs - 1.0f, ni_ = mag * sn; const float den = are * are + aim * aim;
            const float cr_ = (nr_ * are + ni_ * aim) / den, ci_ = (ni_ * are - nr_ * aim) / den;
            const float br = p.bre[(g * 64 + pp) * 16 + i], bi = p.bim[(g * 64 + pp) * 16 + i];
            bbr[idx] = cr_ * br - ci_ * bi; bbi[idx] = cr_ * bi + ci_ * br;
            crs[idx] = p.cre[(size_t)g * 1024 + idx]; cis[idx] = p.cim[(size_t)g * 1024 + idx]; }
        __syncthreads();
        for (int idx = tid; idx < 4 * 256; idx += NTHR) { const int tau = 4 * part + (idx >> 8), j = (idx >> 4) & 15, i = idx & 15; float acc = 0.f;
#pragma unroll 4
            for (int pp = 0; pp < 64; ++pp) { const float pr = pwr[tau * 64 + pp], pi = pwi[tau * 64 + pp], br = bbr[pp * 16 + i], bi = bbi[pp * 16 + i];
                const float gr = pr * br - pi * bi, gi = pr * bi + pi * br; acc += crs[j * 64 + pp] * gr - cis[j * 64 + pp] * gi; }
            kt[idx] = acc; }
        __syncthreads();
        for (int q = tid; q < 8 * 32 * 32; q += NTHR) { const int lg = q >> 10, t = (q >> 5) & 31, j = (q >> 1) & 15, hf = q & 1; int sidx; float v[8];
            if (lg < 4) { sidx = t - (4 * part + lg);
#pragma unroll
                for (int e = 0; e < 8; ++e) v[e] = kt[(lg * 16 + j) * 16 + hf * 8 + e]; }
            else { sidx = t + 4 * part + (lg - 4) + 1;
#pragma unroll
                for (int e = 0; e < 8; ++e) v[e] = 0.f; }
            if (sidx >= 0 && sidx < 32) { uint4 o; o.x = pk2(v[0], v[1]); o.y = pk2(v[2], v[3]); o.z = pk2(v[4], v[5]); o.w = pk2(v[6], v[7]);
                *(uint4*)(TF + ((size_t)g * 512 + t * 16 + j) * 640 + sidx * 16 + hf * 8) = o; } }
        for (int q = tid; q < 64 * 16; q += NTHR) { const int row = part * 64 + (q >> 4), c8 = 64 + (q & 15); const int t = row >> 4, j = row & 15; float v[8];
            { const int n0 = (c8 - 64) * 8;
#pragma unroll
                for (int e = 0; e < 8; ++e) { const int n = n0 + e; const int pp = n & 63; const float cr = crs[j * 64 + pp], ci = cis[j * 64 + pp], pr = pwr[(t + 1) * 64 + pp], pi = pwi[(t + 1) * 64 + pp];
                    v[e] = (n < 64) ? (cr * pr - ci * pi) : -(cr * pi + ci * pr); } }
            uint4 o; o.x = pk2(v[0], v[1]); o.y = pk2(v[2], v[3]); o.z = pk2(v[4], v[5]); o.w = pk2(v[6], v[7]);
            *(uint4*)(TF + ((size_t)g * 512 + row) * 640 + c8 * 8) = o; }
        for (int q = tid; q < 32 * 64; q += NTHR) { const int n = part * 32 + (q >> 6), c8 = q & 63; const int sidx = c8 >> 1, i0 = (c8 & 1) * 8; float v[8];
#pragma unroll
            for (int e = 0; e < 8; ++e) { float val = 0.f;
                if (n < 128) { const int pp = n & 63; const float pr = pwr[(S5L - 1 - sidx) * 64 + pp], pi = pwi[(S5L - 1 - sidx) * 64 + pp], br = bbr[pp * 16 + i0 + e], bi = bbi[pp * 16 + i0 + e];
                    val = (n < 64) ? (pr * br - pi * bi) : (pr * bi + pi * br); }
                v[e] = val; }
            uint4 o; o.x = pk2(v[0], v[1]); o.y = pk2(v[2], v[3]); o.z = pk2(v[4], v[5]); o.w = pk2(v[6], v[7]);
            *(uint4*)(TE + ((size_t)g * 256 + n) * 512 + c8 * 8) = o; }
    }
    __syncthreads();
}
__device__ __forceinline__ void ph_s5_state(const S5P p, const float* __restrict__ XLOC, bf16_t* __restrict__ UGX, int blk0) {
    const int TIDX = otid();
    const int lane = TIDX & 63, wave = TIDX >> 6;
    const int vb = ((int)blockIdx.x + (int)gridDim.x - (blk0 % (int)gridDim.x)) % (int)gridDim.x;
    const int gw = vb * 8 + wave, NGW = gridDim.x * 8;
    for (int it = gw; it < NB * 32; it += NGW) {
        const int b = it >> 5, g = it & 31;
        const float are = p.lre[g * 64 + lane], aim = p.lim[g * 64 + lane]; const float dt = expf(p.ldt[g]);
        const float mag = expf((float)S5L * are * dt); float sn, cs; sincosf((float)S5L * aim * dt, &sn, &cs);
        const float lr = mag * cs, li = mag * sn;
        float xr = 0.f, xi = 0.f;
        const size_t row0 = (size_t)g * S5NC + b * (T / S5L);
#pragma unroll 4
        for (int c = 0; c < T / S5L; ++c) {
            UGX[(row0 + c) * 640 + 512 + lane] = (bf16_t)f2bf(xr); UGX[(row0 + c) * 640 + 576 + lane] = (bf16_t)f2bf(xi);
            const float ar = XLOC[(row0 + c) * 128 + lane], ai = XLOC[(row0 + c) * 128 + 64 + lane];
            const float nxr = lr * xr - li * xi + ar, nxi = lr * xi + li * xr + ai; xr = nxr; xi = nxi;
        }
    }
}


constexpr int R2_SLOT = 11520, R2_WAVE = 4 * R2_SLOT;
constexpr int R2_HALF = 128, R2_WGS = 96;
__device__ __forceinline__ void ph_rwkv_chunk_scan3(const RwkvChunkBufs cb, float* __restrict__ O, bf16_t* __restrict__ CP, bf16_t* __restrict__ SSTt, unsigned* flags, unsigned* barw, float* ldsf,
                                                    const bf16_t* __restrict__ LORA, const bf16_t* __restrict__ BON, const float* __restrict__ ln_w, const float* __restrict__ ln_b, bf16_t* __restrict__ YMIX, unsigned* othersdone, unsigned nothers) {
    const int TIDX = otid();
    const int lane = TIDX & 63, wave = __builtin_amdgcn_readfirstlane(TIDX >> 6);
    if ((int)blockIdx.x >= R2_WGS) return;
    const int role = (int)blockIdx.x >> 5, bh = (int)blockIdx.x & 31;
    const int b = bh >> 3, h = bh & 7;
    const int r = lane & 31, hh = lane >> 5;
    if (wave < 2) {
        const int vt = wave;
        LAS unsigned char* ldsw = (LAS unsigned char*)((LAS unsigned char*)ldsf + wave * R2_WAVE);
        const unsigned char* ldsg = (const unsigned char*)ldsf + wave * R2_WAVE;
#define R2_DMA16(gp, off) __builtin_amdgcn_global_load_lds((const unsigned*)(gp), (LAS unsigned*)(ldsw + (off)), 16, 0, 0)
#define R2_ISSUE(chx, slot) do { const size_t ch_ = (size_t)(chx); const int sb_ = (slot) * R2_SLOT; \
        const unsigned char* ar_ = (const unsigned char*)cb.AR + ch_ * 4096 + r * 128 + hh * 16; \
        R2_DMA16(ar_, sb_); R2_DMA16(ar_ + 32, sb_ + 1024); R2_DMA16(ar_ + 64, sb_ + 2048); R2_DMA16(ar_ + 96, sb_ + 3072); \
        R2_DMA16((const unsigned char*)cb.MK + ch_ * 1024 + r * 32 + hh * 16, sb_ + 4096); \
        R2_DMA16((r < 16) ? ((const unsigned char*)cb.IT + ch_ * 512 + r * 32 + hh * 16) : ((const unsigned char*)cb.MB + ch_ * 512 + (r - 16) * 32 + hh * 16), sb_ + 5120); \
        const unsigned char* bk_ = (const unsigned char*)cb.BKh + ch_ * 4096 + r * 64 + hh * 16; \
        R2_DMA16(bk_, sb_ + 6144); R2_DMA16(bk_ + 32, sb_ + 7168); R2_DMA16(bk_ + 2048, sb_ + 8192); R2_DMA16(bk_ + 2048 + 32, sb_ + 9216); \
        R2_DMA16((const unsigned char*)cb.VT + ch_ * 2048 + (32 * vt + r) * 32 + hh * 16, sb_ + 10240); \
        __builtin_amdgcn_global_load_lds((const unsigned*)(cb.bL + ch_ * 64 + lane), (LAS unsigned*)(ldsw + sb_ + 11264), 4, 0, 0); } while (0)
        f32x16_t S0, S1;
#pragma unroll
        for (int i = 0; i < 16; ++i) { const bool dg = (role == 2) && (((i & 3) + 8 * (i >> 2) + 4 * hh) == r); S0[i] = (dg && vt == 0) ? 1.f : 0.f; S1[i] = (dg && vt == 1) ? 1.f : 0.f; }
        const int cbeg = role ? R2_HALF : 0;
        const int ch0 = bh * 256 + cbeg;
        R2_ISSUE(ch0, 0); R2_ISSUE(ch0 + 1, 1); R2_ISSUE(ch0 + 2, 2);
#pragma unroll 1
        for (int c = 0; c < R2_HALF; ++c) {
            asm volatile("s_waitcnt vmcnt(24)" ::: "memory");
            const unsigned char* sp = ldsg + (c & 3) * R2_SLOT + lane * 16;
            RwkvOps cur;
            cur.ar0 = *(const bf16x8_t*)(sp); cur.ar1 = *(const bf16x8_t*)(sp + 1024); cur.ar2 = *(const bf16x8_t*)(sp + 2048); cur.ar3 = *(const bf16x8_t*)(sp + 3072);
            cur.mk = *(const bf16x8_t*)(sp + 4096);
            { const bf16x8_t v = *(const bf16x8_t*)(sp + 5120); const bf16x8_t z = {0, 0, 0, 0, 0, 0, 0, 0}; cur.it = (r < 16) ? v : z; cur.mb = (r < 16) ? z : v; }
            cur.bb0 = *(const bf16x8_t*)(sp + 6144); cur.bk0 = *(const bf16x8_t*)(sp + 7168); cur.bb1 = *(const bf16x8_t*)(sp + 8192); cur.bk1 = *(const bf16x8_t*)(sp + 9216);
            { const bf16x8_t v = *(const bf16x8_t*)(sp + 10240); const bf16x8_t z = {0, 0, 0, 0, 0, 0, 0, 0}; cur.vt = (role == 2) ? z : v; }
            float4 bl[8];
            { const unsigned char* bp = ldsg + (c & 3) * R2_SLOT + 11264 + 16 * hh;
#pragma unroll
              for (int g = 0; g < 8; ++g) bl[g] = *(const float4*)(bp + 32 * g); }
            asm volatile("s_waitcnt lgkmcnt(0)" ::: "memory");
            if (c + 3 < R2_HALF) R2_ISSUE(ch0 + c + 3, (c + 3) & 3);
            else { R2_ISSUE(ch0 + c, (c + 3) & 3); }
            const bf16x8_t s00 = pack8(S0[0], S0[1], S0[2], S0[3], S0[4], S0[5], S0[6], S0[7]), s01 = pack8(S0[8], S0[9], S0[10], S0[11], S0[12], S0[13], S0[14], S0[15]);
            const bf16x8_t s10 = pack8(S1[0], S1[1], S1[2], S1[3], S1[4], S1[5], S1[6], S1[7]), s11 = pack8(S1[8], S1[9], S1[10], S1[11], S1[12], S1[13], S1[14], S1[15]);
            f32x16_t Ya, Yb;
#pragma unroll
            for (int i = 0; i < 16; ++i) { Ya[i] = 0.f; Yb[i] = 0.f; }
            Ya = MFMA32(cur.ar0, s00, Ya); Yb = MFMA32(cur.ar2, s10, Yb);
            Ya = MFMA32(cur.ar1, s01, Ya); Yb = MFMA32(cur.ar3, s11, Yb);
            Ya = MFMA32(cur.mk, cur.vt, Ya);
#pragma unroll
            for (int i = 0; i < 16; ++i) Ya[i] += Yb[i];
            const bf16x8_t rhs = pack8(Ya[0], Ya[1], Ya[2], Ya[3], Ya[4], Ya[5], Ya[6], Ya[7]);
            f32x16_t Ut;
#pragma unroll
            for (int i = 0; i < 16; ++i) Ut[i] = 0.f;
            Ut = MFMA32(cur.it, rhs, Ut);
            const bf16x8_t uf = pack8(Ut[0], Ut[1], Ut[2], Ut[3], Ut[4], Ut[5], Ut[6], Ut[7]);
#pragma unroll
            for (int g = 0; g < 4; ++g) {
                S0[4 * g] *= bl[g].x; S0[4 * g + 1] *= bl[g].y; S0[4 * g + 2] *= bl[g].z; S0[4 * g + 3] *= bl[g].w;
                S1[4 * g] *= bl[4 + g].x; S1[4 * g + 1] *= bl[4 + g].y; S1[4 * g + 2] *= bl[4 + g].z; S1[4 * g + 3] *= bl[4 + g].w;
            }
            S0 = MFMA32(cur.bb0, uf, S0); S1 = MFMA32(cur.bb1, uf, S1);
            S0 = MFMA32(cur.bk0, cur.vt, S0); S1 = MFMA32(cur.bk1, cur.vt, S1);
            Ya = MFMA32(cur.mb, uf, Ya);
            if (role == 2) {
                bf16_t* cp = CP + ((size_t)bh * (R2_HALF * 16) + c * 16) * 64 + 32 * vt + r;
#pragma unroll
                for (int j = 0; j < 8; ++j) cp[(size_t)((j & 3) + 8 * (j >> 2) + 4 * hh) * 64] = (bf16_t)f2bf(Ya[8 + j]);
            } else {
                float* op = O + ((size_t)b * T + (cbeg + c) * 16) * 512 + h * 64 + 32 * vt + r;
#pragma unroll
                for (int j = 0; j < 8; ++j) op[(size_t)((j & 3) + 8 * (j >> 2) + 4 * hh) * 512] = Ya[8 + j];
            }
        }
        if (role == 0) {
            bf16_t* st = SSTt + ((size_t)bh * 64 + 32 * vt + r) * 64 + 4 * hh;
#pragma unroll
            for (int g = 0; g < 4; ++g) {
                uint2 w0, w1; w0.x = pg8::cvt_pk_bf16(S0[4 * g], S0[4 * g + 1]); w0.y = pg8::cvt_pk_bf16(S0[4 * g + 2], S0[4 * g + 3]);
                w1.x = pg8::cvt_pk_bf16(S1[4 * g], S1[4 * g + 1]); w1.y = pg8::cvt_pk_bf16(S1[4 * g + 2], S1[4 * g + 3]);
                *(uint2*)(st + 8 * g) = w0; *(uint2*)(st + 32 + 8 * g) = w1;
            }
        }
        asm volatile("s_waitcnt vmcnt(0)" ::: "memory");
#undef R2_ISSUE
#undef R2_DMA16
    }
    __syncthreads();
    if (threadIdx.x == 0) {
        __builtin_amdgcn_fence(__ATOMIC_RELEASE, "agent");
        asm volatile("s_waitcnt vmcnt(0)" ::: "memory");
        (void)xb_add(&flags[bh * 16], 1u);
        if (role) { XB_SPIN(xb_ld(&flags[bh * 16]) < 3u, barw); __builtin_amdgcn_fence(__ATOMIC_ACQUIRE, "agent"); asm volatile("s_waitcnt vmcnt(0)" ::: "memory"); }
    }
    __syncthreads();
    if (role) {
#pragma unroll 1
        for (int q = wave; q < 32; q += 8) {
            const int tb = (role - 1) * 32 + q;
            const bf16_t* ap = CP + ((size_t)bh * (R2_HALF * 16) + tb * 32 + r) * 64 + 8 * hh;
            const bf16x8_t a0 = *(const bf16x8_t*)(ap), a1 = *(const bf16x8_t*)(ap + 16), a2 = *(const bf16x8_t*)(ap + 32), a3 = *(const bf16x8_t*)(ap + 48);
#pragma unroll
            for (int nb = 0; nb < 2; ++nb) {
                const bf16_t* bp = SSTt + ((size_t)bh * 64 + 32 * nb + r) * 64 + 8 * hh;
                f32x16_t acc;
#pragma unroll
                for (int i = 0; i < 16; ++i) acc[i] = 0.f;
                acc = MFMA32(a0, *(const bf16x8_t*)(bp), acc); acc = MFMA32(a1, *(const bf16x8_t*)(bp + 16), acc);
                acc = MFMA32(a2, *(const bf16x8_t*)(bp + 32), acc); acc = MFMA32(a3, *(const bf16x8_t*)(bp + 48), acc);
                float* op = O + ((size_t)b * T + R2_HALF * 16 + tb * 32) * 512 + h * 64 + 32 * nb + r;
#pragma unroll
                for (int i = 0; i < 16; ++i) { float* o1 = op + (size_t)((i & 3) + 8 * (i >> 2) + 4 * hh) * 512; *o1 = *o1 + acc[i]; }
            }
        }
    }
    asm volatile("s_waitcnt vmcnt(0)" ::: "memory");
    __syncthreads();
    if (threadIdx.x == 0) { XB_SPIN(xb_ld(othersdone) < nothers, barw); }
    __syncthreads();
    {
        const int t0 = role == 0 ? 0 : (R2_HALF * 16 + (role - 1) * 1024), ntok = role == 0 ? R2_HALF * 16 : 1024;
        const int tq = lane >> 4, l = lane & 15; const int colb = h * 64 + 4 * l;
        const float4 lw = *(const float4*)(ln_w + colb), lb = *(const float4*)(ln_b + colb);
#pragma unroll 2
        for (int tt = wave * 4; tt < ntok; tt += 32) {
            const size_t tok = (size_t)b * T + t0 + tt + tq;
            const float4 o = *(const float4*)(O + tok * 512 + colb);
            const uint2 bw = *(const uint2*)(BON + tok * 512 + colb), gw = *(const uint2*)(LORA + tok * 1536 + 1024 + colb);
            const float mean = row_sum_dpp((o.x + o.y) + (o.z + o.w)) * (1.0f / 64.0f);
            const float d0 = o.x - mean, d1 = o.y - mean, d2 = o.z - mean, d3 = o.w - mean;
            const float var = row_sum_dpp((d0 * d0 + d1 * d1) + (d2 * d2 + d3 * d3)) * (1.0f / 64.0f);
            const float rs = frsq(var + 64e-5f);
            const float y0 = (d0 * rs * lw.x + lb.x + bf2f((unsigned short)(bw.x & 0xffff))) * bf2f((unsigned short)(gw.x & 0xffff));
            const float y1 = (d1 * rs * lw.y + lb.y + bf2f((unsigned short)(bw.x >> 16))) * bf2f((unsigned short)(gw.x >> 16));
            const float y2 = (d2 * rs * lw.z + lb.z + bf2f((unsigned short)(bw.y & 0xffff))) * bf2f((unsigned short)(gw.y & 0xffff));
            const float y3 = (d3 * rs * lw.w + lb.w + bf2f((unsigned short)(bw.y >> 16))) * bf2f((unsigned short)(gw.y >> 16));
            uint2 w; w.x = pg8::cvt_pk_bf16(y0, y1); w.y = pg8::cvt_pk_bf16(y2, y3);
            *(uint2*)(YMIX + tok * 1024 + colb) = w;
        }
    }
}

__device__ __forceinline__ void ph_router(const bf16_t* __restrict__ x, const float* __restrict__ gain, const float* __restrict__ wr, const float* __restrict__ br, unsigned char* __restrict__ HN, int* __restrict__ tok_e, float* __restrict__ tok_w, int* __restrict__ bcnt, float* ldsf) {
    const int TIDX = otid();
    const int lane = TIDX & 63, wave = TIDX >> 6;
    volatile int* hist = (volatile int*)ldsf;
    if (TIDX < 8) hist[TIDX] = 0;
    __syncthreads();
    const int TPB = (M + (int)gridDim.x - 1) / (int)gridDim.x; const int t_beg = (int)blockIdx.x * TPB, t_end = (t_beg + TPB) < M ? (t_beg + TPB) : M;
#pragma unroll 2
    for (int r = t_beg + wave; r < t_end; r += 8) {
        const uint2* xr = (const uint2*)(x + (size_t)r * D) + lane;
        float4 v[4]; float s = 0.f;
#pragma unroll
        for (int j = 0; j < 4; ++j) { const uint2 w = xr[64 * j]; v[j] = make_float4(bf2f((unsigned short)(w.x & 0xffff)), bf2f((unsigned short)(w.x >> 16)), bf2f((unsigned short)(w.y & 0xffff)), bf2f((unsigned short)(w.y >> 16)));
            s += v[j].x * v[j].x + v[j].y * v[j].y + v[j].z * v[j].z + v[j].w * v[j].w; }
        s = wave_sum(s);
        const float rs = 1.0f / sqrtf(s * (1.0f / D) + NORM_EPS);
        float lg[8];
#pragma unroll
        for (int e = 0; e < 8; ++e) lg[e] = 0.f;
        unsigned* o = (unsigned*)(HN + (size_t)r * D) + lane;
#pragma unroll
        for (int j = 0; j < 4; ++j) {
            const float4 g = ((const float4*)gain)[lane + 64 * j];
            const float4 hn = make_float4(v[j].x * rs * g.x, v[j].y * rs * g.y, v[j].z * rs * g.z, v[j].w * rs * g.w);
            o[64 * j] = pk4_fp8(hn.x, hn.y, hn.z, hn.w);
            const int d0 = 4 * (lane + 64 * j);
            const float hv[4] = {hn.x, hn.y, hn.z, hn.w};
#pragma unroll
            for (int i = 0; i < 4; ++i) {
                const float4 w0 = *(const float4*)(wr + (size_t)(d0 + i) * 8), w1 = *(const float4*)(wr + (size_t)(d0 + i) * 8 + 4);
                lg[0] += hv[i] * w0.x; lg[1] += hv[i] * w0.y; lg[2] += hv[i] * w0.z; lg[3] += hv[i] * w0.w;
                lg[4] += hv[i] * w1.x; lg[5] += hv[i] * w1.y; lg[6] += hv[i] * w1.z; lg[7] += hv[i] * w1.w;
            }
        }
#pragma unroll
        for (int e = 0; e < 8; ++e) lg[e] = wave_sum(lg[e]) + br[e];
        if (lane == 0) {
            int i1 = 0; float l1 = lg[0];
#pragma unroll
            for (int e = 1; e < 8; ++e) if (lg[e] > l1) { l1 = lg[e]; i1 = e; }
            int i2 = -1; float l2 = -3.0e38f;
#pragma unroll
            for (int e = 0; e < 8; ++e) if (e != i1 && lg[e] > l2) { l2 = lg[e]; i2 = e; }
            if (i2 < 0) { i2 = (i1 + 1) & 7; l2 = l1; }
            const float ex = expf(l2 - l1); const float w1 = 1.0f / (1.0f + ex);
            tok_e[r * 2] = i1; tok_e[r * 2 + 1] = i2; tok_w[r * 2] = w1; tok_w[r * 2 + 1] = ex * w1;
            atomicAdd((int*)&hist[i1], 1); atomicAdd((int*)&hist[i2], 1);
        }
    }
    __syncthreads();
    if (TIDX < 8) bcnt[blockIdx.x * 8 + TIDX] = hist[TIDX];
}
__device__ __forceinline__ void moe_prefix(const int* cnt, int (&ts)[9]) {
    ts[0] = 0;
#pragma unroll
    for (int e = 0; e < NEXP; ++e) ts[e + 1] = ts[e] + ((__builtin_amdgcn_readfirstlane(cnt[e]) + 255) >> 8);
}
__device__ __forceinline__ void ph_moe_combine(const bf16_t* __restrict__ Y, const int* __restrict__ tokpos, const float* __restrict__ tok_w, const bf16_t* __restrict__ Hb, float* __restrict__ out) {
    const int TIDX = otid();
    const int lane = TIDX & 63, wave = TIDX >> 6;
    const int gw = blockIdx.x * 8 + wave, NGW = gridDim.x * 8;
#pragma unroll 2
    for (int tok = gw; tok < M; tok += NGW) {
        const int p0 = tokpos[tok * 2], p1 = tokpos[tok * 2 + 1]; const float w0 = tok_w[tok * 2], w1 = tok_w[tok * 2 + 1];
        const uint4* y0 = (const uint4*)(Y + (size_t)p0 * D); const uint4* y1 = (const uint4*)(Y + (size_t)p1 * D); const uint4* hr = (const uint4*)(Hb + (size_t)tok * D);
        float4* op = (float4*)(out + (size_t)tok * D);
#pragma unroll
        for (int j = 0; j < 2; ++j) {
            const uint4 a = y0[lane + 64 * j], b = y1[lane + 64 * j], hv = hr[lane + 64 * j];
            const unsigned aw[4] = {a.x, a.y, a.z, a.w}, bw[4] = {b.x, b.y, b.z, b.w}, hw[4] = {hv.x, hv.y, hv.z, hv.w};
#pragma unroll
            for (int q = 0; q < 2; ++q) {
                const unsigned a0 = aw[2 * q], a1 = aw[2 * q + 1], b0 = bw[2 * q], b1 = bw[2 * q + 1], h0 = hw[2 * q], h1 = hw[2 * q + 1];
                float4 o;
                o.x = bf2f((unsigned short)(h0 & 0xffff)) + w0 * bf2f((unsigned short)(a0 & 0xffff)) + w1 * bf2f((unsigned short)(b0 & 0xffff));
                o.y = bf2f((unsigned short)(h0 >> 16)) + w0 * bf2f((unsigned short)(a0 >> 16)) + w1 * bf2f((unsigned short)(b0 >> 16));
                o.z = bf2f((unsigned short)(h1 & 0xffff)) + w0 * bf2f((unsigned short)(a1 & 0xffff)) + w1 * bf2f((unsigned short)(b1 & 0xffff));
                o.w = bf2f((unsigned short)(h1 >> 16)) + w0 * bf2f((unsigned short)(a1 >> 16)) + w1 * bf2f((unsigned short)(b1 >> 16));
                op[(lane + 64 * j) * 2 + q] = o;
            }
        }
    }
}


constexpr float W8_SCALE = 64.0f, W8_INV = 1.0f / 64.0f;
struct WC8 { const float* W; int ldw; int K; int ncols; unsigned char* WT; int rbase; int rs4; };
__device__ __forceinline__ void ph_wconv8(const WC8 w, float* lds, int vb, int vg, int rot) {
    const int TIDX = otid();
    const int lane = TIDX & 63, wave = TIDX >> 6;
    unsigned char* scr = (unsigned char*)lds + wave * 9216;
    const int nwg = vb >= 0 ? vg : (int)gridDim.x; int wgid = (vb >= 0 ? vb : (int)blockIdx.x) - rot; if (wgid < 0) wgid += nwg;
    const int nkt = w.K / 64, nnt = w.ncols / 64; const int bk = nkt >> 1, bn = nnt >> 2;
    const int g = lane >> 4, l15 = lane & 15;
    float4 v[4][4];
#define WC8_LOAD(bt) do { const int kt_ = 2 * ((bt) % bk) + (wave & 1), nt_ = 4 * ((bt) / bk) + (wave >> 1); \
        const float* wp_ = w.W + (size_t)(kt_ * 64 + 4 * g) * w.ldw + nt_ * 64 + 4 * l15; \
        _Pragma("unroll") for (int j = 0; j < 4; ++j) _Pragma("unroll") for (int q = 0; q < 4; ++q) v[j][q] = *(const float4*)(wp_ + (size_t)(16 * j + q) * w.ldw); } while (0)
    int bt = wgid;
    if (bt < bk * bn) WC8_LOAD(bt);
#pragma unroll 1
    for (; bt < bk * bn; bt += nwg) {
        const int kt = 2 * (bt % bk) + (wave & 1), nt = 4 * (bt / bk) + (wave >> 1); const int k0 = kt * 64, n0 = nt * 64;
#pragma unroll
        for (int j = 0; j < 4; ++j) { const int kb = 16 * j + 4 * g;
            *(unsigned*)(scr + (4 * l15 + 0) * 80 + kb) = pk4_fp8(v[j][0].x * W8_SCALE, v[j][1].x * W8_SCALE, v[j][2].x * W8_SCALE, v[j][3].x * W8_SCALE);
            *(unsigned*)(scr + (4 * l15 + 1) * 80 + kb) = pk4_fp8(v[j][0].y * W8_SCALE, v[j][1].y * W8_SCALE, v[j][2].y * W8_SCALE, v[j][3].y * W8_SCALE);
            *(unsigned*)(scr + (4 * l15 + 2) * 80 + kb) = pk4_fp8(v[j][0].z * W8_SCALE, v[j][1].z * W8_SCALE, v[j][2].z * W8_SCALE, v[j][3].z * W8_SCALE);
            *(unsigned*)(scr + (4 * l15 + 3) * 80 + kb) = pk4_fp8(v[j][0].w * W8_SCALE, v[j][1].w * W8_SCALE, v[j][2].w * W8_SCALE, v[j][3].w * W8_SCALE); }
        if (bt + nwg < bk * bn) WC8_LOAD(bt + nwg);
        asm volatile("s_waitcnt lgkmcnt(0)" ::: "memory");
#pragma unroll
        for (int i = 0; i < 4; ++i) { const int q = lane + 64 * i; const int nl = q >> 2, ch = q & 3; const int n = n0 + nl;
            const uint4 o = *(const uint4*)(scr + nl * 80 + ch * 16);
            const int drow = w.rbase + (n >> 2) * w.rs4 + (n & 3); *(uint4*)(w.WT + (size_t)drow * w.K + k0 + 16 * ch) = o; }
        asm volatile("s_waitcnt lgkmcnt(0)" ::: "memory");
    }
#undef WC8_LOAD
}
struct EpiSwiGLU8 {
    static constexpr bool PERM = true, AFTER_DRAIN = false;
    unsigned char* H; int ldh; int nN;
    __device__ __forceinline__ void operator()(const pg8::f32x4 (&acc)[2][2][4][2], const pg8::Unit& u, int wr, int wc, int fr, int fq) const {
        const int row0 = u.pm * 256 + wr * 64 + fr; const int pnl = u.pn % nN;
        const int hc0 = (pnl * 256 + wc * 32 + 8 * fq) >> 1;
#pragma unroll
        for (int ai = 0; ai < 2; ++ai)
#pragma unroll
            for (int m = 0; m < 4; ++m) { unsigned char* rowp = H + (size_t)(row0 + ai * 128 + m * 16) * ldh + hc0;
#pragma unroll
                for (int bj = 0; bj < 2; ++bj) { const pg8::f32x4 g = acc[ai][bj][m][0] * W8_INV, up = acc[ai][bj][m][1] * W8_INV; float o[4];
#pragma unroll
                    for (int j = 0; j < 4; ++j) o[j] = g[j] * __builtin_amdgcn_rcpf(1.0f + __expf(-g[j])) * up[j];
                    *(unsigned*)(rowp + bj * 64) = pk4_fp8(o[0], o[1], o[2], o[3]); } }
    }
};
struct EpiBf16S {
    static constexpr bool PERM = true, AFTER_DRAIN = false;
    bf16_t* O; int ldc; int nN; float scale;
    __device__ __forceinline__ void operator()(const pg8::f32x4 (&acc)[2][2][4][2], const pg8::Unit& u, int wr, int wc, int fr, int fq) const {
        const int row0 = u.pm * 256 + wr * 64 + fr; const int col0 = (u.pn % nN) * 256 + wc * 32 + 8 * fq;
#pragma unroll
        for (int ai = 0; ai < 2; ++ai)
#pragma unroll
            for (int m = 0; m < 4; ++m) { bf16_t* rowp = O + (size_t)(row0 + ai * 128 + m * 16) * ldc + col0;
#pragma unroll
                for (int bj = 0; bj < 2; ++bj) { const pg8::f32x4 v0 = acc[ai][bj][m][0] * scale, v1 = acc[ai][bj][m][1] * scale;
                    pg8::u32x4 w; w.x = pg8::cvt_pk_bf16(v0[0], v0[1]); w.y = pg8::cvt_pk_bf16(v0[2], v0[3]); w.z = pg8::cvt_pk_bf16(v1[0], v1[1]); w.w = pg8::cvt_pk_bf16(v1[2], v1[3]);
                    *(pg8::u32x4*)(rowp + bj * 128) = w; } }
    }
};
__device__ __forceinline__ void ph_moe_place8(const unsigned char* __restrict__ HN8, const int* __restrict__ bcnt, const int* __restrict__ tok_e, unsigned char* __restrict__ AS8, int* __restrict__ tokpos, int* __restrict__ cnt, float* ldsf) {
    const int TIDX = otid();
    const int lane = TIDX & 63, wave = TIDX >> 6;
    volatile int* sh = (volatile int*)ldsf;
    const int G = (int)gridDim.x;
    if (wave == 0) {
        float tot[8], off[8];
#pragma unroll
        for (int e = 0; e < 8; ++e) { tot[e] = 0.f; off[e] = 0.f; }
        for (int bb = lane; bb < G; bb += 64) { const int4 c0 = *(const int4*)(bcnt + bb * 8), c1 = *(const int4*)(bcnt + bb * 8 + 4); const int cc[8] = {c0.x, c0.y, c0.z, c0.w, c1.x, c1.y, c1.z, c1.w};
#pragma unroll
            for (int e = 0; e < 8; ++e) { tot[e] += (float)cc[e]; if (bb < (int)blockIdx.x) off[e] += (float)cc[e]; } }
        int ts = 0;
#pragma unroll
        for (int e = 0; e < 8; ++e) { const int te = (int)(wave_sum_dpp(tot[e]) + 0.5f), oe = (int)(wave_sum_dpp(off[e]) + 0.5f);
            if (lane == 0) { sh[e] = ts * 256 + oe; sh[8 + e] = te; sh[16 + e] = ts; if (blockIdx.x == 0) cnt[e] = te; }
            ts += (te + 255) >> 8; }
        if (lane == 0) sh[24] = ts;
    }
    __syncthreads();
    const int TPB = (M + G - 1) / G; const int t_beg = (int)blockIdx.x * TPB, t_end = (t_beg + TPB) < M ? (t_beg + TPB) : M;
    for (int g0 = t_beg; g0 < t_end; g0 += 64) {
        const int tk = g0 + lane; int e1 = -1, e2 = -1;
        if (tk < t_end) { e1 = tok_e[tk * 2]; e2 = tok_e[tk * 2 + 1]; }
        unsigned long long mk[8];
#pragma unroll
        for (int e = 0; e < 8; ++e) mk[e] = __ballot(e1 == e || e2 == e);
        const int n_here = (t_end - g0) < 64 ? (t_end - g0) : 64;
        for (int tl = wave; tl < n_here; tl += 8) {
            const int tok = g0 + tl;
            const int ea = __builtin_amdgcn_readlane(e1, tl), eb = __builtin_amdgcn_readlane(e2, tl);
            const unsigned long long below = (1ull << tl) - 1ull;
            int pa = 0, pb = 0;
#pragma unroll
            for (int e = 0; e < 8; ++e) { const int rk = __popcll(mk[e] & below); if (e == ea) pa = sh[e] + rk; if (e == eb) pb = sh[e] + rk; }
            const uint4 row = ((const uint4*)(HN8 + (size_t)tok * D))[lane];
            ((uint4*)(AS8 + (size_t)pa * D))[lane] = row; ((uint4*)(AS8 + (size_t)pb * D))[lane] = row;
            if (lane == 0) { tokpos[tok * 2] = pa; tokpos[tok * 2 + 1] = pb; }
        }
        __syncthreads();
        if (TIDX < 8) sh[TIDX] += __popcll(mk[TIDX]);
        __syncthreads();
    }
    const int gw = blockIdx.x * 8 + wave, NGW = G * 8;
#pragma unroll 1
    for (int e = 0; e < 8; ++e) { const int r0 = sh[16 + e] * 256 + sh[8 + e], r1 = (e < 7 ? sh[16 + e + 1] : sh[24]) * 256;
        for (int rr = r0 + gw; rr < r1; rr += NGW) ((uint4*)(AS8 + (size_t)rr * D))[lane] = make_uint4(0u, 0u, 0u, 0u); }
    __syncthreads();
}
#define WSB(mib) ((bf16_t*)(ws + (size_t)(mib) * MiB))
#define GEMM_STATIC(Aptr, Btptr, Mr, Nc, Kd, EpiT, Eobj) do { \
        pg8::Gemm g_{(const bf16_t*)(Aptr), (const bf16_t*)(Btptr), (Mr), (Nc), (Kd), 0, 0}; pg8::StaticOrder S_; S_.init((Mr), (Nc), (int)gridDim.x, VBLK); \
        pg8::gemm_phase<EpiT, pg8::StaticOrder, PG8_ALIGN, PG8_SP2>(ldsq, g_, S_, (Eobj)); } while (0)

#define GEMM_STATIC_OFF(Aptr, Btptr, Mr, Nc, Kd, EpiT, Eobj, COFF) do { \
        pg8::Gemm g_{(const bf16_t*)(Aptr), (const bf16_t*)(Btptr), (Mr), (Nc), (Kd), 0, 0}; pg8::StaticOrder S_; S_.init((Mr), (Nc), (int)gridDim.x, (int)(((unsigned)VBLK + gridDim.x - ((COFF) % gridDim.x)) % gridDim.x)); \
        pg8::gemm_phase<EpiT, pg8::StaticOrder, PG8_ALIGN, PG8_SP2>(ldsq, g_, S_, (Eobj)); } while (0)

template <class T> __device__ __forceinline__ T* opaque_uniform(T* p) {
    const unsigned long long v = (unsigned long long)p;
    unsigned lo = __builtin_amdgcn_readfirstlane((unsigned)v), hi = __builtin_amdgcn_readfirstlane((unsigned)(v >> 32));
    asm volatile("" : "+s"(lo), "+s"(hi));
    return (T*)(((unsigned long long)hi << 32) | lo);
}
__device__ __forceinline__ const float* ld_in(const float* const* t, int i) { t = opaque_uniform(t);
    typedef const float* __attribute__((address_space(4))) const* cptr_t;
    return ((cptr_t)(unsigned long long)t)[i]; }
__global__ void __launch_bounds__(NTHR, 2) fwd(Params P) {
    extern __shared__ __attribute__((aligned(16))) unsigned char lds_raw[];
    float* lds = (float*)lds_raw;
    PG8_LAS unsigned char* ldsq = (PG8_LAS unsigned char*)lds_raw;
    volatile LAS unsigned* MISC = (volatile LAS unsigned*)((LAS unsigned char*)lds_raw + (LDS_BYTES - 64));
    if (threadIdx.x < 16) MISC[threadIdx.x] = 0u;
    __syncthreads();
    unsigned char* ws = P.ws;
    unsigned* ctl = (unsigned*)(ws + WS_CTL);
    XcdBarrier bar = xcd_barrier_post(ctl + CW_BAR, MISC + 8);
#define BAR() do { XcdBarrier b2_ = bar; b2_.bar = opaque_uniform(b2_.bar); xcd_barrier(b2_); } while (0)
    const float* const* in = (const float* const*)__builtin_amdgcn_kernarg_segment_ptr();
#define INP(i) ld_in(in, (i))
    float* out = P.out;

    bf16_t* MEMNb0 = WSB(1); bf16_t* MEMNb1 = WSB(3); bf16_t* KVb0 = WSB(5); bf16_t* KVb1 = WSB(9);
    bf16_t* Wt_in = WSB(13); bf16_t* Wt_glu = WSB(18); bf16_t* Wt_out = WSB(19); bf16_t* Wt_q0 = WSB(21); bf16_t* Wt_kv0 = WSB(23); bf16_t* Wt_o0 = WSB(27); bf16_t* Wt_gu = WSB(29); bf16_t* Wt_dn = WSB(40);
    bf16_t* Wt_lora = WSB(46); bf16_t* Wt_q1 = WSB(48); bf16_t* Wt_kv1 = WSB(50); bf16_t* Wt_o1 = WSB(54);
    bf16_t* HNb = WSB(56);
    bf16_t* ZAb = WSB(88); bf16_t* UGX = WSB(145); float* XLOC = WSF(165); bf16_t* TE = WSB(173); bf16_t* TF = WSB(181); bf16_t* LORA = WSB(201); bf16_t* BON = WSB(249);
    const RwkvChunkBufs cb{WSB(329), WSB(361), WSB(393), WSB(409), WSB(417), WSB(421), WSF(425)};
    bf16_t* LA = WSB(329);
    bf16_t* Hb = WSB(427); float* SSQ = WSF(459);
    bf16_t* Wt_qkv = WSB(460); bf16_t* Wt_dao = WSB(466);
    float* Orw = WSF(56); float* YS = WSF(88); bf16_t* YSb = WSB(120); bf16_t* YMIXb = WSB(168);
    const S5P sp{INP(I_S5_LRE), INP(I_S5_LIM), INP(I_S5_LDT), INP(I_S5_BRE), INP(I_S5_BIM), INP(I_S5_CRE), INP(I_S5_CIM), INP(I_S5_D)};
#pragma unroll 1
    for (int step = 0; step < 2; ++step) {
        const bool mats = (((int)blockIdx.x & 1) == 0) == (step == 0);
        if (mats) ph_s5_mats(sp, TE, TF, lds); else ph_rmsnorm(INP(I_X), INP(I_NORM_MIX), HNb, M);
        __syncthreads();
        if (step == 0) {
        int rot0 = 32 % (int)gridDim.x;
        { WC w{INP(I_HY_WIN), INCOLS, D, INCOLS, 2560, Wt_in, 0, 4, 0, 0, 0, nullptr, 0}; ph_wconv(w, lds, -1, 0, rot0); rot0 = (rot0 + wc_nblk(w)) % (int)gridDim.x; }
        { WC w{INP(I_XA_WKV), 2 * D, D, 2 * D, 2 * D, Wt_kv0, 0, 4, 0, 0, 0, nullptr, 0}; ph_wconv(w, lds, -1, 0, rot0); rot0 = (rot0 + wc_nblk(w)) % (int)gridDim.x; }
        { WC w{INP(I_RW_WUP), 512, 64, 512, 512, Wt_lora, 0, 4, 384, 0, 6, nullptr, 0}; ph_wconv(w, lds, -1, 0, rot0); rot0 = (rot0 + wc_nblk(w)) % (int)gridDim.x; }
        { WC w{INP(I_RW_AUP), 512, 64, 512, 512, Wt_lora, 512, 4, 384, 64, 6, nullptr, 0}; ph_wconv(w, lds, -1, 0, rot0); rot0 = (rot0 + wc_nblk(w)) % (int)gridDim.x; }
        { WC w{INP(I_RW_GUP), 512, 160, 512, 512, Wt_lora, 1024, 4, 384, 128, 6, nullptr, 0}; ph_wconv(w, lds, -1, 0, rot0); rot0 = (rot0 + wc_nblk(w)) % (int)gridDim.x; }
        { WC w{INP(I_XA_WKV) + (size_t)D * 2 * D, 2 * D, D, 2 * D, 2 * D, Wt_kv1, 0, 4, 0, 0, 0, nullptr, 0}; ph_wconv(w, lds, -1, 0, rot0); rot0 = (rot0 + wc_nblk(w)) % (int)gridDim.x; }
            __syncthreads();
        }
    }
    ph_rmsnorm(INP(I_MEM), INP(I_NORM_MEM), MEMNb0, NB * MEML);
    ph_rmsnorm(INP(I_MEM), INP(I_NORM_MEM) + D, MEMNb1, NB * MEML);
    BAR();
    const bool XOK = __builtin_amdgcn_readfirstlane((MISC[11] == 1u && MISC[9] == 8u && bar.x < 8u && MISC[10] < MISC[8] && MISC[8] * 8u == gridDim.x) ? 1 : 0) != 0;
    const int VBLK = __builtin_amdgcn_readfirstlane(XOK ? (int)(MISC[10] * 8u + bar.x) : (int)blockIdx.x);
#define LBAR() do { if (XOK) { XcdBarrier b3_ = bar; b3_.bar = opaque_uniform(b3_.bar); xcd_local_barrier(b3_); } else BAR(); } while (0)
    { EpiZ E{ZAb, UGX}; GEMM_STATIC(HNb, Wt_in, M, 2560, D, EpiZ, E); }
    { EpiBf16P E{KVb0, 2 * D, 0, 0, nullptr}; GEMM_STATIC_OFF(MEMNb0, Wt_kv0, NB * MEML, 2 * D, D, EpiBf16P, E, 128); }
    { EpiBf16P E{KVb1, 2 * D, 0, 0, nullptr}; GEMM_STATIC_OFF(MEMNb1, Wt_kv1, NB * MEML, 2 * D, D, EpiBf16P, E, 160); }
    BAR();
    { pg8::Gemm g_{UGX, TE, 0, 0, 512, 640, 0}; GroupOrder S_{2, 1, 32, (int)gridDim.x, (int)blockIdx.x}; EpiF32S<true> E{XLOC, 128, 1};
      pg8::gemm_phase<EpiF32S<true>, GroupOrder, PG8_ALIGN, PG8_SP2>(ldsq, g_, S_, E); }
    { const int ev0 = (int)gridDim.x > 128 ? 64 : 0; const int evb = (int)blockIdx.x - ev0, evg = (int)gridDim.x - ev0;
      ph_lora_in(ZAb, INP(I_RW_MU), LA, evb, evg);
      ph_knorm_bf16(KVb0, INP(I_XA_KG), INP(I_XA_QG), evb, evg);
      ph_knorm_bf16(KVb1, INP(I_XA_KG) + 256, INP(I_XA_QG) + 256, evb, evg); }
    BAR();
    { EpiBf16P E{LORA, 1536, 0, 0, nullptr}; GEMM_STATIC(LA, Wt_lora, M, 1536, 384, EpiBf16P, E); }
    ph_s5_state(sp, XLOC, UGX, 128);
    BAR();
    { RwkvP rp{INP(I_RW_MU), INP(I_RW_W0), INP(I_RW_WUP), INP(I_RW_A0), INP(I_RW_AUP), INP(I_RW_GUP), INP(I_RW_KK), INP(I_RW_KA), INP(I_RW_RK), INP(I_RW_LNW), INP(I_RW_LNB)};
      ph_rwkv_chunk_prep2(ZAb, LORA, rp, cb, BON, lds); }
    BAR();
    ph_rwkv_chunk_scan3(cb, Orw, WSB(136), WSB(144), ctl + CW_R2F, opaque_uniform(ctl + CW_BAR), lds, LORA, BON, INP(I_RW_LNW), INP(I_RW_LNB), YMIXb, opaque_uniform(ctl + CW_GLUF), (unsigned)((int)gridDim.x - R2_WGS));
    { const int cv0 = R2_WGS; const int cvg = (int)gridDim.x > cv0 ? (int)gridDim.x - cv0 : 0; const int cvb = (int)blockIdx.x - cv0;
      if (cvg == 0 || cvb >= 0) { int rot1 = 0; const int cvn = cvg ? cvg : (int)gridDim.x;
        { WC w{INP(I_S5_WGLU), 512, 512, 512, 512, Wt_glu, 0, 4, 0, 0, 0, nullptr, 0}; ph_wconv(w, lds, cvg ? cvb : -1, cvg, rot1); rot1 = (rot1 + wc_nblk(w)) % cvn; }
        { WC w{INP(I_HY_WOUT), D, D, D, D, Wt_out, 0, 4, 0, 0, 0, nullptr, 0}; ph_wconv(w, lds, cvg ? cvb : -1, cvg, rot1); rot1 = (rot1 + wc_nblk(w)) % cvn; }
        { WC w{INP(I_XA_WQ), D, D, D, D, Wt_q0, 0, 4, 0, 0, 0, INP(I_NORM_XATTN), 0}; ph_wconv(w, lds, cvg ? cvb : -1, cvg, rot1); rot1 = (rot1 + wc_nblk(w)) % cvn; }
        { WC w{INP(I_XA_WO), D, D, D, D, Wt_o0, 0, 4, 0, 0, 0, nullptr, 0}; ph_wconv(w, lds, cvg ? cvb : -1, cvg, rot1); rot1 = (rot1 + wc_nblk(w)) % cvn; }
        { WC w{INP(I_FF_WG), DFF, D, DFF, DFF, Wt_gu, 0, 8, 0, 0, 0, INP(I_NORM_FFN), 0}; ph_wconv(w, lds, cvg ? cvb : -1, cvg, rot1); rot1 = (rot1 + wc_nblk(w)) % cvn; }
        { WC w{INP(I_FF_WU), DFF, D, DFF, DFF, Wt_gu, 4, 8, 0, 0, 0, INP(I_NORM_FFN), 0}; ph_wconv(w, lds, cvg ? cvb : -1, cvg, rot1); rot1 = (rot1 + wc_nblk(w)) % cvn; }
        { WC w{INP(I_FF_WD), D, DFF, D, D, Wt_dn, 0, 4, 0, 0, 0, nullptr, 0}; ph_wconv(w, lds, cvg ? cvb : -1, cvg, rot1); rot1 = (rot1 + wc_nblk(w)) % cvn; }
        { WC w{INP(I_XA_WQ) + (size_t)D * D, D, D, D, D, Wt_q1, 0, 4, 0, 0, 0, INP(I_NORM_XATTN) + D, 0}; ph_wconv(w, lds, cvg ? cvb : -1, cvg, rot1); rot1 = (rot1 + wc_nblk(w)) % cvn; }
        { WC w{INP(I_XA_WO) + (size_t)D * D, D, D, D, D, Wt_o1, 0, 4, 0, 0, 0, nullptr, 0}; ph_wconv(w, lds, cvg ? cvb : -1, cvg, rot1); rot1 = (rot1 + wc_nblk(w)) % cvn; }
        { WC w{INP(I_DA_WQKV), 3 * D, D, 3 * D, 3 * D, Wt_qkv, 0, 4, 0, 0, 0, INP(I_NORM_MIX) + D, 1}; ph_wconv(w, lds, cvg ? cvb : -1, cvg, rot1); rot1 = (rot1 + wc_nblk(w)) % cvn; }
        { WC w{INP(I_DA_WO), D, D, D, D, Wt_dao, 0, 4, 0, 0, 0, nullptr, 0}; ph_wconv(w, lds, cvg ? cvb : -1, cvg, rot1); rot1 = (rot1 + wc_nblk(w)) % cvn; }
      } }
    __syncthreads();
    { const int gsz = (int)gridDim.x - R2_WGS; pg8::Gemm g_{UGX, TF, 0, 0, 640, 640, 640}; GroupOrder S_{2, 2, 32, gsz > 0 ? gsz : (int)gridDim.x, gsz > 0 ? (int)blockIdx.x - R2_WGS : (int)blockIdx.x};
      EpiS5Y E{UGX, INP(I_S5_D), YS, YSb}; pg8::gemm_phase<EpiS5Y, GroupOrder, PG8_ALIGN, PG8_SP2>(ldsq, g_, S_, E); }
    if ((int)gridDim.x > R2_WGS && (int)blockIdx.x >= R2_WGS) {
        unsigned* barw = opaque_uniform(ctl + CW_BAR); unsigned* gf = opaque_uniform(ctl + CW_GLUF);
        asm volatile("s_waitcnt vmcnt(0)" ::: "memory");
        __syncthreads();
        if (threadIdx.x == 0) {
            __builtin_amdgcn_fence(__ATOMIC_RELEASE, "agent");
            asm volatile("s_waitcnt vmcnt(0)" ::: "memory");
            (void)xb_add(gf, 1u);
            if ((int)blockIdx.x - R2_WGS < 128) { XB_SPIN(xb_ld(gf) < (unsigned)((int)gridDim.x - R2_WGS), barw); __builtin_amdgcn_fence(__ATOMIC_ACQUIRE, "agent"); asm volatile("s_waitcnt vmcnt(0)" ::: "memory"); }
        }
        __syncthreads();
        { pg8::Gemm g_{YSb, Wt_glu, 0, 0, 512, 0, 0}; GroupOrder S_{64, 2, 1, (int)gridDim.x - R2_WGS, (int)blockIdx.x - R2_WGS}; EpiGLU E{YS, INP(I_S5_BGLU), YMIXb};
          pg8::gemm_phase<EpiGLU, GroupOrder, PG8_ALIGN, PG8_SP2>(ldsq, g_, S_, E); }
    }
    BAR();
    { EpiRes E{INP(I_X), Hb, SSQ}; GEMM_STATIC(YMIXb, Wt_out, M, D, D, EpiRes, E); }
    LBAR();

#define MEM_XATTN(KVb_, Wq_, Wo_, HbOut, QOFF, AOFF, ENDBAR) do { \
            bf16_t* Qb = WSB(QOFF); bf16_t* AOb = WSB(AOFF); \
            { EpiBf16P E{Qb, D, 0, 0, SSQ}; GEMM_STATIC(Hb, Wq_, M, D, D, EpiBf16P, E); } \
            {     \
              int qpm_, qpn_; pg8::static_unit_of(M / 256, D / 256, VBLK, qpm_, qpn_); \
              asm volatile("s_waitcnt vmcnt(0)" ::: "memory"); __syncthreads(); \
              int u0_ = __builtin_amdgcn_readfirstlane((qpm_ >> 4) * 128 + qpn_ * 32 + 2 * (qpm_ & 15)); asm volatile("" : "+s"(u0_)); \
              ph_mem_attn_mfma(Qb, KVb_, AOb, lds, u0_); } \
            LBAR();        \
            { EpiRes E{nullptr, Hb, SSQ}; GEMM_STATIC(AOb, Wo_, M, D, D, EpiRes, E); } \
            ENDBAR(); } while (0)

    MEM_XATTN(KVb0, Wt_q0, Wt_o0, Hb, 56, 88, LBAR);
    {
        bf16_t* H = WSB(329);
        { EpiSwiGLU E{H, DFF, 0, 0, SSQ}; GEMM_STATIC(Hb, Wt_gu, M, 2 * DFF, D, EpiSwiGLU, E); }
        LBAR();
        { EpiRes E{nullptr, Hb, SSQ}; GEMM_STATIC(H, Wt_dn, M, D, DFF, EpiRes, E); }
        BAR();
    }
    unsigned char* Wt_mgu8 = (unsigned char*)WSB(265); unsigned char* Wt_mdn8 = (unsigned char*)WSB(468);
    {
        bf16_t* QKVb = WSB(56); bf16_t* AOb = WSB(352);
        { EpiQKV E{QKVb, SSQ, INP(I_DA_QG), INP(I_DA_KG)}; GEMM_STATIC(Hb, Wt_qkv, M, 3 * D, D, EpiQKV, E); }
        BAR();
        { const int ncv = gridDim.x >= 192 ? 64 : 0; const int vb = (int)blockIdx.x - ((int)gridDim.x - ncv);
          if (ncv == 0 || vb >= 0) { int rot8 = 0; const int cvn8 = ncv ? ncv : (int)gridDim.x;
#pragma unroll 1
            for (int e = 0; e < NEXP; ++e) {
                { WC8 w{INP(I_MOE_WG) + (size_t)e * D * DFFE, DFFE, D, DFFE, Wt_mgu8 + (size_t)e * 2 * DFFE * D, 0, 8}; ph_wconv8(w, lds, ncv ? vb : -1, ncv, rot8); rot8 = (rot8 + 112) % cvn8; }
                { WC8 w{INP(I_MOE_WU) + (size_t)e * D * DFFE, DFFE, D, DFFE, Wt_mgu8 + (size_t)e * 2 * DFFE * D, 4, 8}; ph_wconv8(w, lds, ncv ? vb : -1, ncv, rot8); rot8 = (rot8 + 112) % cvn8; }
                { WC8 w{INP(I_MOE_WD) + (size_t)e * DFFE * D, D, DFFE, D, Wt_mdn8 + (size_t)e * D * DFFE, 0, 4}; ph_wconv8(w, lds, ncv ? vb : -1, ncv, rot8); rot8 = (rot8 + 112) % cvn8; }
            }
          } }
        { DAP dp{INP(I_DA_LQ1), INP(I_DA_LK1), INP(I_DA_LQ2), INP(I_DA_LK2), INP(I_DA_SUBG)}; ph_diff_attn_mfma(QKVb, dp, AOb, lds, ctl + CW_ATTQ, INP(I_DA_QG), INP(I_DA_KG)); }
        BAR();
        { EpiRes E{nullptr, Hb, SSQ}; GEMM_STATIC(AOb, Wt_dao, M, D, D, EpiRes, E); }
        LBAR();
    }
    MEM_XATTN(KVb1, Wt_q1, Wt_o1, (bf16_t*)nullptr, 56, 88, BAR);
    {
        unsigned char* HN8 = (unsigned char*)WSB(13);
        int* tok_e = (int*)WSF(29); float* tok_w = WSF(29) + 2 * M;
        int* tokpos = (int*)WSF(31);
        int* cnt = (int*)(ctl + CW_CNT);
        unsigned char* AS8 = (unsigned char*)WSB(32);
        bf16_t* Ym = WSB(66);
        unsigned char* Hm8 = (unsigned char*)WSB(134);
        int* bcnt = (int*)WSF(30);
        ph_router(Hb, INP(I_NORM_FFN) + D, INP(I_MOE_WR), INP(I_MOE_BR), HN8, tok_e, tok_w, bcnt, lds);
        BAR();
        ph_moe_place8(HN8, bcnt, tok_e, AS8, tokpos, cnt, lds);
        BAR();
        const int vc = (gridDim.x % 8 == 0) ? (int)((VBLK % 8) * (gridDim.x / 8) + VBLK / 8) : (int)blockIdx.x;
        { MoeOrder S_; S_.cnt = cnt; S_.nN = 2 * DFFE / 256; S_.G = (int)gridDim.x; S_.c = vc; S_.t_lo = 0; S_.t_hi = 136; S_.pm_base = 0;
          pg8::Gemm g_{(const bf16_t*)AS8, (const bf16_t*)Wt_mgu8, 0, 0, D / 2, 0, 0}; EpiSwiGLU8 E{Hm8, DFFE, 2 * DFFE / 256};
          pg8::gemm_phase_f8<EpiSwiGLU8, MoeOrder, PG8_ALIGN, PG8_SP2>(ldsq, g_, S_, E); }
        BAR();
        { MoeOrder S_; S_.cnt = cnt; S_.nN = D / 256; S_.G = (int)gridDim.x; S_.c = vc; S_.t_lo = 0; S_.t_hi = 136; S_.pm_base = 0;
          pg8::Gemm g_{(const bf16_t*)Hm8, (const bf16_t*)Wt_mdn8, 0, 0, DFFE / 2, 0, 0}; EpiBf16S E{Ym, D, D / 256, W8_INV};
          pg8::gemm_phase_f8<EpiBf16S, MoeOrder, PG8_ALIGN, PG8_SP2>(ldsq, g_, S_, E); }
        BAR();
        ph_moe_combine(Ym, tokpos, tok_w, Hb, out);
    }
}

extern "C" void kernel_launch(void* const* d_in, const int* in_sizes, int n_in, void* d_out, int out_size, void* d_ws, size_t ws_size, hipStream_t stream) {
    static int grid = 0;
    if (grid == 0) {
        int dev = 0, cus = 0;
        if (n_in != N_IN || ws_size < (size_t)497 * MiB) { fprintf(stderr, "kernel_launch: unexpected n_in %d / ws %zu\n", n_in, ws_size); grid = -1; return; }
        if (hipGetDevice(&dev) != hipSuccess || hipDeviceGetAttribute(&cus, hipDeviceAttributeMultiprocessorCount, dev) != hipSuccess) { grid = -1; return; }
        if (hipFuncSetAttribute((const void*)fwd, hipFuncAttributeMaxDynamicSharedMemorySize, LDS_BYTES) != hipSuccess) { fprintf(stderr, "hipFuncSetAttribute failed\n"); grid = -1; return; }
        int per_cu = 0;
        if (hipOccupancyMaxActiveBlocksPerMultiprocessor(&per_cu, (const void*)fwd, NTHR, LDS_BYTES) != hipSuccess || per_cu < 1) fprintf(stderr, "occupancy query: %d\n", per_cu);
        (void)hipGetLastError();
        grid = cus;
        if (grid != 256) { fprintf(stderr, "kernel_launch: %d CUs (the phase program deals fixed workgroup ranges of a 256-workgroup grid)\n", cus); grid = -1; return; }
    }
    if (grid < 0) return;
    hipMemsetAsync((char*)d_ws + WS_CTL, 0, CTL_BYTES, stream);
    Params p{};
    for (int i = 0; i < N_IN; ++i) p.in[i] = (const float*)d_in[i];
    p.out = (float*)d_out; p.ws = (unsigned char*)d_ws;
    hipLaunchKernelGGL(fwd, dim3(grid), dim3(NTHR), LDS_BYTES, stream, p);
}
```
